# Optimizing an MI355X kernel written in HIP

```python
import math
import jax, jax.numpy as jnp
from jax import lax
import numpy as np

D_MODEL = 1024
BATCH = 16
SEQ = 256
DEPTH = 4
DEC_BATCH = 8
DEC_SEQ = 4096
PAST_LEN = 512

GRID_W = 64
N_MIXERS = 3
N_LAYERS_A = (DEPTH + 2) // 3
N_LAYERS_B = (DEPTH + 1) // 3
N_LAYERS_C = DEPTH // 3
D_FF = 4 * D_MODEL
N_MOD = 6
RMS_EPS = 1e-6
ROPE_BASE = 10000.0
NEG_INF = -1e30

ATT_HEADS = 16
ATT_KV_HEADS = 4
ATT_HEAD_DIM = 64
ATT_GROUPS = ATT_HEADS // ATT_KV_HEADS
ATT_QKV_W = (ATT_HEADS + 2 * ATT_KV_HEADS) * ATT_HEAD_DIM
WINDOW = 128
BLOCK = 128

RET_HEADS = 4
RET_DK = 256
RET_DV = 512
RET_CHUNK = 128
RET_IN_W = 2 * RET_HEADS * RET_DK + 2 * RET_HEADS * RET_DV

D_RNN = 1024
LRU_BLOCKS = 8
LRU_BW = D_RNN // LRU_BLOCKS
CONV_W = 4
LRU_C = 8.0

kernel_name = "hybrid_flow_trunk_step"


def rms_norm(x, g):
    xf = x.astype(jnp.float32)
    y = xf * lax.rsqrt(jnp.mean(xf * xf, axis=-1, keepdims=True) + RMS_EPS)
    return (y * g.astype(jnp.float32)).astype(x.dtype)


def modulation(cvec, w_ada, b_ada):
    m = jax.nn.silu(cvec) @ w_ada + b_ada
    return jnp.split(m[:, None, :], N_MOD, axis=-1)


def modulate(x, g, shift, scale):
    return rms_norm(x, g) * (1.0 + scale) + shift


def grid_positions(T):
    rows = T // GRID_W
    row = jnp.repeat(jnp.arange(rows, dtype=jnp.int32), GRID_W)
    col = jnp.tile(jnp.arange(GRID_W, dtype=jnp.int32), rows)
    return row, col


def rope_1d(x, pos):
    half = x.shape[-1] // 2
    inv = ROPE_BASE ** (-jnp.arange(half, dtype=jnp.float32) / half)
    ang = pos.astype(jnp.float32)[:, None] * inv[None, :]
    cos = jnp.cos(ang)[:, None, :]
    sin = jnp.sin(ang)[:, None, :]
    xf = x.astype(jnp.float32)
    x1, x2 = xf[..., :half], xf[..., half:]
    return jnp.concatenate([x1 * cos - x2 * sin, x2 * cos + x1 * sin], axis=-1).astype(x.dtype)


def axial_rope(x):
    row, col = grid_positions(x.shape[1])
    h = x.shape[-1] // 2
    return jnp.concatenate([rope_1d(x[..., :h], row), rope_1d(x[..., h:], col)], axis=-1)


def attn_project(h, w_in, q_gain, k_gain):
    B, T, _ = h.shape
    qkv = h @ w_in
    q_end = ATT_HEADS * ATT_HEAD_DIM
    k_end = q_end + ATT_KV_HEADS * ATT_HEAD_DIM
    q = rms_norm(qkv[..., :q_end].reshape(B, T, ATT_HEADS, ATT_HEAD_DIM), q_gain)
    k = rms_norm(qkv[..., q_end:k_end].reshape(B, T, ATT_KV_HEADS, ATT_HEAD_DIM), k_gain)
    v = qkv[..., k_end:].reshape(B, T, ATT_KV_HEADS, ATT_HEAD_DIM)
    return q, k, v


def sink_column(sink, B, Q):
    s = sink.astype(jnp.float32).reshape(ATT_KV_HEADS, ATT_GROUPS)[None, :, :, None, None]
    return jnp.broadcast_to(s, (B, ATT_KV_HEADS, ATT_GROUPS, Q, 1))


def context_attention(q, k, v, sink):
    B, L, H, d = q.shape
    qg = q.reshape(B, L, ATT_KV_HEADS, ATT_GROUPS, d)
    s = jnp.einsum('bqhgd,bkhd->bhgqk', qg, k, preferred_element_type=jnp.float32) * (d ** -0.5)
    p = jax.nn.softmax(jnp.concatenate([s, sink_column(sink, B, L)], axis=-1), axis=-1)[..., :L]
    o = jnp.einsum('bhgqk,bkhd->bqhgd', p.astype(v.dtype), v)
    return o.reshape(B, L, H, d)


def latent_window_attention(q, k, v, k_ctx, v_ctx, sink):
    B, T, H, d = q.shape
    L = k_ctx.shape[1]
    nb = T // BLOCK
    span = BLOCK + 2 * WINDOW
    scale = d ** -0.5
    qg = q.reshape(B, T, ATT_KV_HEADS, ATT_GROUPS, d)
    pad = ((0, 0), (WINDOW, WINDOW), (0, 0), (0, 0))
    kp = jnp.pad(k, pad)
    vp = jnp.pad(v, pad)
    rel = jnp.arange(span)[None, :] - WINDOW - jnp.arange(BLOCK)[:, None]
    near = jnp.abs(rel) <= WINDOW
    sink_col = sink_column(sink, B, BLOCK)

    def one_block(n):
        start = n * BLOCK
        qb = lax.dynamic_slice_in_dim(qg, start, BLOCK, axis=1)
        kb = lax.dynamic_slice_in_dim(kp, start, span, axis=1)
        vb = lax.dynamic_slice_in_dim(vp, start, span, axis=1)
        kpos = start - WINDOW + jnp.arange(span)
        valid = near & ((kpos >= 0) & (kpos < T))[None, :]
        s_lat = jnp.einsum('bqhgd,bkhd->bhgqk', qb, kb, preferred_element_type=jnp.float32) * scale
        s_lat = jnp.where(valid, s_lat, NEG_INF)
        s_ctx = jnp.einsum('bqhgd,bkhd->bhgqk', qb, k_ctx, preferred_element_type=jnp.float32) * scale
        p = jax.nn.softmax(jnp.concatenate([s_lat, s_ctx, sink_col], axis=-1), axis=-1).astype(v.dtype)
        o = (jnp.einsum('bhgqk,bkhd->bqhgd', p[..., :span], vb)
             + jnp.einsum('bhgqk,bkhd->bqhgd', p[..., span:span + L], v_ctx))
        return o.reshape(B, BLOCK, H, d)

    out = lax.map(one_block, jnp.arange(nb))
    return jnp.moveaxis(out, 0, 1).reshape(B, T, H, d)


def retention_scan(q, k, v, log_gamma, s0, inclusive):
    B, T, H, dk = q.shape
    dv = v.shape[-1]
    C = RET_CHUNK
    nc = T // C
    qc = q.reshape(B, nc, C, H, dk)
    kc = k.reshape(B, nc, C, H, dk)
    vc = v.reshape(B, nc, C, H, dv)
    lg = log_gamma.astype(jnp.float32)
    idx = jnp.arange(C, dtype=jnp.float32)
    diff = idx[:, None] - idx[None, :]
    mask = (diff >= 0) if inclusive else (diff > 0)
    decay = jnp.where(mask[None], jnp.exp(lg[:, None, None] * jnp.maximum(diff, 0.0)[None]), 0.0)
    scores = jnp.einsum('bnihd,bnjhd->bnhij', qc, kc, preferred_element_type=jnp.float32) * decay
    o_intra = jnp.einsum('bnhij,bnjhe->bnihe', scores, vc)
    w_state = jnp.exp(lg[:, None] * (C - 1.0 - idx)[None, :])
    w_query = jnp.exp(lg[:, None] * (idx + 1.0)[None, :])
    gamma_chunk = jnp.exp(lg * C)[None, :, None, None]

    def step(s, blk):
        qn, kn, vn = blk
        o_cross = jnp.einsum('bihd,hi,bhde->bihe', qn, w_query, s)
        kv = jnp.einsum('bjhd,hj,bjhe->bhde', kn, w_state, vn)
        return gamma_chunk * s + kv, o_cross

    s_fin, o_cross = lax.scan(step, s0.astype(jnp.float32),
                              (jnp.moveaxis(qc, 1, 0), jnp.moveaxis(kc, 1, 0), jnp.moveaxis(vc, 1, 0)))
    o = o_intra + jnp.moveaxis(o_cross, 0, 1)
    return o.reshape(B, T, H, dv), s_fin


def retention_mixer(h, w_in, w_out, gn_gain, log_decay, s0_f, s0_b, rotate):
    B, T, _ = h.shape
    proj = h @ w_in
    e1 = RET_HEADS * RET_DK
    e2 = 2 * e1
    e3 = e2 + RET_HEADS * RET_DV
    q = proj[..., :e1].reshape(B, T, RET_HEADS, RET_DK)
    k = proj[..., e1:e2].reshape(B, T, RET_HEADS, RET_DK)
    v = proj[..., e2:e3].reshape(B, T, RET_HEADS, RET_DV)
    g = proj[..., e3:]
    if rotate:
        q, k = axial_rope(q), axial_rope(k)
    k = k * (RET_DK ** -0.5)
    o_f, s_f = retention_scan(q, k, v, log_decay[0], s0_f, True)
    o_b, s_b = retention_scan(jnp.flip(q, 1), jnp.flip(k, 1), jnp.flip(v, 1), log_decay[1], s0_b, False)
    o = o_f + jnp.flip(o_b, 1)
    mu = jnp.mean(o, axis=-1, keepdims=True)
    var = jnp.mean(jnp.square(o - mu), axis=-1, keepdims=True)
    o = ((o - mu) * lax.rsqrt(var + RMS_EPS)).reshape(B, T, RET_HEADS * RET_DV) * gn_gain.astype(jnp.float32)
    y = (jax.nn.silu(g) * o.astype(h.dtype)) @ w_out
    return y, s_f, s_b


def centred_depthwise_conv(x, w, b):
    left = CONV_W // 2
    right = CONV_W - 1 - left
    y = lax.conv_general_dilated(x, w[:, None, :], window_strides=(1,), padding=[(left, right)],
                                 dimension_numbers=('NWC', 'WIO', 'NWC'), feature_group_count=x.shape[-1])
    return y + b


def _linear_combine(left, right):
    a_l, u_l = left
    a_r, u_r = right
    return a_l * a_r, a_r * u_l + u_r


def rglru_scan(xc, w_r, b_r, w_i, b_i, lam, h0):
    B, T, _ = xc.shape
    xf = xc.astype(jnp.float32)
    xb = xf.reshape(B, T, LRU_BLOCKS, LRU_BW)
    r = jax.nn.sigmoid(jnp.einsum('btnc,ncd->btnd', xb, w_r.astype(jnp.float32)).reshape(B, T, D_RNN) + b_r)
    i = jax.nn.sigmoid(jnp.einsum('btnc,ncd->btnd', xb, w_i.astype(jnp.float32)).reshape(B, T, D_RNN) + b_i)
    log_a = -LRU_C * r * jax.nn.softplus(-lam.astype(jnp.float32))
    a = jnp.exp(log_a)
    u = jnp.sqrt(-jnp.expm1(2.0 * log_a)) * (i * xf)
    u = u.at[:, 0].add(a[:, 0] * h0.astype(jnp.float32))
    _, hs = lax.associative_scan(_linear_combine, (a, u), axis=1)
    return hs, hs[:, -1]


def lru_mixer(h, w_in, conv_w, conv_b, w_r, b_r, w_i, b_i, lam, w_out, h0_f, h0_b):
    proj = h @ w_in
    gate, xr = proj[..., :D_RNN], proj[..., D_RNN:]
    xc = centred_depthwise_conv(xr, conv_w, conv_b)
    h_f, s_f = rglru_scan(xc, w_r[0], b_r[0], w_i[0], b_i[0], lam[0], h0_f)
    h_b, s_b = rglru_scan(jnp.flip(xc, 1), w_r[1], b_r[1], w_i[1], b_i[1], lam[1], h0_b)
    rec = (h_f + jnp.flip(h_b, 1)).astype(h.dtype)
    y = (jax.nn.gelu(gate) * rec) @ w_out
    return y, s_f, s_b


def sq_relu_mlp(h, w_up, w_down):
    return jnp.square(jax.nn.relu(h @ w_up)) @ w_down


def setup_inputs(seed: int = 0) -> dict:
    key = jax.random.key(seed)
    ks = iter(jax.random.split(key, 48))
    D = D_MODEL

    def nrm(shape, scale):
        return jax.random.normal(next(ks), shape, jnp.float32) * scale

    ret_base = jnp.log1p(-(2.0 ** (-5.0 - jnp.arange(RET_HEADS, dtype=jnp.float32))))
    u = jax.random.uniform(next(ks), (N_LAYERS_C, 2, D_RNN), jnp.float32, 0.9, 0.999)
    return {
        'x_prompt': nrm((BATCH, SEQ, D), 1.0),
        'x_sample': nrm((DEC_BATCH, DEC_SEQ, D), 1.0),
        'cache_attn_k': nrm((DEC_BATCH, N_LAYERS_A, PAST_LEN, ATT_KV_HEADS, ATT_HEAD_DIM), 1.0),
        'cache_attn_v': nrm((DEC_BATCH, N_LAYERS_A, PAST_LEN, ATT_KV_HEADS, ATT_HEAD_DIM), 1.0),
        'state_ret': nrm((DEC_BATCH, N_LAYERS_B, 2, RET_HEADS, RET_DK, RET_DV), 0.5),
        'state_lru': nrm((DEC_BATCH, N_LAYERS_C, 2, D_RNN), 0.5),
        'c': nrm((DEC_BATCH, D), 1.0),
        'c_ctx': nrm((D,), 1.0),
        'norm_mix': 1.0 + nrm((DEPTH, D), 0.02),
        'norm_mlp': 1.0 + nrm((DEPTH, D), 0.02),
        'w_ada': nrm((DEPTH, D, N_MOD * D), 0.5 * D ** -0.5),
        'b_ada': nrm((DEPTH, N_MOD * D), 0.02),
        'w_up': nrm((DEPTH, D, D_FF), D ** -0.5),
        'w_down': nrm((DEPTH, D_FF, D), D_FF ** -0.5),
        'attn_w_in': nrm((N_LAYERS_A, D, ATT_QKV_W), D ** -0.5),
        'attn_w_out': nrm((N_LAYERS_A, ATT_HEADS * ATT_HEAD_DIM, D), (ATT_HEADS * ATT_HEAD_DIM) ** -0.5),
        'attn_q_gain': 1.0 + nrm((N_LAYERS_A, ATT_HEAD_DIM), 0.02),
        'attn_k_gain': 1.0 + nrm((N_LAYERS_A, ATT_HEAD_DIM), 0.02),
        'attn_sink': nrm((N_LAYERS_A, ATT_HEADS), 0.5),
        'ret_w_in': nrm((N_LAYERS_B, D, RET_IN_W), D ** -0.5),
        'ret_w_out': nrm((N_LAYERS_B, RET_HEADS * RET_DV, D), (RET_HEADS * RET_DV) ** -0.5),
        'ret_gn_gain': 1.0 + nrm((N_LAYERS_B, RET_HEADS * RET_DV), 0.02),
        'ret_log_decay': ret_base[None, None, :] * jnp.exp(nrm((N_LAYERS_B, 2, RET_HEADS), 0.05)),
        'lru_w_in': nrm((N_LAYERS_C, D, 2 * D_RNN), D ** -0.5),
        'lru_conv_w': nrm((N_LAYERS_C, CONV_W, D_RNN), CONV_W ** -0.5),
        'lru_conv_b': nrm((N_LAYERS_C, D_RNN), 0.02),
        'lru_w_r': nrm((N_LAYERS_C, 2, LRU_BLOCKS, LRU_BW, LRU_BW), LRU_BW ** -0.5),
        'lru_b_r': nrm((N_LAYERS_C, 2, D_RNN), 0.02),
        'lru_w_i': nrm((N_LAYERS_C, 2, LRU_BLOCKS, LRU_BW, LRU_BW), LRU_BW ** -0.5),
        'lru_b_i': nrm((N_LAYERS_C, 2, D_RNN), 0.02),
        'lru_lambda': jnp.log(u) - jnp.log1p(-u),
        'lru_w_out': nrm((N_LAYERS_C, D_RNN, D), D_RNN ** -0.5),
    }


def reference(x_prompt, x_sample, cache_attn_k, cache_attn_v, state_ret, state_lru, c, c_ctx,
              norm_mix, norm_mlp, w_ada, b_ada, w_up, w_down,
              attn_w_in, attn_w_out, attn_q_gain, attn_k_gain, attn_sink,
              ret_w_in, ret_w_out, ret_gn_gain, ret_log_decay,
              lru_w_in, lru_conv_w, lru_conv_b, lru_w_r, lru_b_r, lru_w_i, lru_b_i, lru_lambda, lru_w_out):
    Bp, Lp, _ = x_prompt.shape
    Bs, Ts, _ = x_sample.shape
    c_prompt = jnp.broadcast_to(c_ctx[None, :], (Bp, D_MODEL))
    xp, xs = x_prompt, x_sample
    new_k, new_v, new_ret, new_lru = [], [], [], []
    for layer in range(DEPTH):
        kind = layer % N_MIXERS
        slot = layer // N_MIXERS
        sh_ap, sc_ap, g_ap, sh_mp, sc_mp, g_mp = modulation(c_prompt, w_ada[layer], b_ada[layer])
        sh_as, sc_as, g_as, sh_ms, sc_ms, g_ms = modulation(c, w_ada[layer], b_ada[layer])
        hp = modulate(xp, norm_mix[layer], sh_ap, sc_ap)
        hs = modulate(xs, norm_mix[layer], sh_as, sc_as)
        if kind == 0:
            q, k, v = attn_project(hp, attn_w_in[slot], attn_q_gain[slot], attn_k_gain[slot])
            yp = context_attention(q, k, v, attn_sink[slot]).reshape(Bp, Lp, -1) @ attn_w_out[slot]
            new_k.append(k)
            new_v.append(v)
            q, k, v = attn_project(hs, attn_w_in[slot], attn_q_gain[slot], attn_k_gain[slot])
            q, k = axial_rope(q), axial_rope(k)
            ys = latent_window_attention(q, k, v, cache_attn_k[:, slot], cache_attn_v[:, slot],
                                         attn_sink[slot]).reshape(Bs, Ts, -1) @ attn_w_out[slot]
        elif kind == 1:
            zero = jnp.zeros((Bp, RET_HEADS, RET_DK, RET_DV), jnp.float32)
            yp, s_f, s_b = retention_mixer(hp, ret_w_in[slot], ret_w_out[slot], ret_gn_gain[slot],
                                           ret_log_decay[slot], zero, zero, False)
            new_ret.append(jnp.stack([s_f, s_b], axis=1).astype(x_prompt.dtype))
            ys, _, _ = retention_mixer(hs, ret_w_in[slot], ret_w_out[slot], ret_gn_gain[slot],
                                       ret_log_decay[slot], state_ret[:, slot, 0], state_ret[:, slot, 1], True)
        else:
            zero = jnp.zeros((Bp, D_RNN), jnp.float32)
            yp, s_f, s_b = lru_mixer(hp, lru_w_in[slot], lru_conv_w[slot], lru_conv_b[slot], lru_w_r[slot],
                                     lru_b_r[slot], lru_w_i[slot], lru_b_i[slot], lru_lambda[slot],
                                     lru_w_out[slot], zero, zero)
            new_lru.append(jnp.stack([s_f, s_b], axis=1).astype(x_prompt.dtype))
            ys, _, _ = lru_mixer(hs, lru_w_in[slot], lru_conv_w[slot], lru_conv_b[slot], lru_w_r[slot],
                                 lru_b_r[slot], lru_w_i[slot], lru_b_i[slot], lru_lambda[slot],
                                 lru_w_out[slot], state_lru[:, slot, 0], state_lru[:, slot, 1])
        xp = xp + g_ap * yp
        xs = xs + g_as * ys
        xp = xp + g_mp * sq_relu_mlp(modulate(xp, norm_mlp[layer], sh_mp, sc_mp), w_up[layer], w_down[layer])
        xs = xs + g_ms * sq_relu_mlp(modulate(xs, norm_mlp[layer], sh_ms, sc_ms), w_up[layer], w_down[layer])
    new_attn_k = jnp.stack(new_k, axis=1)
    new_attn_v = jnp.stack(new_v, axis=1)
    new_state_ret = jnp.stack(new_ret, axis=1)
    new_state_lru = jnp.stack(new_lru, axis=1)
    return (xp, xs, new_attn_k, new_attn_v, new_state_ret, new_state_lru)
```

```cpp
#include <hip/hip_runtime.h>
#include <hip/hip_cooperative_groups.h>
#include <cstdio>
#include <cstdint>
namespace cg = cooperative_groups;

#define LAS __attribute__((address_space(3)))
typedef unsigned short bf16_t;
typedef short bf16x8 __attribute__((ext_vector_type(8)));
typedef short s16x4 __attribute__((ext_vector_type(4)));
typedef float f32x4 __attribute__((ext_vector_type(4)));
typedef float f32x2 __attribute__((ext_vector_type(2)));
typedef float f32x16 __attribute__((ext_vector_type(16)));
typedef unsigned u32x4 __attribute__((ext_vector_type(4)));
typedef unsigned u32x2 __attribute__((ext_vector_type(2)));

#define LOG2E 1.4426950408889634f
constexpr int DM = 1024, NPROMPT = 4096, MTOK = 36864, DFF = 4096;
constexpr size_t MiB = 1u << 20;
constexpr size_t WS_MOD = 1 * MiB;
constexpr size_t WS_WUP = 2 * MiB, WS_WDN = 10 * MiB, WS_WIN = 18 * MiB, WS_WOUT = 26 * MiB, WS_WX = 30 * MiB, WS_WX2 = 32 * MiB;
constexpr size_t WS_CK = 34 * MiB, WS_CV = 38 * MiB;
constexpr size_t WS_A = 44 * MiB;
constexpr size_t WS_H = 440 * MiB;
constexpr size_t WS_AQ = 44 * MiB, WS_AK = 116 * MiB, WS_AV = 134 * MiB, WS_AO = 152 * MiB;
constexpr size_t WS_RQ = 44 * MiB, WS_RK = 116 * MiB, WS_RV = 188 * MiB, WS_RO = 332 * MiB, WS_RSTP = 476 * MiB, WS_RFIN = 494 * MiB;
constexpr size_t WS_LXR = 368 * MiB, WS_LXC = 44 * MiB, WS_LLA = 116 * MiB, WS_LU = 260 * MiB, WS_LAGG = 404 * MiB, WS_LREC = 44 * MiB;
constexpr size_t WS_HID = 44 * MiB;
constexpr size_t WS_PART_A = 224 * MiB, WS_PART_R = 44 * MiB, WS_PART_L = 116 * MiB, WS_PART_M = 332 * MiB;
constexpr size_t OUT_K = 37748736, OUT_V = 39845888, OUT_RET = 41943040, OUT_LRU = 58720256;

__device__ __forceinline__ unsigned cvt_pk_bf16(float lo, float hi) { unsigned r; asm volatile("v_cvt_pk_bf16_f32 %0, %1, %2" : "=v"(r) : "v"(lo), "v"(hi)); return r; }
__device__ __forceinline__ float bf2f(unsigned short b) { return __uint_as_float((unsigned)b << 16); }
__device__ __forceinline__ float bflo(unsigned w) { return __uint_as_float(w << 16); }
__device__ __forceinline__ float bfhi(unsigned w) { return __uint_as_float(w & 0xffff0000u); }
__device__ __forceinline__ float fsigmoid(float x) { return __builtin_amdgcn_rcpf(1.f + __expf(-x)); }
__device__ __forceinline__ float fsilu(float x) { return x * fsigmoid(x); }
__device__ __forceinline__ float fgelu_tanh(float x) { const float u = 0.7978845608028654f * (x + 0.044715f * x * x * x); return x * fsigmoid(2.f * u); }
__device__ __forceinline__ int launder(int v) { asm volatile("" : "+v"(v)); return v; }
__device__ __forceinline__ int lane_id_v() { int l; asm volatile("v_mbcnt_lo_u32_b32 %0, -1, 0\n\tv_mbcnt_hi_u32_b32 %0, -1, %0" : "=v"(l)); return l; }
__device__ __forceinline__ int bid_s() { const int b = *(volatile LAS int*)(uintptr_t)143368u; return __builtin_amdgcn_readfirstlane(b); }
__device__ __forceinline__ int wave_id_s() { return __builtin_amdgcn_readfirstlane(__builtin_amdgcn_workitem_id_x() >> 6); }
__device__ __forceinline__ unsigned char* karg_ptr(int off) {
#if defined(__HIP_DEVICE_COMPILE__)
    unsigned long long v; auto ka = __builtin_amdgcn_kernarg_segment_ptr();
    if (off == 256) asm volatile("s_load_dwordx2 %0, %1, 0x100\n\ts_waitcnt lgkmcnt(0)" : "=s"(v) : "s"(ka));
    else asm volatile("s_load_dwordx2 %0, %1, 0x108\n\ts_waitcnt lgkmcnt(0)" : "=s"(v) : "s"(ka));
    return (unsigned char*)v;
#else
    (void)off; return nullptr;
#endif
}
__device__ __forceinline__ int modidx(int r) { return r < NPROMPT ? 0 : 1 + ((r - NPROMPT) >> 12); }
__device__ __forceinline__ void rope_cs(float pos, float inv, float& c, float& s) {
    float rev = pos * inv * 0.15915494309189535f; rev -= rintf(rev);
    s = __builtin_amdgcn_sinf(rev); c = __builtin_amdgcn_cosf(rev);
}

namespace pg8 {
constexpr int BM = 256, BK = 64, HALF = 128, HTB = HALF * BK * 2, STAGE_BYTES = 8 * HTB, NXCD = 8, WGM = 8;
__host__ __device__ __forceinline__ int lds_byte(int r, int c) { const int st = (r >> 4) * 2 + (c >> 5), rr = r & 15, cc = c & 31, ob = rr * 64 + cc * 2; return st * 1024 + (ob ^ (((ob >> 9) & 1) << 5)); }
__host__ __device__ __forceinline__ void stage_rc(int b, int& R, int& C) { const int st = b / 1024, sb = b % 1024, swz = sb ^ (((sb >> 9) & 1) << 5); R = (st >> 1) * 16 + swz / 64; C = (st & 1) * 32 + (swz % 64) / 2; }
__host__ __device__ __forceinline__ int perm32(int rho) { const int n = rho >> 4, i = rho & 15; return 8 * (i >> 2) + 4 * n + (i & 3); }
struct Unit { int pm, pn, kq; };
struct Gemm { const bf16_t* A; const bf16_t* Bt; int M, N, K, lda, ldb, ash, astep; };
struct StaticOrder {
    int nM, nN, nwg, G, c, ks;
    __device__ void init(int M, int N, int G_, int c_, int ks_ = 0) { nM = M / BM; nN = N / BM; nwg = nM * nN; G = G_; c = c_; ks = ks_; }
    __device__ bool next(int i, Unit& u) const {
        if (ks) { if (i < 2) { const int j = i * 32 + (c >> 3), xx = c & 7; u.pm = 16 * xx + (j >> 2); u.pn = j & 3; u.kq = -1; return true; }
                  if (i == 2) { const int t = c >> 2; u.pm = 128 + (t >> 2); u.pn = t & 3; u.kq = c & 3; return true; } return false; }
        u.kq = -1;
        const int L = i * G + c; if (L >= nwg) return false;
        int wgid = L; { const int q = nwg / NXCD, r = nwg % NXCD, xcd = wgid % NXCD, off = wgid / NXCD; wgid = (xcd < r ? xcd * (q + 1) : r * (q + 1) + (xcd - r) * q) + off; }
        const int nig = WGM * nN, gid = wgid / nig, fm = gid * WGM, gsz = (nM - fm) < WGM ? (nM - fm) : WGM;
        u.pm = fm + ((wgid % nig) % gsz); u.pn = (wgid % nig) / gsz; return true;
    }
};

template <class Epi>
__device__ __forceinline__ void gemm_phase(LAS unsigned char* lds, const Gemm g, const StaticOrder& S, const Epi& E, const int wv) {
    const int wid = wv, lane = lane_id_v(), tid = wid * 64 + lane, wr = wid >> 2, wc = wid & 3, fr = lane & 15, fq = lane >> 4;
    int K_ = g.K; asm volatile("" : "+s"(K_));
    const int K = K_, nt = K / BK;
    unsigned voffA[2], voffB[2];
#pragma unroll
    for (int i = 0; i < 2; ++i) { int R, C; stage_rc(tid * 16 + i * 8192, R, C); const int Rb = Epi::PERM ? ((R & ~31) + perm32(R & 31)) : R;
        voffA[i] = (unsigned)(R * g.lda + C) * 2u; voffB[i] = (unsigned)(Rb * g.ldb + C) * 2u; }
    const unsigned kstep = (unsigned)(BK * 2);
    const unsigned hA = (unsigned)HALF * g.lda * 2u, hB = (unsigned)HALF * g.ldb * 2u, tA = 2u * hA, tB = 2u * hB;
    const unsigned ldsw = (unsigned)wid * 1024u;
    const int aoff = lds_byte(wr * 64 + fr, fq * 8), boff = lds_byte(wc * 32 + fr, fq * 8);
#define PG8_SA(b, h) (((b) * 2 + (h)) * HTB)
#define PG8_SB(b, h) ((4 + (b) * 2 + (h)) * HTB)
#define PG8_STAGE(bufoff, gbase, voff) do { _Pragma("unroll") for (int _i = 0; _i < 2; ++_i) \
        __builtin_amdgcn_global_load_lds((const unsigned*)((const char*)(gbase) + (voff)[_i]), (LAS unsigned*)(lds + (bufoff) + ldsw + _i * 8192), 16, 0, 0); } while (0)
#define PG8_LDA(dst, b, h) do { _Pragma("unroll") for (int m = 0; m < 4; ++m) _Pragma("unroll") for (int k = 0; k < 2; ++k) dst[m][k] = *(const LAS bf16x8*)(lds + PG8_SA(b, h) + aoff + m * 2048 + k * 1024); } while (0)
#define PG8_LDB(dst, b, h) do { _Pragma("unroll") for (int n = 0; n < 2; ++n) _Pragma("unroll") for (int k = 0; k < 2; ++k) dst[n][k] = *(const LAS bf16x8*)(lds + PG8_SB(b, h) + boff + n * 2048 + k * 1024); } while (0)
#define PG8_MMA(ai, bj, At, Bt) do { __builtin_amdgcn_s_setprio(1); _Pragma("unroll") for (int m = 0; m < 4; ++m) _Pragma("unroll") for (int n = 0; n < 2; ++n) _Pragma("unroll") for (int k = 0; k < 2; ++k) \
        acc[ai][bj][m][n] = __builtin_amdgcn_mfma_f32_16x16x32_bf16(Bt[n][k], At[m][k], acc[ai][bj][m][n], 0, 0, 0); __builtin_amdgcn_s_setprio(0); } while (0)
#define PG8_WAIT_V(n) asm volatile("s_waitcnt vmcnt(" #n ")" ::: "memory")
#define PG8_WAIT_L(n) asm volatile("s_waitcnt lgkmcnt(" #n ")" ::: "memory")
#define PG8_BAR __builtin_amdgcn_s_barrier()
#define PG8_SCHED __builtin_amdgcn_sched_barrier(0)
    Unit cur, nxt; int ui = 0;
    if (!S.next(0, cur)) return;
    f32x4 acc[2][2][4][2];
#pragma unroll
    for (int a = 0; a < 2; ++a)
#pragma unroll
        for (int b = 0; b < 2; ++b)
#pragma unroll
            for (int m = 0; m < 4; ++m)
#pragma unroll
                for (int n = 0; n < 2; ++n) acc[a][b][m][n] = (f32x4){0.f, 0.f, 0.f, 0.f};
    bf16x8 At[4][2], B0[2][2], B1[2][2];
    const int ntq = nt >> 2;
    int cnt = cur.kq >= 0 ? ntq : nt;
    const unsigned cko = cur.kq >= 0 ? (unsigned)(cur.kq * ntq) * kstep : 0u;
    const char* cA = (const char*)g.A + ((unsigned)cur.pm * tA + (unsigned)(cur.pn >> g.ash) * (unsigned)g.astep + cko);
    const char* cB = (const char*)g.Bt + ((unsigned)cur.pn * tB + cko);
    PG8_STAGE(PG8_SB(0, 0), cB, voffB); PG8_STAGE(PG8_SB(0, 1), cB + hB, voffB); PG8_STAGE(PG8_SA(0, 0), cA, voffA); PG8_STAGE(PG8_SA(0, 1), cA + hA, voffA);
    if (wr == 1) PG8_BAR;
    PG8_WAIT_V(2); PG8_BAR;
    PG8_STAGE(PG8_SB(1, 0), cB + kstep, voffB); PG8_STAGE(PG8_SA(1, 0), cA + kstep, voffA); PG8_STAGE(PG8_SB(1, 1), cB + hB + kstep, voffB);
    PG8_WAIT_V(6); PG8_BAR;
    for (;;) {
        const bool has_next = S.next(ui + 1, nxt);
        const unsigned nko = (has_next && nxt.kq >= 0) ? (unsigned)(nxt.kq * ntq) * kstep : 0u;
        const char* nA = has_next ? (const char*)g.A + ((unsigned)nxt.pm * tA + (unsigned)(nxt.pn >> g.ash) * (unsigned)g.astep + nko) : cA; const char* nB = has_next ? (const char*)g.Bt + ((unsigned)nxt.pn * tB + nko) : cB;
        for (int t = 0; t < cnt; t += 2) {
            const bool last = (t == cnt - 2);
            const char* a1 = cA + (unsigned)(t + 1) * kstep;
            const char* a2 = last ? nA : cA + (unsigned)(t + 2) * kstep; const char* b2 = last ? nB : cB + (unsigned)(t + 2) * kstep;
            const char* a3 = a2 + kstep; const char* b3 = b2 + kstep;
            PG8_LDB(B0, 0, 0); PG8_LDB(B1, 0, 1); PG8_SCHED; PG8_LDA(At, 0, 0); PG8_STAGE(PG8_SA(1, 1), a1 + hA, voffA);
            PG8_WAIT_V(8); PG8_WAIT_L(0); PG8_BAR; PG8_MMA(0, 0, At, B0); PG8_MMA(0, 1, At, B1); PG8_BAR; PG8_SCHED;
            PG8_LDA(At, 0, 1); PG8_STAGE(PG8_SB(0, 0), b2, voffB); PG8_STAGE(PG8_SB(0, 1), b2 + hB, voffB); PG8_STAGE(PG8_SA(0, 0), a2, voffA);
            PG8_WAIT_V(8); PG8_WAIT_L(0); PG8_BAR; PG8_MMA(1, 0, At, B0); PG8_MMA(1, 1, At, B1); PG8_BAR; PG8_SCHED;
            PG8_LDB(B0, 1, 0); PG8_LDB(B1, 1, 1); PG8_SCHED; PG8_LDA(At, 1, 0); PG8_STAGE(PG8_SA(0, 1), a2 + hA, voffA);
            PG8_WAIT_V(8); PG8_WAIT_L(0); PG8_BAR; PG8_MMA(0, 0, At, B0); PG8_MMA(0, 1, At, B1); PG8_BAR; PG8_SCHED;
            PG8_LDA(At, 1, 1); PG8_STAGE(PG8_SB(1, 0), b3, voffB); PG8_STAGE(PG8_SB(1, 1), b3 + hB, voffB); PG8_STAGE(PG8_SA(1, 0), a3, voffA);
            PG8_WAIT_V(8); PG8_WAIT_L(0); PG8_BAR; PG8_MMA(1, 0, At, B0); PG8_MMA(1, 1, At, B1); PG8_BAR; PG8_SCHED;
        }
        if (wr == 0) PG8_BAR;
        E(acc, cur, wr, wc, fr, fq);
        if (!has_next) break;
#pragma unroll
        for (int a = 0; a < 2; ++a)
#pragma unroll
            for (int b = 0; b < 2; ++b)
#pragma unroll
                for (int m = 0; m < 4; ++m)
#pragma unroll
                    for (int n = 0; n < 2; ++n) acc[a][b][m][n] = (f32x4){0.f, 0.f, 0.f, 0.f};
        cur = nxt; cA = nA; cB = nB; ++ui; cnt = cur.kq >= 0 ? ntq : nt;
        if (wr == 1) PG8_BAR;
    }
    PG8_WAIT_V(0);
    PG8_BAR;
#undef PG8_SA
#undef PG8_SB
#undef PG8_STAGE
#undef PG8_LDA
#undef PG8_LDB
#undef PG8_MMA
#undef PG8_WAIT_V
#undef PG8_WAIT_L
#undef PG8_BAR
#undef PG8_SCHED
}

template <int ACT> struct EpiStore {
    static constexpr bool PERM = true;
    bf16_t* O; int ldc;
    __device__ __forceinline__ void operator()(const f32x4 (&acc)[2][2][4][2], const Unit& u, int wr, int wc, int fr, int fq) const {
        fr = launder(fr); fq = launder(fq);
        const int row0 = u.pm * BM + wr * 64 + fr, col0 = u.pn * BM + wc * 32 + 8 * fq;
#pragma unroll
        for (int ai = 0; ai < 2; ++ai)
#pragma unroll
            for (int m = 0; m < 4; ++m) { bf16_t* rowp = O + (size_t)(row0 + ai * HALF + m * 16) * ldc + col0;
#pragma unroll
                for (int bj = 0; bj < 2; ++bj) { f32x4 v0 = acc[ai][bj][m][0], v1 = acc[ai][bj][m][1];
                    if (ACT == 2) {
#pragma unroll
                        for (int e = 0; e < 4; ++e) { const float a = fmaxf(v0[e], 0.f), b = fmaxf(v1[e], 0.f); v0[e] = a * a; v1[e] = b * b; } }
                    u32x4 w; w.x = cvt_pk_bf16(v0[0], v0[1]); w.y = cvt_pk_bf16(v0[2], v0[3]); w.z = cvt_pk_bf16(v1[0], v1[1]); w.w = cvt_pk_bf16(v1[2], v1[3]);
                    *(u32x4*)(rowp + bj * HALF) = w; } asm volatile("" ::: "memory"); }
    }
};
struct EpiResid {
    static constexpr bool PERM = true;
    float* x; const float* gate; float* part;
    __device__ __forceinline__ void operator()(const f32x4 (&acc)[2][2][4][2], const Unit& u, int wr, int wc, int fr, int fq) const {
        fr = launder(fr); fq = launder(fq);
        const int row0 = u.pm * BM + wr * 64 + fr, col0 = u.pn * BM + wc * 32 + 8 * fq;
        if (u.kq >= 0) {
#pragma unroll
            for (int ai = 0; ai < 2; ++ai)
#pragma unroll
                for (int m = 0; m < 4; ++m) { float* rowp = part + ((size_t)u.kq * 4096 + (row0 + ai * HALF + m * 16 - 32768)) * DM + col0;
#pragma unroll
                    for (int bj = 0; bj < 2; ++bj)
#pragma unroll
                        for (int n = 0; n < 2; ++n) *(f32x4*)(rowp + bj * HALF + 4 * n) = acc[ai][bj][m][n]; }
            return;
        }
        const float* gp = gate + (size_t)modidx(u.pm * BM) * 6144 + col0;
        f32x4 gv[2][2];
#pragma unroll
        for (int bj = 0; bj < 2; ++bj)
#pragma unroll
            for (int n = 0; n < 2; ++n) gv[bj][n] = *(const f32x4*)(gp + bj * HALF + 4 * n);
#pragma unroll
        for (int ai = 0; ai < 2; ++ai)
#pragma unroll
            for (int m = 0; m < 4; ++m) { float* rowp = x + (size_t)(row0 + ai * HALF + m * 16) * DM + col0;
#pragma unroll
                for (int bj = 0; bj < 2; ++bj)
#pragma unroll
                    for (int n = 0; n < 2; ++n) { f32x4* p = (f32x4*)(rowp + bj * HALF + 4 * n); *p = *p + gv[bj][n] * acc[ai][bj][m][n]; }
                asm volatile("" ::: "memory"); }
    }
};
__device__ __forceinline__ void st4(bf16_t* p, const f32x4 v) { u32x2 w; w.x = cvt_pk_bf16(v[0], v[1]); w.y = cvt_pk_bf16(v[2], v[3]); *(u32x2*)p = w; }
struct EpiAttnQKV {
    static constexpr bool PERM = false;
    bf16_t *q, *k, *v; float *nk, *nv; const float *qg, *kg; int slot;
    __device__ __forceinline__ void operator()(const f32x4 (&acc)[2][2][4][2], const Unit& u, int wr, int wc, int fr, int fq) const {
        fr = launder(fr); fq = launder(fq);
        const int pn = u.pn;
#pragma unroll
        for (int ai = 0; ai < 2; ++ai)
#pragma unroll
            for (int m = 0; m < 4; ++m) {
                const int r = u.pm * BM + ai * HALF + wr * 64 + m * 16 + fr;
                f32x4 v00 = acc[ai][0][m][0], v01 = acc[ai][0][m][1], v10 = acc[ai][1][m][0], v11 = acc[ai][1][m][1];
                if (pn < 5) {
                    float ss = 0.f;
#pragma unroll
                    for (int e = 0; e < 4; ++e) ss += v00[e] * v00[e] + v01[e] * v01[e] + v10[e] * v10[e] + v11[e] * v11[e];
                    ss += __shfl_xor(ss, 16); ss += __shfl_xor(ss, 32);
                    const float rs = rsqrtf(ss * (1.f / 64.f) + 1e-6f);
                    const float* gn = (pn < 4 ? qg : kg) + 4 * fq;
                    v00 = v00 * rs * *(const f32x4*)(gn); v01 = v01 * rs * *(const f32x4*)(gn + 16); v10 = v10 * rs * *(const f32x4*)(gn + 32); v11 = v11 * rs * *(const f32x4*)(gn + 48);
                    if (r >= NPROMPT) {
                        const int t = (r - NPROMPT) & 4095; const float rp = (float)(t >> 6), cp = (float)(t & 63);
#pragma unroll
                        for (int e = 0; e < 4; ++e) {
                            const float inv = __builtin_amdgcn_exp2f(-(float)(4 * fq + e) * (13.287712379549449f / 16.f)); float c, s;
                            rope_cs(rp, inv, c, s); { const float x1 = v00[e], x2 = v01[e]; v00[e] = x1 * c - x2 * s; v01[e] = x2 * c + x1 * s; }
                            rope_cs(cp, inv, c, s); { const float x1 = v10[e], x2 = v11[e]; v10[e] = x1 * c - x2 * s; v11[e] = x2 * c + x1 * s; }
                        }
                    }
                }
                if (pn < 4) {
                    bf16_t* d = q + (size_t)r * 1024 + (4 * pn + wc) * 64 + 4 * fq;
                    constexpr float QS = 0.125f * LOG2E; st4(d, v00 * QS); st4(d + 16, v01 * QS); st4(d + 32, v10 * QS); st4(d + 48, v11 * QS);
                } else {
                    bf16_t* d = (pn == 4 ? k : v) + (size_t)r * 256 + wc * 64 + 4 * fq;
                    st4(d, v00); st4(d + 16, v01); st4(d + 32, v10); st4(d + 48, v11);
                    if (r < NPROMPT) { const int b = r >> 8, t = r & 255; float* o = (pn == 4 ? nk : nv) + ((size_t)(b * 2 + slot) * 256 + t) * 256 + wc * 64 + 4 * fq;
                        *(f32x4*)o = v00; *(f32x4*)(o + 16) = v01; *(f32x4*)(o + 32) = v10; *(f32x4*)(o + 48) = v11; }
                }
            }
    }
};
struct EpiRetQKV {
    static constexpr bool PERM = false;
    bf16_t *q, *k, *v;
    __device__ __forceinline__ void operator()(const f32x4 (&acc)[2][2][4][2], const Unit& u, int wr, int wc, int fr, int fq) const {
        fr = launder(fr); fq = launder(fq);
        const int pn = u.pn;
#pragma unroll
        for (int ai = 0; ai < 2; ++ai)
#pragma unroll
            for (int m = 0; m < 4; ++m) {
                const int r = u.pm * BM + ai * HALF + wr * 64 + m * 16 + fr;
                f32x4 v00 = acc[ai][0][m][0], v01 = acc[ai][0][m][1], v10 = acc[ai][1][m][0], v11 = acc[ai][1][m][1];
                if (pn < 8) {
                    if (r >= NPROMPT) {
                        const int t = (r - NPROMPT) & 4095; const float rp = (float)(t >> 6), cp = (float)(t & 63);
#pragma unroll
                        for (int e = 0; e < 4; ++e) {
                            const float inv = __builtin_amdgcn_exp2f(-(float)(16 * wc + 4 * fq + e) * (13.287712379549449f / 64.f)); float c, s;
                            rope_cs(rp, inv, c, s); { const float x1 = v00[e], x2 = v01[e]; v00[e] = x1 * c - x2 * s; v01[e] = x2 * c + x1 * s; }
                            rope_cs(cp, inv, c, s); { const float x1 = v10[e], x2 = v11[e]; v10[e] = x1 * c - x2 * s; v11[e] = x2 * c + x1 * s; }
                        }
                    }
                    if (pn >= 4) { v00 = v00 * 0.0625f; v01 = v01 * 0.0625f; v10 = v10 * 0.0625f; v11 = v11 * 0.0625f; }
                }
                bf16_t* d = (pn < 4 ? q + (size_t)r * 1024 + pn * 256 : pn < 8 ? k + (size_t)r * 1024 + (pn - 4) * 256 : v + (size_t)r * 2048 + (pn - 8) * 256) + 16 * wc + 4 * fq;
                st4(d, v00); st4(d + 64, v01); st4(d + 128, v10); st4(d + 192, v11);
            }
    }
};
template <int MODE> struct EpiLateGate {
    static constexpr bool PERM = true;
    bf16_t* Z; int ldz; const float* fin; const float* gn;
    __device__ __forceinline__ void operator()(const f32x4 (&acc)[2][2][4][2], const Unit& u, int wr, int wc, int fr, int fq) const {
        fr = launder(fr); fq = launder(fq);
        const int row0 = u.pm * BM + wr * 64 + fr, col0 = u.pn * BM + wc * 32 + 8 * fq;
#pragma unroll
        for (int ai = 0; ai < 2; ++ai)
#pragma unroll
            for (int m = 0; m < 4; ++m) { const int r = row0 + ai * HALF + m * 16;
#pragma unroll
                for (int bj = 0; bj < 2; ++bj) { const int c0 = col0 + bj * HALF; bf16_t* zp = Z + (size_t)r * ldz + c0;
                    const u32x4 zw = *(const u32x4*)zp; float z[8] = {bflo(zw.x), bfhi(zw.x), bflo(zw.y), bfhi(zw.y), bflo(zw.z), bfhi(zw.z), bflo(zw.w), bfhi(zw.w)};
                    float a[8]; { const f32x4 a0 = acc[ai][bj][m][0], a1 = acc[ai][bj][m][1]; a[0] = a0[0]; a[1] = a0[1]; a[2] = a0[2]; a[3] = a0[3]; a[4] = a1[0]; a[5] = a1[1]; a[6] = a1[2]; a[7] = a1[3]; }
                    float y[8];
                    if (MODE == 0) { const f32x2 st = *(const f32x2*)(fin + ((size_t)r * 4 + (c0 >> 9)) * 2); const f32x4 g0 = *(const f32x4*)(gn + c0), g1 = *(const f32x4*)(gn + c0 + 4);
                        const float gg[8] = {g0[0], g0[1], g0[2], g0[3], g1[0], g1[1], g1[2], g1[3]};
#pragma unroll
                        for (int e = 0; e < 8; ++e) y[e] = fsilu(a[e]) * ((z[e] - st.x) * st.y * gg[e]);
                    } else {
#pragma unroll
                        for (int e = 0; e < 8; ++e) y[e] = fgelu_tanh(a[e]) * z[e];
                    }
                    u32x4 w; w.x = cvt_pk_bf16(y[0], y[1]); w.y = cvt_pk_bf16(y[2], y[3]); w.z = cvt_pk_bf16(y[4], y[5]); w.w = cvt_pk_bf16(y[6], y[7]);
                    *(u32x4*)zp = w; asm volatile("" ::: "memory"); } }
    }
};
struct EpiLruGates {
    static constexpr bool PERM = false;
    const bf16_t* xc; bf16_t *la, *uu; const float *br, *bi, *lam;
    __device__ __forceinline__ void operator()(const f32x4 (&acc)[2][2][4][2], const Unit& u, int wr, int wc, int fr, int fq) const {
        fr = launder(fr); fq = launder(fq);
        const int nb = u.pn >> 1, dir = u.pn & 1;
#pragma unroll
        for (int bj = 0; bj < 2; ++bj) {
            const int ch = nb * 128 + 64 * bj + 16 * wc + 4 * fq;
            const f32x4 brv = *(const f32x4*)(br + dir * 1024 + ch), biv = *(const f32x4*)(bi + dir * 1024 + ch), lv = *(const f32x4*)(lam + dir * 1024 + ch);
            f32x4 sp;
#pragma unroll
            for (int e = 0; e < 4; ++e) sp[e] = -8.f * __logf(1.f + __expf(-lv[e]));
#pragma unroll
            for (int ai = 0; ai < 2; ++ai)
#pragma unroll
                for (int m = 0; m < 4; ++m) {
                    const int r = u.pm * BM + ai * HALF + wr * 64 + m * 16 + fr;
                    const u32x2 xw = *(const u32x2*)(xc + (size_t)r * 1024 + ch); const float xv[4] = {bflo(xw.x), bfhi(xw.x), bflo(xw.y), bfhi(xw.y)};
                    const f32x4 rp = acc[ai][bj][m][0], ip = acc[ai][bj][m][1]; f32x4 lo, uo;
#pragma unroll
                    for (int e = 0; e < 4; ++e) { const float pa = 1.f + __expf(-(rp[e] + brv[e])), pb = 1.f + __expf(-(ip[e] + biv[e])); const float inv = __builtin_amdgcn_rcpf(pa * pb);
                        const float rg = pb * inv, ig = pa * inv; const float l = rg * sp[e]; lo[e] = l; uo[e] = __builtin_amdgcn_sqrtf(fmaxf(1.f - __expf(2.f * l), 0.f)) * ig * xv[e]; }
                    st4(la + ((size_t)r * 2 + dir) * 1024 + ch, lo); st4(uu + ((size_t)r * 2 + dir) * 1024 + ch, uo);
                    asm volatile("" ::: "memory");
                }
        }
    }
};
}
using pg8::st4;

struct KArgs { const float* in[32]; float* out; unsigned char* ws; };
struct KTab { const float* const* t; };
__device__ __forceinline__ const float* inp(const KTab& a, int k) { return a.t[k]; }
__device__ __forceinline__ const float* inp(const KArgs& a, int k) { return a.in[k]; }

__device__ __forceinline__ float wave_sum(float v) {
#pragma unroll
    for (int o = 1; o < 64; o <<= 1) v += __shfl_xor(v, o);
    return v;
}
__device__ __forceinline__ float wave_max(float v) {
#pragma unroll
    for (int o = 1; o < 64; o <<= 1) v = fmaxf(v, __shfl_xor(v, o));
    return v;
}

template <int MODE>
__device__ __forceinline__ const float* wcol(const float* s0, const float* s1, int n) {
    if (MODE == 0) return s0 + n;
    if (MODE == 1) { const int gp = (n >> 5) & 7, bj = gp >> 2, wc = gp & 3; return s0 + (n & ~255) + (2 * wc + bj) * 32 + (n & 31); }
    if (MODE == 2) { const int p = n & 255, bj = p >> 7, wc = (p >> 5) & 3, nn = (p >> 4) & 1, r = p & 15; return s0 + (n & ~255) + 128 * bj + 64 * nn + 16 * wc + r; }
    { const int pn = n >> 8, nb = pn >> 1, dir = pn & 1, p = n & 255, bj = p >> 7, wc = (p >> 5) & 3, nn = (p >> 4) & 1, r = p & 15; const int cb = 64 * bj + 16 * wc + r;
      return (nn ? s1 : s0) + (size_t)(dir * 8 + nb) * 16384 + cb; }
}
template <int MODE>
__device__ __forceinline__ void wconv(const float* s0, const float* s1, int ld, int K, int N, bf16_t* WT, LAS float* scr, int lane_, int gw, int NGW) {
    const int lane = lane_id_v(); (void)lane_; asm volatile("" : "+s"(gw));
    const int nblk = N / 32, nitems = (K / 64) * nblk;
    for (int item = gw; item < nitems; item += NGW) {
        const int kb = item / nblk, nb = item % nblk, k0 = 64 * kb, n0 = 32 * nb;
        const float* cp = wcol<MODE>(s0, s1, n0 + (lane & 31));
#pragma unroll 8
        for (int i = 0; i < 32; ++i) { const int kk = 2 * i + (lane >> 5); scr[kk * 33 + (lane & 31)] = cp[(size_t)(k0 + kk) * ld]; }
        asm volatile("s_waitcnt lgkmcnt(0)" ::: "memory");
        const int c = lane & 7;
#pragma unroll
        for (int j = 0; j < 4; ++j) { const int n = (lane >> 3) + 8 * j; const LAS float* s = scr + (8 * c) * 33 + n;
            u32x4 o; o.x = cvt_pk_bf16(s[0 * 33], s[1 * 33]); o.y = cvt_pk_bf16(s[2 * 33], s[3 * 33]); o.z = cvt_pk_bf16(s[4 * 33], s[5 * 33]); o.w = cvt_pk_bf16(s[6 * 33], s[7 * 33]);
            *(u32x4*)(WT + (size_t)(n0 + n) * K + k0 + 8 * c) = o; }
        asm volatile("s_waitcnt lgkmcnt(0)" ::: "memory");
    }
}
template <class AT>
__device__ __forceinline__ void convert_layer_weights(const AT& a, unsigned char* ws, int layer, LAS unsigned char* lds, int wave, int lane, int gw, int NGW) {
    LAS float* scr = (LAS float*)(lds + wave * 8448);
    wconv<0>(inp(a, 12) + (size_t)layer * DM * DFF, nullptr, DFF, DM, DFF, (bf16_t*)(ws + WS_WUP), scr, lane, gw, NGW);
    wconv<0>(inp(a, 13) + (size_t)layer * DFF * DM, nullptr, DM, DFF, DM, (bf16_t*)(ws + WS_WDN), scr, lane, gw, NGW);
    const int kind = layer % 3, slot = layer / 3;
    if (kind == 0) {
        wconv<1>(inp(a, 14) + (size_t)slot * DM * 1536, nullptr, 1536, DM, 1536, (bf16_t*)(ws + WS_WIN), scr, lane, gw, NGW);
        wconv<0>(inp(a, 15) + (size_t)slot * DM * DM, nullptr, DM, DM, DM, (bf16_t*)(ws + WS_WOUT), scr, lane, gw, NGW);
    } else if (kind == 1) {
        wconv<2>(inp(a, 19) + (size_t)slot * DM * 6144, nullptr, 6144, DM, 4096, (bf16_t*)(ws + WS_WIN), scr, lane, gw, NGW);
        wconv<0>(inp(a, 19) + (size_t)slot * DM * 6144 + 4096, nullptr, 6144, DM, 2048, (bf16_t*)(ws + WS_WX), scr, lane, gw, NGW);
        wconv<0>(inp(a, 20) + (size_t)slot * 2048 * DM, nullptr, DM, 2048, DM, (bf16_t*)(ws + WS_WOUT), scr, lane, gw, NGW);
    } else {
        wconv<0>(inp(a, 23) + (size_t)slot * DM * 2048 + 1024, nullptr, 2048, DM, 1024, (bf16_t*)(ws + WS_WIN), scr, lane, gw, NGW);
        wconv<0>(inp(a, 23) + (size_t)slot * DM * 2048, nullptr, 2048, DM, 1024, (bf16_t*)(ws + WS_WX), scr, lane, gw, NGW);
        wconv<3>(inp(a, 26) + (size_t)slot * 2 * 8 * 16384, inp(a, 28) + (size_t)slot * 2 * 8 * 16384, 128, 128, 4096, (bf16_t*)(ws + WS_WX2), scr, lane, gw, NGW);
        wconv<0>(inp(a, 31) + (size_t)slot * DM * DM, nullptr, DM, DM, DM, (bf16_t*)(ws + WS_WOUT), scr, lane, gw, NGW);
    }
}

__device__ __forceinline__ void mod_phase(const KArgs& a, LAS unsigned char* lds, const int wv) {
    LAS float* sc = (LAS float*)lds;
    LAS float* red = (LAS float*)(lds + 36864);
    const int tid = (wv * 64 + lane_id_v());
    if (bid_s() >= 384) return;
    for (int i = tid; i < 9 * 1024; i += 512) { const int j = i >> 10, k = i & 1023; const float v = j == 0 ? inp(a, 7)[k] : inp(a, 6)[(j - 1) * 1024 + k]; sc[i] = fsilu(v); }
    __syncthreads();
    float* modt = (float*)(a.ws + WS_MOD);
    const int cl = tid & 63, ks = tid >> 6;
    for (int item = bid_s(); item < 384; item += gridDim.x) {
        const int l = item / 96, cg_ = item % 96, col = cg_ * 64 + cl;
        const float* w = inp(a, 10) + (size_t)l * DM * 6144 + col;
        float acc[9];
#pragma unroll
        for (int j = 0; j < 9; ++j) acc[j] = 0.f;
        for (int k0 = ks * 128; k0 < ks * 128 + 128; k0 += 16) {
            float wv[16];
#pragma unroll
            for (int u = 0; u < 16; ++u) wv[u] = w[(size_t)(k0 + u) * 6144];
#pragma unroll
            for (int u = 0; u < 16; ++u)
#pragma unroll
                for (int j = 0; j < 9; ++j) acc[j] += sc[j * 1024 + k0 + u] * wv[u];
        }
#pragma unroll
        for (int j = 0; j < 9; ++j) red[(ks * 9 + j) * 64 + cl] = acc[j];
        __syncthreads();
        for (int idx = tid; idx < 576; idx += 512) { const int j = idx >> 6, c2 = idx & 63; float s = inp(a, 11)[(size_t)l * 6144 + cg_ * 64 + c2];
#pragma unroll
            for (int q = 0; q < 8; ++q) s += red[(q * 9 + j) * 64 + c2];
            modt[((size_t)l * 9 + j) * 6144 + cg_ * 64 + c2] = s; }
        __syncthreads();
    }
}
__device__ __forceinline__ void cache_phase(const KArgs& a, const int wv) {
    const size_t n4 = (size_t)8 * 2 * 512 * 256 / 4;
    for (size_t i = (size_t)bid_s() * 512 + (wv * 64 + lane_id_v()); i < 2 * n4; i += (size_t)gridDim.x * 512) {
        const bool isv = i >= n4; const size_t j = isv ? i - n4 : i;
        const f32x4 v = *(const f32x4*)((isv ? inp(a, 3) : inp(a, 2)) + j * 4);
        st4((bf16_t*)(a.ws + (isv ? WS_CV : WS_CK)) + j * 4, v);
    }
}
template <bool FIRST>
__device__ __forceinline__ void norm_phase(const float* xp_, const float* xs_, float* xres, const float* gain, const float* modl, int sh_chunk, bf16_t* hout, int lane_, int gw, int NGW, const float* part = nullptr, const float* fixgate = nullptr) {
    const int lane = lane_id_v(); (void)lane_; asm volatile("" : "+s"(gw));
    for (int r = gw; r < MTOK; r += NGW) {
        const float* xr = FIRST ? (r < NPROMPT ? xp_ + (size_t)r * DM : xs_ + (size_t)(r - NPROMPT) * DM) : xres + (size_t)r * DM;
        f32x4 v[4]; float s = 0.f;
#pragma unroll
        for (int j = 0; j < 4; ++j) { v[j] = *(const f32x4*)(xr + 4 * lane + 256 * j); s += v[j][0] * v[j][0] + v[j][1] * v[j][1] + v[j][2] * v[j][2] + v[j][3] * v[j][3]; }
        if (FIRST) {
#pragma unroll
            for (int j = 0; j < 4; ++j) *(f32x4*)(xres + (size_t)r * DM + 4 * lane + 256 * j) = v[j];
        }
        if (!FIRST && part != nullptr && r >= 32768) {
            const float* gp = fixgate + (size_t)modidx(r) * 6144; s = 0.f;
#pragma unroll
            for (int j = 0; j < 4; ++j) { const int c = 4 * lane + 256 * j; const float* pp = part + (size_t)(r - 32768) * DM + c;
                const f32x4 ps = ((*(const f32x4*)pp + *(const f32x4*)(pp + (size_t)4096 * DM)) + *(const f32x4*)(pp + (size_t)2 * 4096 * DM)) + *(const f32x4*)(pp + (size_t)3 * 4096 * DM);
                v[j] = v[j] + *(const f32x4*)(gp + c) * ps; *(f32x4*)(xres + (size_t)r * DM + c) = v[j];
                s += v[j][0] * v[j][0] + v[j][1] * v[j][1] + v[j][2] * v[j][2] + v[j][3] * v[j][3]; }
        }
        const float rs = rsqrtf(wave_sum(s) * (1.f / DM) + 1e-6f);
        const float* mp = modl + (size_t)modidx(r) * 6144 + sh_chunk * 1024;
#pragma unroll
        for (int j = 0; j < 4; ++j) { const int c = 4 * lane + 256 * j; const f32x4 g = *(const f32x4*)(gain + c), sh = *(const f32x4*)(mp + c), sc = *(const f32x4*)(mp + 1024 + c);
            const f32x4 y = v[j] * rs * g * (1.f + sc) + sh; st4(hout + (size_t)r * DM + c, y); }
    }
}

__device__ __forceinline__ bf16x8 tr8(const LAS bf16_t* p0, const LAS bf16_t* p1) {
    const s16x4 a = __builtin_amdgcn_ds_read_tr16_b64_v4i16((LAS s16x4*)p0);
    const s16x4 b = __builtin_amdgcn_ds_read_tr16_b64_v4i16((LAS s16x4*)p1);
    return (bf16x8){a[0], a[1], a[2], a[3], b[0], b[1], b[2], b[3]};
}
__device__ __forceinline__ f32x16 mfma32(bf16x8 a, bf16x8 b, f32x16 c) { return __builtin_amdgcn_mfma_f32_32x32x16_bf16(a, b, c, 0, 0, 0); }
__device__ __forceinline__ f32x4 mfma16(bf16x8 a, bf16x8 b, f32x4 c) { return __builtin_amdgcn_mfma_f32_16x16x32_bf16(a, b, c, 0, 0, 0); }
__device__ __forceinline__ float fexp2(float x) { return __builtin_amdgcn_exp2f(x); }

__device__ __forceinline__ void att_tile(const LAS bf16_t* Ks, const LAS bf16_t* Vs, const bf16x8 (&Qf)[2][4], f32x16 (&ot)[2][2], float (&mrun)[2], float (&lrun)[2],
                                         bool skipw, bool needmask, int kpos0, int qpos0, int l31, int lh, int q4, int p4, int blk) {
            if (!skipw) {
                f32x16 sc[2][2];
#pragma unroll
                for (int cb = 0; cb < 2; ++cb)
#pragma unroll
                    for (int kk = 0; kk < 2; ++kk)
#pragma unroll
                        for (int r = 0; r < 16; ++r) sc[cb][kk][r] = 0.f;
#pragma unroll
                for (int s = 0; s < 4; ++s) {
                    const bf16x8 k0 = *(const LAS bf16x8*)(Ks + l31 * 72 + 16 * s + 8 * lh), k1 = *(const LAS bf16x8*)(Ks + (32 + l31) * 72 + 16 * s + 8 * lh);
                    sc[0][0] = mfma32(k0, Qf[0][s], sc[0][0]); sc[0][1] = mfma32(k1, Qf[0][s], sc[0][1]);
                    sc[1][0] = mfma32(k0, Qf[1][s], sc[1][0]); sc[1][1] = mfma32(k1, Qf[1][s], sc[1][1]);
                }
                bf16x8 pf[2][2][2];
#pragma unroll
                for (int cb = 0; cb < 2; ++cb) {
                    const int qpos = qpos0 + cb * 32 + l31;
                    float mx = -3.0e38f;
                    if (needmask) {
#pragma unroll
                        for (int r = 0; r < 16; ++r) { const int d0 = kpos0 + (r & 3) + 8 * (r >> 2) + 4 * lh - qpos, d1 = d0 + 32;
                            if (d0 > 128 || d0 < -128) sc[cb][0][r] = -1e30f; if (d1 > 128 || d1 < -128) sc[cb][1][r] = -1e30f; }
                    }
#pragma unroll
                    for (int r = 0; r < 16; ++r) mx = fmaxf(mx, fmaxf(sc[cb][0][r], sc[cb][1][r]));
                    mx = fmaxf(mx, __shfl_xor(mx, 32));
                    const float mnew = fmaxf(mrun[cb], mx), alpha = fexp2(mrun[cb] - mnew); mrun[cb] = mnew;
                    float ls = 0.f;
#pragma unroll
                    for (int r = 0; r < 16; ++r) { sc[cb][0][r] = fexp2(sc[cb][0][r] - mnew); sc[cb][1][r] = fexp2(sc[cb][1][r] - mnew); ls += sc[cb][0][r] + sc[cb][1][r]; }
                    lrun[cb] = lrun[cb] * alpha + ls;
                    if (__builtin_amdgcn_ballot_w64(alpha != 1.f) != 0ull) { ot[0][cb] = ot[0][cb] * alpha; ot[1][cb] = ot[1][cb] * alpha; }
#pragma unroll
                    for (int kk = 0; kk < 2; ++kk)
#pragma unroll
                        for (int s2 = 0; s2 < 2; ++s2) {
                            u32x4 w0;
                            w0.x = cvt_pk_bf16(sc[cb][kk][8 * s2 + 0], sc[cb][kk][8 * s2 + 1]); w0.y = cvt_pk_bf16(sc[cb][kk][8 * s2 + 2], sc[cb][kk][8 * s2 + 3]);
                            w0.z = cvt_pk_bf16(sc[cb][kk][8 * s2 + 4], sc[cb][kk][8 * s2 + 5]); w0.w = cvt_pk_bf16(sc[cb][kk][8 * s2 + 6], sc[cb][kk][8 * s2 + 7]);
                            pf[cb][kk][s2] = __builtin_bit_cast(bf16x8, w0);
                        }
                }
#pragma unroll
                for (int db = 0; db < 2; ++db)
#pragma unroll
                    for (int kbk = 0; kbk < 2; ++kbk)
#pragma unroll
                        for (int s2 = 0; s2 < 2; ++s2) {
                            const LAS bf16_t* vp = Vs + (kbk * 32 + 16 * s2 + 4 * lh + q4) * 72 + 32 * db + 16 * blk + 4 * p4;
                            const bf16x8 vf = tr8(vp, vp + 8 * 72);
                            ot[db][0] = mfma32(vf, pf[0][kbk][s2], ot[db][0]);
                            ot[db][1] = mfma32(vf, pf[1][kbk][s2], ot[db][1]);
                        }
            }
}
__device__ __forceinline__ void attn_phase(LAS unsigned char* lds, const bf16_t* qb, const bf16_t* kb, const bf16_t* vb, const bf16_t* ck, const bf16_t* cv, bf16_t* ob, const float* sink, const int wv) {
    LAS bf16_t* Ks = (LAS bf16_t*)lds; LAS bf16_t* Vs = (LAS bf16_t*)(lds + 9216);
    const int wid = wv, lane = lane_id_v(), tid = wid * 64 + lane, g = wid >> 1, qh = wid & 1;
    const int l31 = lane & 31, lh = lane >> 5, q4 = (lane & 15) >> 2, p4 = lane & 3, blk = (lane >> 4) & 1;
    const int skey = tid >> 3, sdc = tid & 7;
    for (int it = bid_s(); it < 1152; it += gridDim.x) {
        int b, hk, seqrow0, T, qbase, nlat, latk0, nctx; bool masked;
        if (it < 1024) { b = it >> 7; const int n = (it >> 2) & 31; hk = it & 3; seqrow0 = NPROMPT + b * 4096; T = 4096; qbase = n * 128; nlat = 6; latk0 = qbase - 128; nctx = 8; masked = true; }
        else { const int i2 = it - 1024; b = i2 >> 3; hk = (i2 >> 1) & 3; seqrow0 = b * 256; T = 256; qbase = (i2 & 1) * 128; nlat = 4; latk0 = 0; nctx = 0; masked = false; }
        const int h = hk * 4 + g, qpos0 = qbase + 64 * qh, ntiles = nlat + nctx;
        bf16x8 Qf[2][4];
#pragma unroll
        for (int cb = 0; cb < 2; ++cb)
#pragma unroll
            for (int s = 0; s < 4; ++s) Qf[cb][s] = *(const bf16x8*)(qb + (size_t)(seqrow0 + qpos0 + cb * 32 + l31) * 1024 + h * 64 + 16 * s + 8 * lh);
        float mrun[2], lrun[2]; f32x16 ot[2][2];
        const float sk = sink[h] * LOG2E;
        mrun[0] = sk; mrun[1] = sk; lrun[0] = lh == 0 ? 1.f : 0.f; lrun[1] = lrun[0];
#pragma unroll
        for (int i = 0; i < 2; ++i)
#pragma unroll
            for (int j = 0; j < 2; ++j)
#pragma unroll
                for (int r = 0; r < 16; ++r) ot[i][j][r] = 0.f;
        int ti = 0; while (ti < nlat && latk0 + 64 * ti < 0) ++ti;
        u32x4 kr0, vr0, kr1, vr1;
#define ATT_NEXT(tt) (((tt) + 1 < nlat && latk0 + 64 * ((tt) + 1) >= T) ? nlat : (tt) + 1)
#define ATT_LD(tt, KR, VR) do { const bf16_t *kp_, *vp_; if ((tt) < nlat) { const size_t o_ = (size_t)(seqrow0 + latk0 + 64 * (tt) + skey) * 256 + hk * 64 + sdc * 8; kp_ = kb + o_; vp_ = vb + o_; } \
            else { const size_t o_ = ((size_t)b * 1024 + 64 * ((tt) - nlat) + skey) * 256 + hk * 64 + sdc * 8; kp_ = ck + o_; vp_ = cv + o_; } KR = *(const u32x4*)kp_; VR = *(const u32x4*)vp_; } while (0)
#define ATT_FLAGS(cur_, SK, NM, KP) const bool SK##l_ = (cur_) < nlat; const int KP = latk0 + 64 * (cur_); bool SK = false, NM = false; \
            if (masked && SK##l_) { SK = (KP > qpos0 + 63 + 128) || (KP + 63 < qpos0 - 128); NM = (KP < qpos0 - 64) || (KP > qpos0 + 64); }
        int tp = ti, tq = ATT_NEXT(tp);
        ATT_LD(tp, kr0, vr0); ATT_LD(tq, kr1, vr1);
        while (tp < ntiles) {
            __syncthreads();
            *(LAS u32x4*)(Ks + skey * 72 + sdc * 8) = kr0; *(LAS u32x4*)(Vs + skey * 72 + sdc * 8) = vr0;
            *(LAS u32x4*)(Ks + 9216 + skey * 72 + sdc * 8) = kr1; *(LAS u32x4*)(Vs + 9216 + skey * 72 + sdc * 8) = vr1;
            __syncthreads();
            const int c0 = tp, c1 = tq;
            tp = ATT_NEXT(tq); tq = ATT_NEXT(tp);
            if (tp < ntiles) { ATT_LD(tp, kr0, vr0); ATT_LD(tq, kr1, vr1); }
            { ATT_FLAGS(c0, sk0, nm0, kp0) att_tile(Ks, Vs, Qf, ot, mrun, lrun, sk0, nm0, kp0, qpos0, l31, lh, q4, p4, blk); }
            { ATT_FLAGS(c1, sk1, nm1, kp1) att_tile(Ks + 9216, Vs + 9216, Qf, ot, mrun, lrun, sk1, nm1, kp1, qpos0, l31, lh, q4, p4, blk); }
        }
#undef ATT_NEXT
#undef ATT_LD
#undef ATT_FLAGS
#pragma unroll
        for (int cb = 0; cb < 2; ++cb) {
            const float lt = lrun[cb] + __shfl_xor(lrun[cb], 32), inv = 1.f / lt;
            bf16_t* orow = ob + (size_t)(seqrow0 + qpos0 + cb * 32 + l31) * 1024 + h * 64;
#pragma unroll
            for (int db = 0; db < 2; ++db)
#pragma unroll
                for (int rg = 0; rg < 4; ++rg) { const f32x4 v = {ot[db][cb][4 * rg] * inv, ot[db][cb][4 * rg + 1] * inv, ot[db][cb][4 * rg + 2] * inv, ot[db][cb][4 * rg + 3] * inv};
                    st4(orow + db * 32 + 8 * rg + 4 * lh, v); }
        }
    }
}

__device__ __forceinline__ void ret_scan_phase(LAS unsigned char* lds, const bf16_t* qb, const bf16_t* kb, const bf16_t* vb, bf16_t* ob, float* statp, const float* logdec, const float* state_in, float* state_out, const int wv) {
    constexpr int QST = 264, VST = 72;
    LAS bf16_t* Qs = (LAS bf16_t*)lds; LAS bf16_t* Ks = (LAS bf16_t*)(lds + 33792); LAS bf16_t* ST = (LAS bf16_t*)(lds + 67584);
    LAS bf16_t* Vs0 = (LAS bf16_t*)(lds + 101376); LAS bf16_t* Vw = (LAS bf16_t*)(lds + 110592); LAS bf16_t* Ps = (LAS bf16_t*)(lds + 119808);
    const int w = wv, lane = lane_id_v(), tid = w * 64 + lane, c16 = lane & 15, g = lane >> 4, q4 = (lane & 15) >> 2, p4 = lane & 3;
    const int itl = w >> 1, eb = 2 * (w & 1);
    for (int rnd = 0; rnd < 3; ++rnd) {
        const int bid = bid_s(), xx = bid & 7, ss = bid >> 3;
        const bool samp = rnd == 0; const int gidx = (samp ? 0 : (rnd - 1) * 32) + xx * 4 + (ss >> 3); const int b = gidx >> 2, head = gidx & 3, sl = ss & 7;
        const int seqrow0 = samp ? NPROMPT + b * 4096 : b * 256, T = samp ? 4096 : 256, nc = T / 64;
        for (int dir = 0; dir < 2; ++dir) {
            const float lg2 = logdec[dir * 4 + head] * LOG2E;
            f32x4 sacc[2][4];
#pragma unroll
            for (int dd = 0; dd < 2; ++dd)
#pragma unroll
                for (int et = 0; et < 4; ++et)
#pragma unroll
                    for (int r = 0; r < 4; ++r)
                        sacc[dd][et][r] = samp ? state_in[((((size_t)b * 2 + dir) * 4 + head) * 256 + 32 * w + 16 * dd + 4 * g + r) * 512 + sl * 64 + 16 * et + c16] : 0.f;
            __syncthreads();
#pragma unroll
            for (int dd = 0; dd < 2; ++dd)
#pragma unroll
                for (int et = 0; et < 4; ++et) { u32x2 wv; wv.x = cvt_pk_bf16(sacc[dd][et][0], sacc[dd][et][1]); wv.y = cvt_pk_bf16(sacc[dd][et][2], sacc[dd][et][3]);
                    *(LAS u32x2*)(ST + (16 * et + c16) * QST + 32 * w + 16 * dd + 4 * g) = wv; }
            u32x4 qreg[4], kreg[4], vreg;
#define RET_LOAD(cc_) do { const int t0_ = 64 * (cc_); _Pragma("unroll") for (int p = 0; p < 4; ++p) { const int idx = tid + 512 * p, row = idx >> 5, ch = idx & 31; \
                const size_t o_ = (size_t)(seqrow0 + t0_ + row) * 1024 + head * 256 + ch * 8; qreg[p] = *(const u32x4*)(qb + o_); kreg[p] = *(const u32x4*)(kb + o_); } \
                vreg = *(const u32x4*)(vb + (size_t)(seqrow0 + t0_ + (tid >> 3)) * 2048 + head * 512 + sl * 64 + (tid & 7) * 8); } while (0)
            RET_LOAD(dir ? nc - 1 : 0);
            const float gC = fexp2(lg2 * 64.f);
            float dec[2][4];
#pragma unroll
            for (int x = 0; x < 2; ++x)
#pragma unroll
                for (int r = 0; r < 4; ++r) { const int i = itl * 16 + c16, j = (eb + x) * 16 + 4 * g + r; const int df = dir ? j - i : i - j; const bool ok = dir ? df > 0 : df >= 0; dec[x][r] = ok ? fexp2(lg2 * (float)df) : 0.f; }
            const float wq_c = fexp2(lg2 * (float)(dir ? 64 - (itl * 16 + c16) : (itl * 16 + c16) + 1));
            const float wsj_c = fexp2(lg2 * (float)(dir ? (tid >> 3) : 63 - (tid >> 3)));
            for (int cc = 0; cc < nc; ++cc) {
                const int c = dir ? nc - 1 - cc : cc, t0 = 64 * c;
                LAS bf16_t* Vs = Vs0 + (cc & 1) * 13824;
#pragma unroll
                for (int p = 0; p < 4; ++p) { const int idx = tid + 512 * p, row = idx >> 5, ch = idx & 31; *(LAS u32x4*)(Qs + row * QST + ch * 8) = qreg[p]; *(LAS u32x4*)(Ks + row * QST + ch * 8) = kreg[p]; }
                { const int row = tid >> 3, ch = tid & 7; *(LAS u32x4*)(Vs + row * VST + ch * 8) = vreg;
                  const float wsj = wsj_c; u32x4 sv;
                  sv.x = cvt_pk_bf16(bflo(vreg.x) * wsj, bfhi(vreg.x) * wsj); sv.y = cvt_pk_bf16(bflo(vreg.y) * wsj, bfhi(vreg.y) * wsj);
                  sv.z = cvt_pk_bf16(bflo(vreg.z) * wsj, bfhi(vreg.z) * wsj); sv.w = cvt_pk_bf16(bflo(vreg.w) * wsj, bfhi(vreg.w) * wsj);
                  *(LAS u32x4*)(Vw + row * VST + ch * 8) = sv; }
                __syncthreads();
                if (cc + 1 < nc) RET_LOAD(dir ? nc - 2 - cc : cc + 1);
                const int orow = seqrow0 + t0 + itl * 16 + c16; bf16_t* op = ob + (size_t)orow * 2048 + head * 512 + sl * 64 + 4 * g;
                u32x2 pw0 = {0u, 0u}, pw1 = {0u, 0u};
                if (dir) { pw0 = *(const u32x2*)(op + eb * 16); pw1 = *(const u32x2*)(op + (eb + 1) * 16); }
                bf16x8 qf[8];
#pragma unroll
                for (int ks = 0; ks < 8; ++ks) qf[ks] = *(const LAS bf16x8*)(Qs + (itl * 16 + c16) * QST + 32 * ks + 8 * g);
#pragma unroll
                for (int x = 0; x < 2; ++x) {
                    const int jt = eb + x; f32x4 pt = {0.f, 0.f, 0.f, 0.f};
#pragma unroll
                    for (int ks = 0; ks < 8; ++ks) pt = mfma16(*(const LAS bf16x8*)(Ks + (jt * 16 + c16) * QST + 32 * ks + 8 * g), qf[ks], pt);
                    const int i = itl * 16 + c16; f32x4 pv;
#pragma unroll
                    for (int r = 0; r < 4; ++r) pv[r] = pt[r] * dec[x][r];
                    u32x2 wv; wv.x = cvt_pk_bf16(pv[0], pv[1]); wv.y = cvt_pk_bf16(pv[2], pv[3]);
                    *(LAS u32x2*)(Ps + i * VST + jt * 16 + 4 * g) = wv;
                }
                f32x4 oc[2];
                { const float wq = wq_c;
#pragma unroll
                  for (int x = 0; x < 2; ++x) { const int et = eb + x; f32x4 o = {0.f, 0.f, 0.f, 0.f};
#pragma unroll
                      for (int ks = 0; ks < 8; ++ks) o = mfma16(*(const LAS bf16x8*)(ST + (et * 16 + c16) * QST + 32 * ks + 8 * g), qf[ks], o);
                      oc[x] = o * wq; } }
#pragma unroll
                for (int dd = 0; dd < 2; ++dd)
#pragma unroll
                    for (int et = 0; et < 4; ++et) sacc[dd][et] = sacc[dd][et] * gC;
#pragma unroll
                for (int ks = 0; ks < 2; ++ks) {
                    bf16x8 bfr[4];
#pragma unroll
                    for (int et = 0; et < 4; ++et) { const LAS bf16_t* vp = Vw + (32 * ks + 8 * g + q4) * VST + 16 * et + 4 * p4; bfr[et] = tr8(vp, vp + 4 * VST); }
#pragma unroll
                    for (int dd = 0; dd < 2; ++dd) { const LAS bf16_t* kp = Ks + (32 * ks + 8 * g + q4) * QST + 32 * w + 16 * dd + 4 * p4; const bf16x8 af = tr8(kp, kp + 4 * QST);
#pragma unroll
                        for (int et = 0; et < 4; ++et) sacc[dd][et] = mfma16(af, bfr[et], sacc[dd][et]); }
                }
                __syncthreads();
#pragma unroll
                for (int x = 0; x < 2; ++x) { const int et = eb + x;
#pragma unroll
                    for (int ks = 0; ks < 2; ++ks) { const LAS bf16_t* vp = Vs + (32 * ks + 8 * g + q4) * VST + 16 * et + 4 * p4;
                        oc[x] = mfma16(tr8(vp, vp + 4 * VST), *(const LAS bf16x8*)(Ps + (itl * 16 + c16) * VST + 32 * ks + 8 * g), oc[x]); } }
                { const int row = orow;
                  if (dir == 0) { st4(op + eb * 16, oc[0]); st4(op + (eb + 1) * 16, oc[1]); }
                  else { float s1 = 0.f, s2 = 0.f;
#pragma unroll
                      for (int x = 0; x < 2; ++x) { bf16_t* o2 = op + (eb + x) * 16; const u32x2 pw = x ? pw1 : pw0; f32x4 f = oc[x];
                          f[0] += bflo(pw.x); f[1] += bfhi(pw.x); f[2] += bflo(pw.y); f[3] += bfhi(pw.y); st4(o2, f);
                          s1 += f[0] + f[1] + f[2] + f[3]; s2 += f[0] * f[0] + f[1] * f[1] + f[2] * f[2] + f[3] * f[3]; }
                      s1 += __shfl_xor(s1, 16); s1 += __shfl_xor(s1, 32); s2 += __shfl_xor(s2, 16); s2 += __shfl_xor(s2, 32);
                      if (g == 0) *(f32x2*)(statp + (((size_t)row * 4 + head) * 16 + sl * 2 + (w & 1)) * 2) = (f32x2){s1, s2}; } }
#pragma unroll
                for (int dd = 0; dd < 2; ++dd)
#pragma unroll
                    for (int et = 0; et < 4; ++et) { u32x2 wv; wv.x = cvt_pk_bf16(sacc[dd][et][0], sacc[dd][et][1]); wv.y = cvt_pk_bf16(sacc[dd][et][2], sacc[dd][et][3]);
                        *(LAS u32x2*)(ST + (16 * et + c16) * QST + 32 * w + 16 * dd + 4 * g) = wv; }
            }
#undef RET_LOAD
            if (!samp) {
#pragma unroll
                for (int dd = 0; dd < 2; ++dd)
#pragma unroll
                    for (int et = 0; et < 4; ++et)
#pragma unroll
                        for (int r = 0; r < 4; ++r)
                            state_out[((((size_t)b * 2 + dir) * 4 + head) * 256 + 32 * w + 16 * dd + 4 * g + r) * 512 + sl * 64 + 16 * et + c16] = sacc[dd][et][r];
            }
        }
    }
}
__device__ __forceinline__ void ret_fin_phase(const float* statp, float* fin, const int wv) {
    for (int i = bid_s() * 512 + (wv * 64 + lane_id_v()); i < MTOK * 4; i += gridDim.x * 512) {
        float s1 = 0.f, s2 = 0.f;
#pragma unroll
        for (int p = 0; p < 16; ++p) { const f32x2 v = *(const f32x2*)(statp + ((size_t)i * 16 + p) * 2); s1 += v.x; s2 += v.y; }
        const float mu = s1 * (1.f / 512.f), var = fmaxf(s2 * (1.f / 512.f) - mu * mu, 0.f);
        *(f32x2*)(fin + (size_t)i * 2) = (f32x2){mu, rsqrtf(var + 1e-6f)};
    }
}

__device__ __forceinline__ void lru_conv_phase(const bf16_t* xr, bf16_t* xc, const float* cw, const float* cbias, const int wv) {
    for (size_t i = (size_t)bid_s() * 512 + (wv * 64 + lane_id_v()); i < (size_t)MTOK * 128; i += (size_t)gridDim.x * 512) {
        const int r = (int)(i >> 7), c8 = (int)(i & 127) * 8;
        const int t = r < NPROMPT ? (r & 255) : ((r - NPROMPT) & 4095), T = r < NPROMPT ? 256 : 4096;
        float acc[8];
        { const f32x4 b0 = *(const f32x4*)(cbias + c8), b1 = *(const f32x4*)(cbias + c8 + 4); acc[0] = b0[0]; acc[1] = b0[1]; acc[2] = b0[2]; acc[3] = b0[3]; acc[4] = b1[0]; acc[5] = b1[1]; acc[6] = b1[2]; acc[7] = b1[3]; }
#pragma unroll
        for (int jj = 0; jj < 4; ++jj) { const int tt = t - 2 + jj;
            if (tt >= 0 && tt < T) { const u32x4 xw = *(const u32x4*)(xr + (size_t)(r - 2 + jj) * 1024 + c8); const f32x4 w0 = *(const f32x4*)(cw + jj * 1024 + c8), w1 = *(const f32x4*)(cw + jj * 1024 + c8 + 4);
                acc[0] += w0[0] * bflo(xw.x); acc[1] += w0[1] * bfhi(xw.x); acc[2] += w0[2] * bflo(xw.y); acc[3] += w0[3] * bfhi(xw.y);
                acc[4] += w1[0] * bflo(xw.z); acc[5] += w1[1] * bfhi(xw.z); acc[6] += w1[2] * bflo(xw.w); acc[7] += w1[3] * bfhi(xw.w); } }
        u32x4 o; o.x = cvt_pk_bf16(acc[0], acc[1]); o.y = cvt_pk_bf16(acc[2], acc[3]); o.z = cvt_pk_bf16(acc[4], acc[5]); o.w = cvt_pk_bf16(acc[6], acc[7]);
        *(u32x4*)(xc + (size_t)r * 1024 + c8) = o;
    }
}
__device__ __forceinline__ void lru_scanA_phase(const bf16_t* __restrict__ la, const bf16_t* __restrict__ uu, float* __restrict__ agg, const int wv) {
    constexpr int NS = 8 * 2 * 32 * 512, NP = 16 * 2 * 2 * 512;
    for (int idx = bid_s() * 512 + (wv * 64 + lane_id_v()); idx < NS + NP; idx += gridDim.x * 512) {
        int cp, dir, row0, segidx;
        if (idx < NS) { cp = idx & 511; const int seg = (idx >> 9) & 31; dir = (idx >> 14) & 1; const int b = idx >> 15; row0 = NPROMPT + b * 4096 + seg * 128; segidx = (b * 2 + dir) * 32 + seg; }
        else { const int i2 = idx - NS; cp = i2 & 511; const int seg = (i2 >> 9) & 1; dir = (i2 >> 10) & 1; const int b = i2 >> 11; row0 = b * 256 + seg * 128; segidx = 512 + (b * 2 + dir) * 2 + seg; }
        float L0 = 0.f, L1 = 0.f, H0 = 0.f, H1 = 0.f;
        for (int s0 = 0; s0 < 128; s0 += 16) {
            unsigned lw[16], uw[16];
#pragma unroll
            for (int j = 0; j < 16; ++j) { const int r = row0 + (dir ? 127 - (s0 + j) : s0 + j); const size_t o = ((size_t)r * 2 + dir) * 1024 + 2 * cp; lw[j] = *(const unsigned*)(la + o); uw[j] = *(const unsigned*)(uu + o); }
#pragma unroll
            for (int j = 0; j < 16; ++j) { const float l0 = bflo(lw[j]), l1 = bfhi(lw[j]); H0 = __expf(l0) * H0 + bflo(uw[j]); H1 = __expf(l1) * H1 + bfhi(uw[j]); L0 += l0; L1 += l1; }
        }
        *(f32x4*)(agg + ((size_t)segidx * 1024 + 2 * cp) * 2) = (f32x4){L0, H0, L1, H1};
    }
}
__device__ __forceinline__ void lru_scanC_phase(const bf16_t* __restrict__ la, const bf16_t* __restrict__ uu, const float* __restrict__ agg, bf16_t* __restrict__ rec, const float* __restrict__ st_in, float* __restrict__ st_out, const int wv) {
    constexpr int NS = 8 * 32 * 512, NP = 16 * 2 * 512;
    for (int idx = bid_s() * 512 + (wv * 64 + lane_id_v()); idx < NS + NP; idx += gridDim.x * 512) {
        int cp, seg, b, row0, nseg, segb; const bool samp = idx < NS;
        if (samp) { cp = idx & 511; seg = (idx >> 9) & 31; b = idx >> 14; row0 = NPROMPT + b * 4096 + seg * 128; nseg = 32; segb = b * 64; }
        else { const int i2 = idx - NS; cp = i2 & 511; seg = (i2 >> 9) & 1; b = i2 >> 10; row0 = b * 256 + seg * 128; nseg = 2; segb = 512 + b * 4; }
        float h0 = 0.f, h1 = 0.f;
        if (samp) { const f32x2 v = *(const f32x2*)(st_in + (b * 2 + 0) * 1024 + 2 * cp); h0 = v.x; h1 = v.y; }
        for (int s2 = 0; s2 < seg; ++s2) { const f32x4 v = *(const f32x4*)(agg + ((size_t)(segb + s2) * 1024 + 2 * cp) * 2); h0 = __expf(v[0]) * h0 + v[1]; h1 = __expf(v[2]) * h1 + v[3]; }
        for (int s0 = 0; s0 < 128; s0 += 16) {
            unsigned lw[16], uw[16];
#pragma unroll
            for (int j = 0; j < 16; ++j) { const size_t o = ((size_t)(row0 + s0 + j) * 2 + 0) * 1024 + 2 * cp; lw[j] = *(const unsigned*)(la + o); uw[j] = *(const unsigned*)(uu + o); }
#pragma unroll
            for (int j = 0; j < 16; ++j) { h0 = __expf(bflo(lw[j])) * h0 + bflo(uw[j]); h1 = __expf(bfhi(lw[j])) * h1 + bfhi(uw[j]); *(unsigned*)(rec + (size_t)(row0 + s0 + j) * 1024 + 2 * cp) = cvt_pk_bf16(h0, h1); }
        }
        if (!samp && seg == nseg - 1) *(f32x2*)(st_out + (b * 2 + 0) * 1024 + 2 * cp) = (f32x2){h0, h1};
        h0 = 0.f; h1 = 0.f;
        if (samp) { const f32x2 v = *(const f32x2*)(st_in + (b * 2 + 1) * 1024 + 2 * cp); h0 = v.x; h1 = v.y; }
        for (int s2 = nseg - 1; s2 > seg; --s2) { const f32x4 v = *(const f32x4*)(agg + ((size_t)(segb + nseg + s2) * 1024 + 2 * cp) * 2); h0 = __expf(v[0]) * h0 + v[1]; h1 = __expf(v[2]) * h1 + v[3]; }
        for (int s0 = 0; s0 < 128; s0 += 16) {
            unsigned lw[16], uw[16], rw[16];
#pragma unroll
            for (int j = 0; j < 16; ++j) { const int r = row0 + 127 - (s0 + j); const size_t o = ((size_t)r * 2 + 1) * 1024 + 2 * cp; lw[j] = *(const unsigned*)(la + o); uw[j] = *(const unsigned*)(uu + o); rw[j] = *(const unsigned*)(rec + (size_t)r * 1024 + 2 * cp); }
#pragma unroll
            for (int j = 0; j < 16; ++j) { const int r = row0 + 127 - (s0 + j); h0 = __expf(bflo(lw[j])) * h0 + bflo(uw[j]); h1 = __expf(bfhi(lw[j])) * h1 + bfhi(uw[j]);
                *(unsigned*)(rec + (size_t)r * 1024 + 2 * cp) = cvt_pk_bf16(bflo(rw[j]) + h0, bfhi(rw[j]) + h1); }
        }
        if (!samp && seg == 0) *(f32x2*)(st_out + (b * 2 + 1) * 1024 + 2 * cp) = (f32x2){h0, h1};
    }
}

#ifndef REP_BAR
#define REP_BAR 1
#endif
#ifndef REP_ATT
#define REP_ATT 1
#endif
#ifndef REP_RET
#define REP_RET 1
#endif
#ifndef REP_LRU
#define REP_LRU 1
#endif
#ifndef REP_UP
#define REP_UP 1
#endif
#ifndef REP_NORM
#define REP_NORM 1
#endif
__device__ __forceinline__ int opq(int n) { asm volatile("" : "+s"(n)); return n; }
constexpr int LDS_BYTES = 147456;
constexpr size_t WS_BAR = 4096;
#define XB_TMO      128
#define XB_XCNT(j)  (256  + 64 * (j))
#define XB_XSUB(j)  (1280 + 64 * (j))
#define XB_XGEN(j)  (2304 + 64 * (j))
#define XB_TOP      3328
#define XB_TOPGEN   3392
#define XCD_BAR_WORDS 3456
#define XB_SPIN_CAP (1u << 22)
__device__ __forceinline__ unsigned xb_ld(unsigned* p)              { return __hip_atomic_load(p, __ATOMIC_RELAXED, __HIP_MEMORY_SCOPE_AGENT); }
__device__ __forceinline__ unsigned xb_add(unsigned* p, unsigned v) { return __hip_atomic_fetch_add(p, v, __ATOMIC_RELAXED, __HIP_MEMORY_SCOPE_AGENT); }
__device__ __forceinline__ unsigned xb_xcc_id() { return (unsigned)__builtin_amdgcn_s_getreg((3 << 11) | 20) & 0xFu; }
#define XB_SPIN(cond, bar) do { unsigned _sp = 0; while (cond) { __builtin_amdgcn_s_sleep(1); \
    if ((++_sp & 255u) == 0u) { if (xb_ld(&(bar)[XB_TMO])) break; if (_sp > XB_SPIN_CAP) { atomicAdd(&(bar)[XB_TMO], 1u); break; } } } } while (0)
__device__ __forceinline__ void xcd_barrier_complete(unsigned* bar, unsigned x, unsigned& nloc, unsigned& nx) {
    const unsigned G = gridDim.x;
    unsigned sum, cnt, mine, sp = 0u;
    for (;;) {
        sum = 0u; cnt = 0u; mine = 0u;
#pragma unroll
        for (unsigned j = 0; j < 16; ++j) { const unsigned c = xb_ld(&bar[XB_XCNT(j)]); sum += c; cnt += (c > 0u) ? 1u : 0u; mine = (j == x) ? c : mine; }
        if (sum == G) break;
        __builtin_amdgcn_s_sleep(1);
        if ((++sp & 255u) == 0u) { if (xb_ld(&bar[XB_TMO])) break; if (sp > XB_SPIN_CAP) { atomicAdd(&bar[XB_TMO], 1u); break; } }
    }
    nloc = mine > 0u ? mine : 1u; nx = cnt > 0u ? cnt : 1u;
}
__device__ __forceinline__ void gbar(unsigned* bar, volatile LAS unsigned* st, const int wv) {
    asm volatile("s_waitcnt vmcnt(0) lgkmcnt(0)" ::: "memory");
    __syncthreads();
    if (wv == 0) {
      if (lane_id_v() == 0) {
        const unsigned x = xb_xcc_id();
        unsigned nloc = st[0], nx = st[1];
        if (nloc == 0u) { xcd_barrier_complete(bar, x, nloc, nx); st[0] = nloc; st[1] = nx; }
        const unsigned old = xb_add(&bar[XB_XSUB(x)], 1u);
        const unsigned gen = old / nloc;
        if (old + 1u == (gen + 1u) * nloc) {
            __builtin_amdgcn_fence(__ATOMIC_RELEASE, "agent");
            asm volatile("s_waitcnt vmcnt(0)" ::: "memory");
            const unsigned og = xb_add(&bar[XB_TOP], 1u);
            const unsigned tg = og / nx;
            if (og + 1u == (tg + 1u) * nx) xb_add(&bar[XB_TOPGEN], 1u);
            else XB_SPIN(xb_ld(&bar[XB_TOPGEN]) == tg, bar);
            __builtin_amdgcn_fence(__ATOMIC_ACQUIRE, "agent");
            xb_add(&bar[XB_XGEN(x)], 1u);
            asm volatile("s_waitcnt vmcnt(0)" ::: "memory");
        } else {
            XB_SPIN(xb_ld(&bar[XB_XGEN(x)]) == gen, bar);
            __builtin_amdgcn_fence(__ATOMIC_ACQUIRE, "agent");
            asm volatile("s_waitcnt vmcnt(0)" ::: "memory");
        }
      }
    }
    __syncthreads();
}
__global__ void __launch_bounds__(512, 2) fwd_mega(KArgs a) {
    extern __shared__ __attribute__((aligned(16))) unsigned char lds_raw[];
    LAS unsigned char* lds = (LAS unsigned char*)lds_raw;
    cg::this_grid().sync();
    volatile LAS unsigned* bst = (volatile LAS unsigned*)(lds + 143360);
    if (wave_id_s() == 0 && lane_id_v() == 0) { bst[0] = 0u; bst[1] = 0u; const unsigned xc_ = xb_xcc_id();
        const unsigned slot_ = xb_add(&((unsigned*)(karg_ptr(264) + WS_BAR))[XB_XCNT(xc_)], 1u); bst[2] = blockIdx.x; bst[3] = (xc_ << 8) | slot_; }
    __syncthreads();
    const int wave = wave_id_s(), lane = 0, G = gridDim.x, gw = bid_s() * 8 + wave, NGW = G * 8;
#define ws karg_ptr(264)
#define XR ((float*)karg_ptr(256))
#define modt ((float*)(ws + WS_MOD))
#define hbuf ((bf16_t*)(ws + WS_H))
#define WUP ((bf16_t*)(ws + WS_WUP))
#define WDN ((bf16_t*)(ws + WS_WDN))
#define WIN ((bf16_t*)(ws + WS_WIN))
#define WOUT ((bf16_t*)(ws + WS_WOUT))
#define WX ((bf16_t*)(ws + WS_WX))
#define WX2 ((bf16_t*)(ws + WS_WX2))
    mod_phase(a, lds, wave); __syncthreads();
    cache_phase(a, wave);
    convert_layer_weights(a, ws, 0, lds, wave, lane, gw, NGW);
    if (bid_s() == 0 && wave == 0) { const int l_ = lane_id_v(); if (l_ < 32) ((const float**)ws)[l_] = a.in[l_]; }
    for (int rb_ = opq(REP_BAR); rb_ > 0; --rb_) gbar((unsigned*)(ws + WS_BAR), bst, wave);
    if (wave == 0 && lane_id_v() == 0) {
        unsigned* bar_ = (unsigned*)(ws + WS_BAR); bool ok_ = gridDim.x == 256;
        for (unsigned j = 0; j < 16; ++j) { const unsigned c_ = xb_ld(&bar_[XB_XCNT(j)]); ok_ = ok_ && (c_ == (j < 8 ? 32u : 0u)); }
        const unsigned v_ = bst[3]; if (ok_) bst[2] = (v_ & 255u) * 8u + (v_ >> 8);
    }
    __syncthreads();
#define tb (KTab{(const float* const*)ws})
    constexpr int KS = 1;
    for (int layer = 0; layer < 4; ++layer) {
        const int kind = layer % 3, slot = layer / 3;
#define modl (modt + (size_t)layer * 9 * 6144)
        pg8::StaticOrder S;
        if (layer == 0) norm_phase<true>(inp(tb, 0), inp(tb, 1), XR, inp(tb, 8), modl, 0, hbuf, lane, gw, NGW);
        else { norm_phase<false>(nullptr, nullptr, XR, inp(tb, 8) + layer * DM, modl, 0, hbuf, lane, gw, NGW, KS ? (const float*)(ws + WS_PART_M) : nullptr, modl - 9 * 6144 + 5 * 1024); __syncthreads(); convert_layer_weights(tb, ws, layer, lds, wave, lane, gw, NGW); }
        for (int rb_ = opq(REP_BAR); rb_ > 0; --rb_) gbar((unsigned*)(ws + WS_BAR), bst, wave);
        if (kind == 0) {
            bf16_t *q = (bf16_t*)(ws + WS_AQ), *k = (bf16_t*)(ws + WS_AK), *v = (bf16_t*)(ws + WS_AV), *o = (bf16_t*)(ws + WS_AO);
            { pg8::Gemm g{hbuf, WIN, MTOK, 1536, 1024, 1024, 1024, 31, 0}; S.init(MTOK, 1536, G, bid_s());
              pg8::EpiAttnQKV E{q, k, v, XR + OUT_K, XR + OUT_V, inp(tb, 16) + slot * 64, inp(tb, 17) + slot * 64, slot};
              pg8::gemm_phase(lds, g, S, E, wave); }
            for (int rb_ = opq(REP_BAR); rb_ > 0; --rb_) gbar((unsigned*)(ws + WS_BAR), bst, wave);
            for (int rp_ = opq(REP_ATT); rp_ > 0; --rp_) attn_phase(lds, q, k, v, (const bf16_t*)(ws + WS_CK) + (size_t)slot * 512 * 256, (const bf16_t*)(ws + WS_CV) + (size_t)slot * 512 * 256, o, inp(tb, 18) + slot * 16, wave);
            for (int rb_ = opq(REP_BAR); rb_ > 0; --rb_) gbar((unsigned*)(ws + WS_BAR), bst, wave);
            { pg8::Gemm g{o, WOUT, MTOK, 1024, 1024, 1024, 1024, 31, 0}; S.init(MTOK, 1024, G, bid_s(), KS); pg8::EpiResid E{XR, modl + 2 * 1024, (float*)(ws + WS_PART_A)}; pg8::gemm_phase(lds, g, S, E, wave); }
            for (int rb_ = opq(REP_BAR); rb_ > 0; --rb_) gbar((unsigned*)(ws + WS_BAR), bst, wave);
        } else if (kind == 1) {
            bf16_t *q = (bf16_t*)(ws + WS_RQ), *k = (bf16_t*)(ws + WS_RK), *v = (bf16_t*)(ws + WS_RV), *o = (bf16_t*)(ws + WS_RO);
            float* statp = (float*)(ws + WS_RSTP); float* fin = (float*)(ws + WS_RFIN);
            { pg8::Gemm g{hbuf, WIN, MTOK, 4096, 1024, 1024, 1024, 31, 0}; S.init(MTOK, 4096, G, bid_s()); pg8::EpiRetQKV E{q, k, v}; pg8::gemm_phase(lds, g, S, E, wave); }
            for (int rb_ = opq(REP_BAR); rb_ > 0; --rb_) gbar((unsigned*)(ws + WS_BAR), bst, wave);
            for (int rp_ = opq(REP_RET); rp_ > 0; --rp_) ret_scan_phase(lds, q, k, v, o, statp, inp(tb, 22) + slot * 8, inp(tb, 4), XR + OUT_RET, wave);
            for (int rb_ = opq(REP_BAR); rb_ > 0; --rb_) gbar((unsigned*)(ws + WS_BAR), bst, wave);
            bf16_t* h2 = (bf16_t*)(ws + WS_RQ);
            norm_phase<false>(nullptr, nullptr, XR, inp(tb, 8) + layer * DM, modl, 0, h2, lane, gw, NGW);
            ret_fin_phase(statp, fin, wave);
            for (int rb_ = opq(REP_BAR); rb_ > 0; --rb_) gbar((unsigned*)(ws + WS_BAR), bst, wave);
            { pg8::Gemm g{h2, WX, MTOK, 2048, 1024, 1024, 1024, 31, 0}; S.init(MTOK, 2048, G, bid_s()); pg8::EpiLateGate<0> E{o, 2048, fin, inp(tb, 21) + slot * 2048}; pg8::gemm_phase(lds, g, S, E, wave); }
            for (int rb_ = opq(REP_BAR); rb_ > 0; --rb_) gbar((unsigned*)(ws + WS_BAR), bst, wave);
            { pg8::Gemm g{o, WOUT, MTOK, 1024, 2048, 2048, 2048, 31, 0}; S.init(MTOK, 1024, G, bid_s(), KS); pg8::EpiResid E{XR, modl + 2 * 1024, (float*)(ws + WS_PART_R)}; pg8::gemm_phase(lds, g, S, E, wave); }
            for (int rb_ = opq(REP_BAR); rb_ > 0; --rb_) gbar((unsigned*)(ws + WS_BAR), bst, wave);
        } else {
            bf16_t *xr = (bf16_t*)(ws + WS_LXR), *xc = (bf16_t*)(ws + WS_LXC), *la = (bf16_t*)(ws + WS_LLA), *uu = (bf16_t*)(ws + WS_LU), *rec = (bf16_t*)(ws + WS_LREC);
            float* agg = (float*)(ws + WS_LAGG);
            { pg8::Gemm g{hbuf, WIN, MTOK, 1024, 1024, 1024, 1024, 31, 0}; S.init(MTOK, 1024, G, bid_s()); pg8::EpiStore<0> E{xr, 1024}; pg8::gemm_phase(lds, g, S, E, wave); }
            for (int rb_ = opq(REP_BAR); rb_ > 0; --rb_) gbar((unsigned*)(ws + WS_BAR), bst, wave);
            for (int rp_ = opq(REP_LRU); rp_ > 0; --rp_) lru_conv_phase(xr, xc, inp(tb, 24) + slot * 4096, inp(tb, 25) + slot * 1024, wave);
            for (int rb_ = opq(REP_BAR); rb_ > 0; --rb_) gbar((unsigned*)(ws + WS_BAR), bst, wave);
            { pg8::Gemm g{xc, WX2, MTOK, 4096, 128, 1024, 128, 1, 256}; S.init(MTOK, 4096, G, bid_s());
              pg8::EpiLruGates E{xc, la, uu, inp(tb, 27) + slot * 2048, inp(tb, 29) + slot * 2048, inp(tb, 30) + slot * 2048}; pg8::gemm_phase(lds, g, S, E, wave); }
            for (int rb_ = opq(REP_BAR); rb_ > 0; --rb_) gbar((unsigned*)(ws + WS_BAR), bst, wave);
            for (int rp_ = opq(REP_LRU); rp_ > 0; --rp_) lru_scanA_phase(la, uu, agg, wave);
            for (int rb_ = opq(REP_BAR); rb_ > 0; --rb_) gbar((unsigned*)(ws + WS_BAR), bst, wave);
            for (int rp_ = opq(REP_LRU); rp_ > 0; --rp_) lru_scanC_phase(la, uu, agg, rec, inp(tb, 5) + slot * 2048, XR + OUT_LRU, wave);
            for (int rb_ = opq(REP_BAR); rb_ > 0; --rb_) gbar((unsigned*)(ws + WS_BAR), bst, wave);
            { pg8::Gemm g{hbuf, WX, MTOK, 1024, 1024, 1024, 1024, 31, 0}; S.init(MTOK, 1024, G, bid_s()); pg8::EpiLateGate<1> E{rec, 1024, nullptr, nullptr}; pg8::gemm_phase(lds, g, S, E, wave); }
            for (int rb_ = opq(REP_BAR); rb_ > 0; --rb_) gbar((unsigned*)(ws + WS_BAR), bst, wave);
            { pg8::Gemm g{rec, WOUT, MTOK, 1024, 1024, 1024, 1024, 31, 0}; S.init(MTOK, 1024, G, bid_s(), KS); pg8::EpiResid E{XR, modl + 2 * 1024, (float*)(ws + WS_PART_L)}; pg8::gemm_phase(lds, g, S, E, wave); }
            for (int rb_ = opq(REP_BAR); rb_ > 0; --rb_) gbar((unsigned*)(ws + WS_BAR), bst, wave);
        }
        norm_phase<false>(nullptr, nullptr, XR, inp(tb, 9) + layer * DM, modl, 3, hbuf, lane, gw, NGW, KS ? (const float*)(ws + (kind == 0 ? WS_PART_A : kind == 1 ? WS_PART_R : WS_PART_L)) : nullptr, modl + 2 * 1024);
        for (int rb_ = opq(REP_BAR); rb_ > 0; --rb_) gbar((unsigned*)(ws + WS_BAR), bst, wave);
        bf16_t* hid = (bf16_t*)(ws + WS_HID);
        for (int rp_ = opq(REP_UP); rp_ > 0; --rp_) { pg8::Gemm g{hbuf, WUP, MTOK, 4096, 1024, 1024, 1024, 31, 0}; S.init(MTOK, 4096, G, bid_s()); pg8::EpiStore<2> E{hid, 4096}; pg8::gemm_phase(lds, g, S, E, wave); }
        for (int rb_ = opq(REP_BAR); rb_ > 0; --rb_) gbar((unsigned*)(ws + WS_BAR), bst, wave);
        { pg8::Gemm g{hid, WDN, MTOK, 1024, 4096, 4096, 4096, 31, 0}; S.init(MTOK, 1024, G, bid_s(), KS); pg8::EpiResid E{XR, modl + 5 * 1024, (float*)(ws + WS_PART_M)}; pg8::gemm_phase(lds, g, S, E, wave); }
        for (int rb_ = opq(REP_BAR); rb_ > 0; --rb_) gbar((unsigned*)(ws + WS_BAR), bst, wave);
    }
    if (KS) {
        const int layer = 3; const float* gate = modl + 5 * 1024; const float* part = (const float*)(ws + WS_PART_M); float* xo = XR;
        const int l_ = lane_id_v();
        for (int r = 32768 + gw; r < MTOK; r += NGW) { const float* gp = gate + (size_t)modidx(r) * 6144;
#pragma unroll
            for (int j = 0; j < 4; ++j) { const int c = 4 * l_ + 256 * j; const float* pp = part + (size_t)(r - 32768) * DM + c;
                const f32x4 ps = ((*(const f32x4*)pp + *(const f32x4*)(pp + (size_t)4096 * DM)) + *(const f32x4*)(pp + (size_t)2 * 4096 * DM)) + *(const f32x4*)(pp + (size_t)3 * 4096 * DM);
                f32x4* xp = (f32x4*)(xo + (size_t)r * DM + c); *xp = *xp + *(const f32x4*)(gp + c) * ps; } }
    }
}

#undef ws
#undef XR
#undef modt
#undef hbuf
#undef WUP
#undef WDN
#undef WIN
#undef WOUT
#undef WX
#undef WX2
#undef modl
#undef tb
extern "C" void kernel_launch(void* const* d_in, const int* in_sizes, int n_in, void* d_out, int out_size, void* d_ws, size_t ws_size, hipStream_t stream) {
    static int grid = 0;
    if (grid == 0) {
        int dev = 0, cus = 0, per_cu = 0;
        hipGetDevice(&dev); hipDeviceGetAttribute(&cus, hipDeviceAttributeMultiprocessorCount, dev);
        if (hipFuncSetAttribute((const void*)fwd_mega, hipFuncAttributeMaxDynamicSharedMemorySize, LDS_BYTES) != hipSuccess) { fprintf(stderr, "hipFuncSetAttribute failed\n"); grid = -1; return; }
        if (hipOccupancyMaxActiveBlocksPerMultiprocessor(&per_cu, (const void*)fwd_mega, 512, LDS_BYTES) != hipSuccess || per_cu < 1) { fprintf(stderr, "occupancy query: %d\n", per_cu); per_cu = 1; }
        (void)hipGetLastError();
        grid = cus * per_cu;
        if (grid != 256) { fprintf(stderr, "kernel_launch: this build needs exactly 256 resident workgroups (got %d)\n", grid); grid = -1; return; }
        if (n_in != 32 || ws_size < 512 * MiB) { fprintf(stderr, "kernel_launch: unexpected n_in %d / ws %zu\n", n_in, ws_size); grid = -1; return; }
    }
    if (grid < 0) return;
    KArgs a{};
    for (int i = 0; i < 32; ++i) a.in[i] = (const float*)d_in[i];
    a.out = (float*)d_out; a.ws = (unsigned char*)d_ws;
    if (hipMemsetAsync((char*)d_ws + WS_BAR, 0, 16384, stream) != hipSuccess) { fprintf(stderr, "memset failed\n"); return; }
    void* args[] = {&a};
    hipError_t e = hipLaunchCooperativeKernel((const void*)fwd_mega, dim3(grid), dim3(512), args, LDS_BYTES, stream);
    if (e != hipSuccess) fprintf(stderr, "cooperative launch failed: %s (grid %d)\n", hipGetErrorString(e), grid);
}
```

```cpp
#include <hip/hip_runtime.h>
#include <hip/hip_cooperative_groups.h>
#include <cstdio>
#include <cstdint>
namespace cg = cooperative_groups;

#define LAS __attribute__((address_space(3)))
typedef unsigned short bf16_t;
typedef short bf16x8 __attribute__((ext_vector_type(8)));
typedef short s16x4 __attribute__((ext_vector_type(4)));
typedef float f32x4 __attribute__((ext_vector_type(4)));
typedef float f32x2 __attribute__((ext_vector_type(2)));
typedef float f32x16 __attribute__((ext_vector_type(16)));
typedef unsigned u32x4 __attribute__((ext_vector_type(4)));
typedef unsigned u32x2 __attribute__((ext_vector_type(2)));

#define LOG2E 1.4426950408889634f
constexpr int DM = 1024, NPROMPT = 4096, MTOK = 36864, DFF = 4096;
constexpr size_t MiB = 1u << 20;
constexpr size_t WS_MOD = 1 * MiB;
constexpr size_t WS_WUP = 2 * MiB, WS_WDN = 10 * MiB, WS_WIN = 18 * MiB, WS_WOUT = 26 * MiB, WS_WX = 30 * MiB, WS_WX2 = 32 * MiB;
constexpr size_t WS_CK = 34 * MiB, WS_CV = 38 * MiB;
constexpr size_t WS_A = 44 * MiB;
constexpr size_t WS_H = 440 * MiB;
constexpr size_t WS_AQ = 44 * MiB, WS_AK = 116 * MiB, WS_AV = 134 * MiB, WS_AO = 152 * MiB;
constexpr size_t WS_RQ = 44 * MiB, WS_RK = 116 * MiB, WS_RV = 188 * MiB, WS_RO = 332 * MiB, WS_RSTP = 476 * MiB, WS_RFIN = 494 * MiB;
constexpr size_t WS_LXR = 368 * MiB, WS_LXC = 44 * MiB, WS_LLA = 116 * MiB, WS_LU = 260 * MiB, WS_LAGG = 404 * MiB, WS_LREC = 44 * MiB;
constexpr size_t WS_HID = 44 * MiB;
constexpr size_t WS_PART_A = 224 * MiB, WS_PART_R = 44 * MiB, WS_PART_L = 116 * MiB, WS_PART_M = 332 * MiB;
constexpr size_t OUT_K = 37748736, OUT_V = 39845888, OUT_RET = 41943040, OUT_LRU = 58720256;

__device__ __forceinline__ unsigned cvt_pk_bf16(float lo, float hi) { unsigned r; asm volatile("v_cvt_pk_bf16_f32 %0, %1, %2" : "=v"(r) : "v"(lo), "v"(hi)); return r; }
__device__ __forceinline__ float bf2f(unsigned short b) { return __uint_as_float((unsigned)b << 16); }
__device__ __forceinline__ float bflo(unsigned w) { return __uint_as_float(w << 16); }
__device__ __forceinline__ float bfhi(unsigned w) { return __uint_as_float(w & 0xffff0000u); }
__device__ __forceinline__ float fsigmoid(float x) { return __builtin_amdgcn_rcpf(1.f + __expf(-x)); }
__device__ __forceinline__ float fsilu(float x) { return x * fsigmoid(x); }
__device__ __forceinline__ float fgelu_tanh(float x) { const float u = 0.7978845608028654f * (x + 0.044715f * x * x * x); return x * fsigmoid(2.f * u); }
__device__ __forceinline__ int launder(int v) { asm volatile("" : "+v"(v)); return v; }
__device__ __forceinline__ int lane_id_v() { int l; asm volatile("v_mbcnt_lo_u32_b32 %0, -1, 0\n\tv_mbcnt_hi_u32_b32 %0, -1, %0" : "=v"(l)); return l; }
__device__ __forceinline__ int bid_s() { const int b = *(volatile LAS int*)(uintptr_t)143368u; return __builtin_amdgcn_readfirstlane(b); }
__device__ __forceinline__ int wave_id_s() { return __builtin_amdgcn_readfirstlane(__builtin_amdgcn_workitem_id_x() >> 6); }
__device__ __forceinline__ unsigned char* karg_ptr(int off) {
#if defined(__HIP_DEVICE_COMPILE__)
    unsigned long long v; auto ka = __builtin_amdgcn_kernarg_segment_ptr();
    if (off == 256) asm volatile("s_load_dwordx2 %0, %1, 0x100\n\ts_waitcnt lgkmcnt(0)" : "=s"(v) : "s"(ka));
    else asm volatile("s_load_dwordx2 %0, %1, 0x108\n\ts_waitcnt lgkmcnt(0)" : "=s"(v) : "s"(ka));
    return (unsigned char*)v;
#else
    (void)off; return nullptr;
#endif
}
__device__ __forceinline__ int modidx(int r) { return r < NPROMPT ? 0 : 1 + ((r - NPROMPT) >> 12); }
__device__ __forceinline__ void rope_cs(float pos, float inv, float& c, float& s) {
    float rev = pos * inv * 0.15915494309189535f; rev -= rintf(rev);
    s = __builtin_amdgcn_sinf(rev); c = __builtin_amdgcn_cosf(rev);
}

namespace pg8 {
constexpr int BM = 256, BK = 64, HALF = 128, HTB = HALF * BK * 2, STAGE_BYTES = 8 * HTB, NXCD = 8, WGM = 8;
__host__ __device__ __forceinline__ int lds_byte(int r, int c) { const int st = (r >> 4) * 2 + (c >> 5), rr = r & 15, cc = c & 31, ob = rr * 64 + cc * 2; return st * 1024 + (ob ^ (((ob >> 9) & 1) << 5)); }
__host__ __device__ __forceinline__ void stage_rc(int b, int& R, int& C) { const int st = b / 1024, sb = b % 1024, swz = sb ^ (((sb >> 9) & 1) << 5); R = (st >> 1) * 16 + swz / 64; C = (st & 1) * 32 + (swz % 64) / 2; }
__host__ __device__ __forceinline__ int perm32(int rho) { const int n = rho >> 4, i = rho & 15; return 8 * (i >> 2) + 4 * n + (i & 3); }
struct Unit { int pm, pn, kq; };
struct Gemm { const bf16_t* A; const bf16_t* Bt; int M, N, K, lda, ldb, ash, astep; };
struct StaticOrder {
    int nM, nN, nwg, G, c, ks;
    __device__ void init(int M, int N, int G_, int c_, int ks_ = 0) { nM = M / BM; nN = N / BM; nwg = nM * nN; G = G_; c = c_; ks = ks_; }
    __device__ bool next(int i, Unit& u) const {
        if (ks) { if (i < 2) { const int j = i * 32 + (c >> 3), xx = c & 7; u.pm = 16 * xx + (j >> 2); u.pn = j & 3; u.kq = -1; return true; }
                  if (i == 2) { const int t = c >> 2; u.pm = 128 + (t >> 2); u.pn = t & 3; u.kq = c & 3; return true; } return false; }
        u.kq = -1;
        const int L = i * G + c; if (L >= nwg) return false;
        int wgid = L; { const int q = nwg / NXCD, r = nwg % NXCD, xcd = wgid % NXCD, off = wgid / NXCD; wgid = (xcd < r ? xcd * (q + 1) : r * (q + 1) + (xcd - r) * q) + off; }
        const int nig = WGM * nN, gid = wgid / nig, fm = gid * WGM, gsz = (nM - fm) < WGM ? (nM - fm) : WGM;
        u.pm = fm + ((wgid % nig) % gsz); u.pn = (wgid % nig) / gsz; return true;
    }
};

template <class Epi>
__device__ __forceinline__ void gemm_phase(LAS unsigned char* lds, const Gemm g, const StaticOrder& S, const Epi& E, const int wv) {
    const int wid = wv, lane = lane_id_v(), tid = wid * 64 + lane, wr = wid >> 2, wc = wid & 3, fr = lane & 15, fq = lane >> 4;
    int K_ = g.K; asm volatile("" : "+s"(K_));
    const int K = K_, nt = K / BK;
    unsigned voffA[2], voffB[2];
#pragma unroll
    for (int i = 0; i < 2; ++i) { int R, C; stage_rc(tid * 16 + i * 8192, R, C); const int Rb = Epi::PERM ? ((R & ~31) + perm32(R & 31)) : R;
        voffA[i] = (unsigned)(R * g.lda + C) * 2u; voffB[i] = (unsigned)(Rb * g.ldb + C) * 2u; }
    const unsigned kstep = (unsigned)(BK * 2);
    const unsigned hA = (unsigned)HALF * g.lda * 2u, hB = (unsigned)HALF * g.ldb * 2u, tA = 2u * hA, tB = 2u * hB;
    const unsigned ldsw = (unsigned)wid * 1024u;
    const int aoff = lds_byte(wr * 64 + fr, fq * 8), boff = lds_byte(wc * 32 + fr, fq * 8);
#define PG8_SA(b, h) (((b) * 2 + (h)) * HTB)
#define PG8_SB(b, h) ((4 + (b) * 2 + (h)) * HTB)
#define PG8_STAGE(bufoff, gbase, voff) do { _Pragma("unroll") for (int _i = 0; _i < 2; ++_i) \
        __builtin_amdgcn_global_load_lds((const unsigned*)((const char*)(gbase) + (voff)[_i]), (LAS unsigned*)(lds + (bufoff) + ldsw + _i * 8192), 16, 0, 0); } while (0)
#define PG8_LDA(dst, b, h) do { _Pragma("unroll") for (int m = 0; m < 4; ++m) _Pragma("unroll") for (int k = 0; k < 2; ++k) dst[m][k] = *(const LAS bf16x8*)(lds + PG8_SA(b, h) + aoff + m * 2048 + k * 1024); } while (0)
#define PG8_LDB(dst, b, h) do { _Pragma("unroll") for (int n = 0; n < 2; ++n) _Pragma("unroll") for (int k = 0; k < 2; ++k) dst[n][k] = *(const LAS bf16x8*)(lds + PG8_SB(b, h) + boff + n * 2048 + k * 1024); } while (0)
#define PG8_MMA(ai, bj, At, Bt) do { __builtin_amdgcn_s_setprio(1); _Pragma("unroll") for (int m = 0; m < 4; ++m) _Pragma("unroll") for (int n = 0; n < 2; ++n) _Pragma("unroll") for (int k = 0; k < 2; ++k) \
        acc[ai][bj][m][n] = __builtin_amdgcn_mfma_f32_16x16x32_bf16(Bt[n][k], At[m][k], acc[ai][bj][m][n], 0, 0, 0); __builtin_amdgcn_s_setprio(0); } while (0)
#define PG8_WAIT_V(n) asm volatile("s_waitcnt vmcnt(" #n ")" ::: "memory")
#define PG8_WAIT_L(n) asm volatile("s_waitcnt lgkmcnt(" #n ")" ::: "memory")
#define PG8_BAR __builtin_amdgcn_s_barrier()
#define PG8_SCHED __builtin_amdgcn_sched_barrier(0)
    Unit cur, nxt; int ui = 0;
    if (!S.next(0, cur)) return;
    f32x4 acc[2][2][4][2];
#pragma unroll
    for (int a = 0; a < 2; ++a)
#pragma unroll
        for (int b = 0; b < 2; ++b)
#pragma unroll
            for (int m = 0; m < 4; ++m)
#pragma unroll
                for (int n = 0; n < 2; ++n) acc[a][b][m][n] = (f32x4){0.f, 0.f, 0.f, 0.f};
    bf16x8 At[4][2], B0[2][2], B1[2][2];
    const int ntq = nt >> 2;
    int cnt = cur.kq >= 0 ? ntq : nt;
    const unsigned cko = cur.kq >= 0 ? (unsigned)(cur.kq * ntq) * kstep : 0u;
    const char* cA = (const char*)g.A + ((unsigned)cur.pm * tA + (unsigned)(cur.pn >> g.ash) * (unsigned)g.astep + cko);
    const char* cB = (const char*)g.Bt + ((unsigned)cur.pn * tB + cko);
    PG8_STAGE(PG8_SB(0, 0), cB, voffB); PG8_STAGE(PG8_SB(0, 1), cB + hB, voffB); PG8_STAGE(PG8_SA(0, 0), cA, voffA); PG8_STAGE(PG8_SA(0, 1), cA + hA, voffA);
    if (wr == 1) PG8_BAR;
    PG8_WAIT_V(2); PG8_BAR;
    PG8_STAGE(PG8_SB(1, 0), cB + kstep, voffB); PG8_STAGE(PG8_SA(1, 0), cA + kstep, voffA); PG8_STAGE(PG8_SB(1, 1), cB + hB + kstep, voffB);
    PG8_WAIT_V(6); PG8_BAR;
    for (;;) {
        const bool has_next = S.next(ui + 1, nxt);
        const unsigned nko = (has_next && nxt.kq >= 0) ? (unsigned)(nxt.kq * ntq) * kstep : 0u;
        const char* nA = has_next ? (const char*)g.A + ((unsigned)nxt.pm * tA + (unsigned)(nxt.pn >> g.ash) * (unsigned)g.astep + nko) : cA; const char* nB = has_next ? (const char*)g.Bt + ((unsigned)nxt.pn * tB + nko) : cB;
        for (int t = 0; t < cnt; t += 2) {
            const bool last = (t == cnt - 2);
            const char* a1 = cA + (unsigned)(t + 1) * kstep;
            const char* a2 = last ? nA : cA + (unsigned)(t + 2) * kstep; const char* b2 = last ? nB : cB + (unsigned)(t + 2) * kstep;
            const char* a3 = a2 + kstep; const char* b3 = b2 + kstep;
            PG8_LDB(B0, 0, 0); PG8_LDB(B1, 0, 1); PG8_SCHED; PG8_LDA(At, 0, 0); PG8_STAGE(PG8_SA(1, 1), a1 + hA, voffA);
            PG8_WAIT_V(8); PG8_WAIT_L(0); PG8_BAR; PG8_MMA(0, 0, At, B0); PG8_MMA(0, 1, At, B1); PG8_BAR; PG8_SCHED;
            PG8_LDA(At, 0, 1); PG8_STAGE(PG8_SB(0, 0), b2, voffB); PG8_STAGE(PG8_SB(0, 1), b2 + hB, voffB); PG8_STAGE(PG8_SA(0, 0), a2, voffA);
            PG8_WAIT_V(8); PG8_WAIT_L(0); PG8_BAR; PG8_MMA(1, 0, At, B0); PG8_MMA(1, 1, At, B1); PG8_BAR; PG8_SCHED;
            PG8_LDB(B0, 1, 0); PG8_LDB(B1, 1, 1); PG8_SCHED; PG8_LDA(At, 1, 0); PG8_STAGE(PG8_SA(0, 1), a2 + hA, voffA);
            PG8_WAIT_V(8); PG8_WAIT_L(0); PG8_BAR; PG8_MMA(0, 0, At, B0); PG8_MMA(0, 1, At, B1); PG8_BAR; PG8_SCHED;
            PG8_LDA(At, 1, 1); PG8_STAGE(PG8_SB(1, 0), b3, voffB); PG8_STAGE(PG8_SB(1, 1), b3 + hB, voffB); PG8_STAGE(PG8_SA(1, 0), a3, voffA);
            PG8_WAIT_V(8); PG8_WAIT_L(0); PG8_BAR; PG8_MMA(1, 0, At, B0); PG8_MMA(1, 1, At, B1); PG8_BAR; PG8_SCHED;
        }
        if (wr == 0) PG8_BAR;
        E(acc, cur, wr, wc, fr, fq);
        if (!has_next) break;
#pragma unroll
        for (int a = 0; a < 2; ++a)
#pragma unroll
            for (int b = 0; b < 2; ++b)
#pragma unroll
                for (int m = 0; m < 4; ++m)
#pragma unroll
                    for (int n = 0; n < 2; ++n) acc[a][b][m][n] = (f32x4){0.f, 0.f, 0.f, 0.f};
        cur = nxt; cA = nA; cB = nB; ++ui; cnt = cur.kq >= 0 ? ntq : nt;
        if (wr == 1) PG8_BAR;
    }
    PG8_WAIT_V(0);
    PG8_BAR;
#undef PG8_SA
#undef PG8_SB
#undef PG8_STAGE
#undef PG8_LDA
#undef PG8_LDB
#undef PG8_MMA
#undef PG8_WAIT_V
#undef PG8_WAIT_L
#undef PG8_BAR
#undef PG8_SCHED
}

template <int ACT> struct EpiStore {
    static constexpr bool PERM = true;
    bf16_t* O; int ldc;
    __device__ __forceinline__ void operator()(const f32x4 (&acc)[2][2][4][2], const Unit& u, int wr, int wc, int fr, int fq) const {
        fr = launder(fr); fq = launder(fq);
        const int row0 = u.pm * BM + wr * 64 + fr, col0 = u.pn * BM + wc * 32 + 8 * fq;
#pragma unroll
        for (int ai = 0; ai < 2; ++ai)
#pragma unroll
            for (int m = 0; m < 4; ++m) { bf16_t* rowp = O + (size_t)(row0 + ai * HALF + m * 16) * ldc + col0;
#pragma unroll
                for (int bj = 0; bj < 2; ++bj) { f32x4 v0 = acc[ai][bj][m][0], v1 = acc[ai][bj][m][1];
                    if (ACT == 2) {
#pragma unroll
                        for (int e = 0; e < 4; ++e) { const float a = fmaxf(v0[e], 0.f), b = fmaxf(v1[e], 0.f); v0[e] = a * a; v1[e] = b * b; } }
                    u32x4 w; w.x = cvt_pk_bf16(v0[0], v0[1]); w.y = cvt_pk_bf16(v0[2], v0[3]); w.z = cvt_pk_bf16(v1[0], v1[1]); w.w = cvt_pk_bf16(v1[2], v1[3]);
                    *(u32x4*)(rowp + bj * HALF) = w; } asm volatile("" ::: "memory"); }
    }
};
struct EpiResid {
    static constexpr bool PERM = true;
    float* x; const float* gate; float* part;
    __device__ __forceinline__ void operator()(const f32x4 (&acc)[2][2][4][2], const Unit& u, int wr, int wc, int fr, int fq) const {
        fr = launder(fr); fq = launder(fq);
        const int row0 = u.pm * BM + wr * 64 + fr, col0 = u.pn * BM + wc * 32 + 8 * fq;
        if (u.kq >= 0) {
#pragma unroll
            for (int ai = 0; ai < 2; ++ai)
#pragma unroll
                for (int m = 0; m < 4; ++m) { float* rowp = part + ((size_t)u.kq * 4096 + (row0 + ai * HALF + m * 16 - 32768)) * DM + col0;
#pragma unroll
                    for (int bj = 0; bj < 2; ++bj)
#pragma unroll
                        for (int n = 0; n < 2; ++n) *(f32x4*)(rowp + bj * HALF + 4 * n) = acc[ai][bj][m][n]; }
            return;
        }
        const float* gp = gate + (size_t)modidx(u.pm * BM) * 6144 + col0;
        f32x4 gv[2][2];
#pragma unroll
        for (int bj = 0; bj < 2; ++bj)
#pragma unroll
            for (int n = 0; n < 2; ++n) gv[bj][n] = *(const f32x4*)(gp + bj * HALF + 4 * n);
#pragma unroll
        for (int ai = 0; ai < 2; ++ai)
#pragma unroll
            for (int m = 0; m < 4; ++m) { bf16_t* rowp = (bf16_t*)x + (size_t)(row0 + ai * HALF + m * 16) * 2048 + col0;
#pragma unroll
                for (int bj = 0; bj < 2; ++bj) { u32x4* p = (u32x4*)(rowp + bj * HALF); const u32x4 w = *p;
                    const f32x4 xa = (f32x4){bflo(w.x), bfhi(w.x), bflo(w.y), bfhi(w.y)} + gv[bj][0] * acc[ai][bj][m][0], xb = (f32x4){bflo(w.z), bfhi(w.z), bflo(w.w), bfhi(w.w)} + gv[bj][1] * acc[ai][bj][m][1];
                    u32x4 o; o.x = cvt_pk_bf16(xa[0], xa[1]); o.y = cvt_pk_bf16(xa[2], xa[3]); o.z = cvt_pk_bf16(xb[0], xb[1]); o.w = cvt_pk_bf16(xb[2], xb[3]); *p = o; }
                asm volatile("" ::: "memory"); }
    }
};
__device__ __forceinline__ void st4(bf16_t* p, const f32x4 v) { u32x2 w; w.x = cvt_pk_bf16(v[0], v[1]); w.y = cvt_pk_bf16(v[2], v[3]); *(u32x2*)p = w; }
struct EpiAttnQKV {
    static constexpr bool PERM = false;
    bf16_t *q, *k, *v; float *nk, *nv; const float *qg, *kg; int slot;
    __device__ __forceinline__ void operator()(const f32x4 (&acc)[2][2][4][2], const Unit& u, int wr, int wc, int fr, int fq) const {
        fr = launder(fr); fq = launder(fq);
        const int pn = u.pn;
#pragma unroll
        for (int ai = 0; ai < 2; ++ai)
#pragma unroll
            for (int m = 0; m < 4; ++m) {
                const int r = u.pm * BM + ai * HALF + wr * 64 + m * 16 + fr;
                f32x4 v00 = acc[ai][0][m][0], v01 = acc[ai][0][m][1], v10 = acc[ai][1][m][0], v11 = acc[ai][1][m][1];
                if (pn < 5) {
                    float ss = 0.f;
#pragma unroll
                    for (int e = 0; e < 4; ++e) ss += v00[e] * v00[e] + v01[e] * v01[e] + v10[e] * v10[e] + v11[e] * v11[e];
                    ss += __shfl_xor(ss, 16); ss += __shfl_xor(ss, 32);
                    const float rs = rsqrtf(ss * (1.f / 64.f) + 1e-6f);
                    const float* gn = (pn < 4 ? qg : kg) + 4 * fq;
                    v00 = v00 * rs * *(const f32x4*)(gn); v01 = v01 * rs * *(const f32x4*)(gn + 16); v10 = v10 * rs * *(const f32x4*)(gn + 32); v11 = v11 * rs * *(const f32x4*)(gn + 48);
                    if (r >= NPROMPT) {
                        const int t = (r - NPROMPT) & 4095; const float rp = (float)(t >> 6), cp = (float)(t & 63);
#pragma unroll
                        for (int e = 0; e < 4; ++e) {
                            const float inv = __builtin_amdgcn_exp2f(-(float)(4 * fq + e) * (13.287712379549449f / 16.f)); float c, s;
                            rope_cs(rp, inv, c, s); { const float x1 = v00[e], x2 = v01[e]; v00[e] = x1 * c - x2 * s; v01[e] = x2 * c + x1 * s; }
                            rope_cs(cp, inv, c, s); { const float x1 = v10[e], x2 = v11[e]; v10[e] = x1 * c - x2 * s; v11[e] = x2 * c + x1 * s; }
                        }
                    }
                }
                if (pn < 4) {
                    bf16_t* d = q + (size_t)r * 1024 + (4 * pn + wc) * 64 + 4 * fq;
                    constexpr float QS = 0.125f * LOG2E; st4(d, v00 * QS); st4(d + 16, v01 * QS); st4(d + 32, v10 * QS); st4(d + 48, v11 * QS);
                } else {
                    bf16_t* d = (pn == 4 ? k : v) + (size_t)r * 256 + wc * 64 + 4 * fq;
                    st4(d, v00); st4(d + 16, v01); st4(d + 32, v10); st4(d + 48, v11);
                    if (r < NPROMPT) { const int b = r >> 8, t = r & 255; float* o = (pn == 4 ? nk : nv) + ((size_t)(b * 2 + slot) * 256 + t) * 256 + wc * 64 + 4 * fq;
                        *(f32x4*)o = v00; *(f32x4*)(o + 16) = v01; *(f32x4*)(o + 32) = v10; *(f32x4*)(o + 48) = v11; }
                }
            }
    }
};
struct EpiRetQKV {
    static constexpr bool PERM = false;
    bf16_t *q, *k, *v;
    __device__ __forceinline__ void operator()(const f32x4 (&acc)[2][2][4][2], const Unit& u, int wr, int wc, int fr, int fq) const {
        fr = launder(fr); fq = launder(fq);
        const int pn = u.pn;
#pragma unroll
        for (int ai = 0; ai < 2; ++ai)
#pragma unroll
            for (int m = 0; m < 4; ++m) {
                const int r = u.pm * BM + ai * HALF + wr * 64 + m * 16 + fr;
                f32x4 v00 = acc[ai][0][m][0], v01 = acc[ai][0][m][1], v10 = acc[ai][1][m][0], v11 = acc[ai][1][m][1];
                if (pn < 8) {
                    if (r >= NPROMPT) {
                        const int t = (r - NPROMPT) & 4095; const float rp = (float)(t >> 6), cp = (float)(t & 63);
#pragma unroll
                        for (int e = 0; e < 4; ++e) {
                            const float inv = __builtin_amdgcn_exp2f(-(float)(16 * wc + 4 * fq + e) * (13.287712379549449f / 64.f)); float c, s;
                            rope_cs(rp, inv, c, s); { const float x1 = v00[e], x2 = v01[e]; v00[e] = x1 * c - x2 * s; v01[e] = x2 * c + x1 * s; }
                            rope_cs(cp, inv, c, s); { const float x1 = v10[e], x2 = v11[e]; v10[e] = x1 * c - x2 * s; v11[e] = x2 * c + x1 * s; }
                        }
                    }
                    if (pn >= 4) { v00 = v00 * 0.0625f; v01 = v01 * 0.0625f; v10 = v10 * 0.0625f; v11 = v11 * 0.0625f; }
                }
                bf16_t* d = (pn < 4 ? q + (size_t)r * 1024 + pn * 256 : pn < 8 ? k + (size_t)r * 1024 + (pn - 4) * 256 : v + (size_t)r * 2048 + (pn - 8) * 256) + 16 * wc + 4 * fq;
                st4(d, v00); st4(d + 64, v01); st4(d + 128, v10); st4(d + 192, v11);
            }
    }
};
template <int MODE> struct EpiLateGate {
    static constexpr bool PERM = true;
    bf16_t* Z; int ldz; const float* fin; const float* gn;
    __device__ __forceinline__ void operator()(const f32x4 (&acc)[2][2][4][2], const Unit& u, int wr, int wc, int fr, int fq) const {
        fr = launder(fr); fq = launder(fq);
        const int row0 = u.pm * BM + wr * 64 + fr, col0 = u.pn * BM + wc * 32 + 8 * fq;
#pragma unroll
        for (int ai = 0; ai < 2; ++ai)
#pragma unroll
            for (int m = 0; m < 4; ++m) { const int r = row0 + ai * HALF + m * 16;
#pragma unroll
                for (int bj = 0; bj < 2; ++bj) { const int c0 = col0 + bj * HALF; bf16_t* zp = Z + (size_t)r * ldz + c0;
                    const u32x4 zw = *(const u32x4*)zp; float z[8] = {bflo(zw.x), bfhi(zw.x), bflo(zw.y), bfhi(zw.y), bflo(zw.z), bfhi(zw.z), bflo(zw.w), bfhi(zw.w)};
                    float a[8]; { const f32x4 a0 = acc[ai][bj][m][0], a1 = acc[ai][bj][m][1]; a[0] = a0[0]; a[1] = a0[1]; a[2] = a0[2]; a[3] = a0[3]; a[4] = a1[0]; a[5] = a1[1]; a[6] = a1[2]; a[7] = a1[3]; }
                    float y[8];
                    if (MODE == 0) { const f32x2 st = *(const f32x2*)(fin + ((size_t)r * 4 + (c0 >> 9)) * 2); const f32x4 g0 = *(const f32x4*)(gn + c0), g1 = *(const f32x4*)(gn + c0 + 4);
                        const float gg[8] = {g0[0], g0[1], g0[2], g0[3], g1[0], g1[1], g1[2], g1[3]};
#pragma unroll
                        for (int e = 0; e < 8; ++e) y[e] = fsilu(a[e]) * ((z[e] - st.x) * st.y * gg[e]);
                    } else {
#pragma unroll
                        for (int e = 0; e < 8; ++e) y[e] = fgelu_tanh(a[e]) * z[e];
                    }
                    u32x4 w; w.x = cvt_pk_bf16(y[0], y[1]); w.y = cvt_pk_bf16(y[2], y[3]); w.z = cvt_pk_bf16(y[4], y[5]); w.w = cvt_pk_bf16(y[6], y[7]);
                    *(u32x4*)zp = w; asm volatile("" ::: "memory"); } }
    }
};
struct EpiLruGates {
    static constexpr bool PERM = false;
    const bf16_t* xc; bf16_t *la, *uu; const float *br, *bi, *lam;
    __device__ __forceinline__ void operator()(const f32x4 (&acc)[2][2][4][2], const Unit& u, int wr, int wc, int fr, int fq) const {
        fr = launder(fr); fq = launder(fq);
        const int nb = u.pn >> 1, dir = u.pn & 1;
#pragma unroll
        for (int bj = 0; bj < 2; ++bj) {
            const int ch = nb * 128 + 64 * bj + 16 * wc + 4 * fq;
            const f32x4 brv = *(const f32x4*)(br + dir * 1024 + ch), biv = *(const f32x4*)(bi + dir * 1024 + ch), lv = *(const f32x4*)(lam + dir * 1024 + ch);
            f32x4 sp;
#pragma unroll
            for (int e = 0; e < 4; ++e) sp[e] = -8.f * __logf(1.f + __expf(-lv[e]));
#pragma unroll
            for (int ai = 0; ai < 2; ++ai)
#pragma unroll
                for (int m = 0; m < 4; ++m) {
                    const int r = u.pm * BM + ai * HALF + wr * 64 + m * 16 + fr;
                    const u32x2 xw = *(const u32x2*)(xc + (size_t)r * 1024 + ch); const float xv[4] = {bflo(xw.x), bfhi(xw.x), bflo(xw.y), bfhi(xw.y)};
                    const f32x4 rp = acc[ai][bj][m][0], ip = acc[ai][bj][m][1]; f32x4 lo, uo;
#pragma unroll
                    for (int e = 0; e < 4; ++e) { const float pa = 1.f + __expf(-(rp[e] + brv[e])), pb = 1.f + __expf(-(ip[e] + biv[e])); const float inv = __builtin_amdgcn_rcpf(pa * pb);
                        const float rg = pb * inv, ig = pa * inv; const float l = rg * sp[e]; lo[e] = l; uo[e] = __builtin_amdgcn_sqrtf(fmaxf(1.f - __expf(2.f * l), 0.f)) * ig * xv[e]; }
                    st4(la + ((size_t)r * 2 + dir) * 1024 + ch, lo); st4(uu + ((size_t)r * 2 + dir) * 1024 + ch, uo);
                    asm volatile("" ::: "memory");
                }
        }
    }
};
}
using pg8::st4;

struct KArgs { const float* in[32]; float* out; unsigned char* ws; };
struct KTab { const float* const* t; };
__device__ __forceinline__ const float* inp(const KTab& a, int k) { return a.t[k]; }
__device__ __forceinline__ const float* inp(const KArgs& a, int k) { return a.in[k]; }

__device__ __forceinline__ float wave_sum(float v) {
#pragma unroll
    for (int o = 1; o < 64; o <<= 1) v += __shfl_xor(v, o);
    return v;
}
__device__ __forceinline__ float wave_max(float v) {
#pragma unroll
    for (int o = 1; o < 64; o <<= 1) v = fmaxf(v, __shfl_xor(v, o));
    return v;
}

template <int MODE>
__device__ __forceinline__ const float* wcol(const float* s0, const float* s1, int n) {
    if (MODE == 0) return s0 + n;
    if (MODE == 1) { const int gp = (n >> 5) & 7, bj = gp >> 2, wc = gp & 3; return s0 + (n & ~255) + (2 * wc + bj) * 32 + (n & 31); }
    if (MODE == 2) { const int p = n & 255, bj = p >> 7, wc = (p >> 5) & 3, nn = (p >> 4) & 1, r = p & 15; return s0 + (n & ~255) + 128 * bj + 64 * nn + 16 * wc + r; }
    { const int pn = n >> 8, nb = pn >> 1, dir = pn & 1, p = n & 255, bj = p >> 7, wc = (p >> 5) & 3, nn = (p >> 4) & 1, r = p & 15; const int cb = 64 * bj + 16 * wc + r;
      return (nn ? s1 : s0) + (size_t)(dir * 8 + nb) * 16384 + cb; }
}
template <int MODE>
__device__ __forceinline__ void wconv(const float* s0, const float* s1, int ld, int K, int N, bf16_t* WT, LAS float* scr, int lane_, int gw, int NGW) {
    const int lane = lane_id_v(); (void)lane_; asm volatile("" : "+s"(gw));
    const int nblk = N / 32, nitems = (K / 64) * nblk;
    for (int item = gw; item < nitems; item += NGW) {
        const int kb = item / nblk, nb = item % nblk, k0 = 64 * kb, n0 = 32 * nb;
        const float* cp = wcol<MODE>(s0, s1, n0 + (lane & 31));
#pragma unroll 8
        for (int i = 0; i < 32; ++i) { const int kk = 2 * i + (lane >> 5); scr[kk * 33 + (lane & 31)] = cp[(size_t)(k0 + kk) * ld]; }
        asm volatile("s_waitcnt lgkmcnt(0)" ::: "memory");
        const int c = lane & 7;
#pragma unroll
        for (int j = 0; j < 4; ++j) { const int n = (lane >> 3) + 8 * j; const LAS float* s = scr + (8 * c) * 33 + n;
            u32x4 o; o.x = cvt_pk_bf16(s[0 * 33], s[1 * 33]); o.y = cvt_pk_bf16(s[2 * 33], s[3 * 33]); o.z = cvt_pk_bf16(s[4 * 33], s[5 * 33]); o.w = cvt_pk_bf16(s[6 * 33], s[7 * 33]);
            *(u32x4*)(WT + (size_t)(n0 + n) * K + k0 + 8 * c) = o; }
        asm volatile("s_waitcnt lgkmcnt(0)" ::: "memory");
    }
}
template <class AT>
__device__ __forceinline__ void convert_layer_weights(const AT& a, unsigned char* ws, int layer, LAS unsigned char* lds, int wave, int lane, int gw, int NGW) {
    LAS float* scr = (LAS float*)(lds + wave * 8448);
    wconv<0>(inp(a, 12) + (size_t)layer * DM * DFF, nullptr, DFF, DM, DFF, (bf16_t*)(ws + WS_WUP), scr, lane, gw, NGW);
    wconv<0>(inp(a, 13) + (size_t)layer * DFF * DM, nullptr, DM, DFF, DM, (bf16_t*)(ws + WS_WDN), scr, lane, gw, NGW);
    const int kind = layer % 3, slot = layer / 3;
    if (kind == 0) {
        wconv<1>(inp(a, 14) + (size_t)slot * DM * 1536, nullptr, 1536, DM, 1536, (bf16_t*)(ws + WS_WIN), scr, lane, gw, NGW);
        wconv<0>(inp(a, 15) + (size_t)slot * DM * DM, nullptr, DM, DM, DM, (bf16_t*)(ws + WS_WOUT), scr, lane, gw, NGW);
    } else if (kind == 1) {
        wconv<2>(inp(a, 19) + (size_t)slot * DM * 6144, nullptr, 6144, DM, 4096, (bf16_t*)(ws + WS_WIN), scr, lane, gw, NGW);
        wconv<0>(inp(a, 19) + (size_t)slot * DM * 6144 + 4096, nullptr, 6144, DM, 2048, (bf16_t*)(ws + WS_WX), scr, lane, gw, NGW);
        wconv<0>(inp(a, 20) + (size_t)slot * 2048 * DM, nullptr, DM, 2048, DM, (bf16_t*)(ws + WS_WOUT), scr, lane, gw, NGW);
    } else {
        wconv<0>(inp(a, 23) + (size_t)slot * DM * 2048 + 1024, nullptr, 2048, DM, 1024, (bf16_t*)(ws + WS_WIN), scr, lane, gw, NGW);
        wconv<0>(inp(a, 23) + (size_t)slot * DM * 2048, nullptr, 2048, DM, 1024, (bf16_t*)(ws + WS_WX), scr, lane, gw, NGW);
        wconv<3>(inp(a, 26) + (size_t)slot * 2 * 8 * 16384, inp(a, 28) + (size_t)slot * 2 * 8 * 16384, 128, 128, 4096, (bf16_t*)(ws + WS_WX2), scr, lane, gw, NGW);
        wconv<0>(inp(a, 31) + (size_t)slot * DM * DM, nullptr, DM, DM, DM, (bf16_t*)(ws + WS_WOUT), scr, lane, gw, NGW);
    }
}

__device__ __forceinline__ void mod_phase(const KArgs& a, LAS unsigned char* lds, const int wv) {
    LAS float* sc = (LAS float*)lds;
    LAS float* red = (LAS float*)(lds + 36864);
    const int tid = (wv * 64 + lane_id_v());
    if (bid_s() >= 384) return;
    for (int i = tid; i < 9 * 1024; i += 512) { const int j = i >> 10, k = i & 1023; const float v = j == 0 ? inp(a, 7)[k] : inp(a, 6)[(j - 1) * 1024 + k]; sc[i] = fsilu(v); }
    __syncthreads();
    float* modt = (float*)(a.ws + WS_MOD);
    const int cl = tid & 63, ks = tid >> 6;
    for (int item = bid_s(); item < 384; item += gridDim.x) {
        const int l = item / 96, cg_ = item % 96, col = cg_ * 64 + cl;
        const float* w = inp(a, 10) + (size_t)l * DM * 6144 + col;
        float acc[9];
#pragma unroll
        for (int j = 0; j < 9; ++j) acc[j] = 0.f;
        for (int k0 = ks * 128; k0 < ks * 128 + 128; k0 += 16) {
            float wv[16];
#pragma unroll
            for (int u = 0; u < 16; ++u) wv[u] = w[(size_t)(k0 + u) * 6144];
#pragma unroll
            for (int u = 0; u < 16; ++u)
#pragma unroll
                for (int j = 0; j < 9; ++j) acc[j] += sc[j * 1024 + k0 + u] * wv[u];
        }
#pragma unroll
        for (int j = 0; j < 9; ++j) red[(ks * 9 + j) * 64 + cl] = acc[j];
        __syncthreads();
        for (int idx = tid; idx < 576; idx += 512) { const int j = idx >> 6, c2 = idx & 63; float s = inp(a, 11)[(size_t)l * 6144 + cg_ * 64 + c2];
#pragma unroll
            for (int q = 0; q < 8; ++q) s += red[(q * 9 + j) * 64 + c2];
            modt[((size_t)l * 9 + j) * 6144 + cg_ * 64 + c2] = s; }
        __syncthreads();
    }
}
__device__ __forceinline__ void cache_phase(const KArgs& a, const int wv) {
    const size_t n4 = (size_t)8 * 2 * 512 * 256 / 4;
    for (size_t i = (size_t)bid_s() * 512 + (wv * 64 + lane_id_v()); i < 2 * n4; i += (size_t)gridDim.x * 512) {
        const bool isv = i >= n4; const size_t j = isv ? i - n4 : i;
        const f32x4 v = *(const f32x4*)((isv ? inp(a, 3) : inp(a, 2)) + j * 4);
        st4((bf16_t*)(a.ws + (isv ? WS_CV : WS_CK)) + j * 4, v);
    }
}
template <bool FIRST>
__device__ __forceinline__ void norm_phase(const float* xp_, const float* xs_, float* xres, const float* gain, const float* modl, int sh_chunk, bf16_t* hout, int lane_, int gw, int NGW, const float* part = nullptr, const float* fixgate = nullptr) {
    const int lane = lane_id_v(); (void)lane_; asm volatile("" : "+s"(gw));
    for (int r = gw; r < MTOK; r += NGW) {
        const float* xr = FIRST ? (r < NPROMPT ? xp_ + (size_t)r * DM : xs_ + (size_t)(r - NPROMPT) * DM) : nullptr;
        bf16_t* xb = (bf16_t*)xres + (size_t)r * 2048;
        f32x4 v[4]; float s = 0.f;
#pragma unroll
        for (int j = 0; j < 4; ++j) {
            if (FIRST) v[j] = *(const f32x4*)(xr + 4 * lane + 256 * j);
            else { const u32x2 w = *(const u32x2*)(xb + 4 * lane + 256 * j); v[j] = (f32x4){bflo(w.x), bfhi(w.x), bflo(w.y), bfhi(w.y)}; }
            s += v[j][0] * v[j][0] + v[j][1] * v[j][1] + v[j][2] * v[j][2] + v[j][3] * v[j][3]; }
        if (FIRST) {
#pragma unroll
            for (int j = 0; j < 4; ++j) st4(xb + 4 * lane + 256 * j, v[j]);
        }
        if (!FIRST && part != nullptr && r >= 32768) {
            const float* gp = fixgate + (size_t)modidx(r) * 6144; s = 0.f;
#pragma unroll
            for (int j = 0; j < 4; ++j) { const int c = 4 * lane + 256 * j; const float* pp = part + (size_t)(r - 32768) * DM + c;
                const f32x4 ps = ((*(const f32x4*)pp + *(const f32x4*)(pp + (size_t)4096 * DM)) + *(const f32x4*)(pp + (size_t)2 * 4096 * DM)) + *(const f32x4*)(pp + (size_t)3 * 4096 * DM);
                v[j] = v[j] + *(const f32x4*)(gp + c) * ps; st4(xb + c, v[j]);
                s += v[j][0] * v[j][0] + v[j][1] * v[j][1] + v[j][2] * v[j][2] + v[j][3] * v[j][3]; }
        }
        const float rs = rsqrtf(wave_sum(s) * (1.f / DM) + 1e-6f);
        const float* mp = modl + (size_t)modidx(r) * 6144 + sh_chunk * 1024;
#pragma unroll
        for (int j = 0; j < 4; ++j) { const int c = 4 * lane + 256 * j; const f32x4 g = *(const f32x4*)(gain + c), sh = *(const f32x4*)(mp + c), sc = *(const f32x4*)(mp + 1024 + c);
            const f32x4 y = v[j] * rs * g * (1.f + sc) + sh; st4(hout + (size_t)r * DM + c, y); }
    }
}

__device__ __forceinline__ bf16x8 tr8(const LAS bf16_t* p0, const LAS bf16_t* p1) {
    const s16x4 a = __builtin_amdgcn_ds_read_tr16_b64_v4i16((LAS s16x4*)p0);
    const s16x4 b = __builtin_amdgcn_ds_read_tr16_b64_v4i16((LAS s16x4*)p1);
    return (bf16x8){a[0], a[1], a[2], a[3], b[0], b[1], b[2], b[3]};
}
__device__ __forceinline__ f32x16 mfma32(bf16x8 a, bf16x8 b, f32x16 c) { return __builtin_amdgcn_mfma_f32_32x32x16_bf16(a, b, c, 0, 0, 0); }
__device__ __forceinline__ f32x4 mfma16(bf16x8 a, bf16x8 b, f32x4 c) { return __builtin_amdgcn_mfma_f32_16x16x32_bf16(a, b, c, 0, 0, 0); }
__device__ __forceinline__ float fexp2(float x) { return __builtin_amdgcn_exp2f(x); }

__device__ __forceinline__ void att_tile(const LAS bf16_t* Ks, const LAS bf16_t* Vs, const bf16x8 (&Qf)[2][4], f32x16 (&ot)[2][2], float (&mrun)[2], float (&lrun)[2],
                                         bool skipw, bool needmask, int kpos0, int qpos0, int l31, int lh, int q4, int p4, int blk) {
            if (!skipw) {
                f32x16 sc[2][2];
#pragma unroll
                for (int cb = 0; cb < 2; ++cb)
#pragma unroll
                    for (int kk = 0; kk < 2; ++kk)
#pragma unroll
                        for (int r = 0; r < 16; ++r) sc[cb][kk][r] = 0.f;
#pragma unroll
                for (int s = 0; s < 4; ++s) {
                    const bf16x8 k0 = *(const LAS bf16x8*)(Ks + l31 * 72 + 16 * s + 8 * lh), k1 = *(const LAS bf16x8*)(Ks + (32 + l31) * 72 + 16 * s + 8 * lh);
                    sc[0][0] = mfma32(k0, Qf[0][s], sc[0][0]); sc[0][1] = mfma32(k1, Qf[0][s], sc[0][1]);
                    sc[1][0] = mfma32(k0, Qf[1][s], sc[1][0]); sc[1][1] = mfma32(k1, Qf[1][s], sc[1][1]);
                }
                bf16x8 pf[2][2][2];
#pragma unroll
                for (int cb = 0; cb < 2; ++cb) {
                    const int qpos = qpos0 + cb * 32 + l31;
                    float mx = -3.0e38f;
                    if (needmask) {
#pragma unroll
                        for (int r = 0; r < 16; ++r) { const int d0 = kpos0 + (r & 3) + 8 * (r >> 2) + 4 * lh - qpos, d1 = d0 + 32;
                            if (d0 > 128 || d0 < -128) sc[cb][0][r] = -1e30f; if (d1 > 128 || d1 < -128) sc[cb][1][r] = -1e30f; }
                    }
#pragma unroll
                    for (int r = 0; r < 16; ++r) mx = fmaxf(mx, fmaxf(sc[cb][0][r], sc[cb][1][r]));
                    mx = fmaxf(mx, __shfl_xor(mx, 32));
                    const float mnew = fmaxf(mrun[cb], mx), alpha = fexp2(mrun[cb] - mnew); mrun[cb] = mnew;
                    float ls = 0.f;
#pragma unroll
                    for (int r = 0; r < 16; ++r) { sc[cb][0][r] = fexp2(sc[cb][0][r] - mnew); sc[cb][1][r] = fexp2(sc[cb][1][r] - mnew); ls += sc[cb][0][r] + sc[cb][1][r]; }
                    lrun[cb] = lrun[cb] * alpha + ls;
                    if (__builtin_amdgcn_ballot_w64(alpha != 1.f) != 0ull) { ot[0][cb] = ot[0][cb] * alpha; ot[1][cb] = ot[1][cb] * alpha; }
#pragma unroll
                    for (int kk = 0; kk < 2; ++kk)
#pragma unroll
                        for (int s2 = 0; s2 < 2; ++s2) {
                            u32x4 w0;
                            w0.x = cvt_pk_bf16(sc[cb][kk][8 * s2 + 0], sc[cb][kk][8 * s2 + 1]); w0.y = cvt_pk_bf16(sc[cb][kk][8 * s2 + 2], sc[cb][kk][8 * s2 + 3]);
                            w0.z = cvt_pk_bf16(sc[cb][kk][8 * s2 + 4], sc[cb][kk][8 * s2 + 5]); w0.w = cvt_pk_bf16(sc[cb][kk][8 * s2 + 6], sc[cb][kk][8 * s2 + 7]);
                            pf[cb][kk][s2] = __builtin_bit_cast(bf16x8, w0);
                        }
                }
#pragma unroll
                for (int db = 0; db < 2; ++db)
#pragma unroll
                    for (int kbk = 0; kbk < 2; ++kbk)
#pragma unroll
                        for (int s2 = 0; s2 < 2; ++s2) {
                            const LAS bf16_t* vp = Vs + (kbk * 32 + 16 * s2 + 4 * lh + q4) * 72 + 32 * db + 16 * blk + 4 * p4;
                            const bf16x8 vf = tr8(vp, vp + 8 * 72);
                            ot[db][0] = mfma32(vf, pf[0][kbk][s2], ot[db][0]);
                            ot[db][1] = mfma32(vf, pf[1][kbk][s2], ot[db][1]);
                        }
            }
}
__device__ __forceinline__ void attn_phase(LAS unsigned char* lds, const bf16_t* qb, const bf16_t* kb, const bf16_t* vb, const bf16_t* ck, const bf16_t* cv, bf16_t* ob, const float* sink, const int wv) {
    LAS bf16_t* Ks = (LAS bf16_t*)lds; LAS bf16_t* Vs = (LAS bf16_t*)(lds + 9216);
    const int wid = wv, lane = lane_id_v(), tid = wid * 64 + lane, g = wid >> 1, qh = wid & 1;
    const int l31 = lane & 31, lh = lane >> 5, q4 = (lane & 15) >> 2, p4 = lane & 3, blk = (lane >> 4) & 1;
    const int skey = tid >> 3, sdc = tid & 7;
    for (int it = bid_s(); it < 1152; it += gridDim.x) {
        int b, hk, seqrow0, T, qbase, nlat, latk0, nctx; bool masked;
        if (it < 1024) { b = it >> 7; const int n = (it >> 2) & 31; hk = it & 3; seqrow0 = NPROMPT + b * 4096; T = 4096; qbase = n * 128; nlat = 6; latk0 = qbase - 128; nctx = 8; masked = true; }
        else { const int i2 = it - 1024; b = i2 >> 3; hk = (i2 >> 1) & 3; seqrow0 = b * 256; T = 256; qbase = (i2 & 1) * 128; nlat = 4; latk0 = 0; nctx = 0; masked = false; }
        const int h = hk * 4 + g, qpos0 = qbase + 64 * qh, ntiles = nlat + nctx;
        bf16x8 Qf[2][4];
#pragma unroll
        for (int cb = 0; cb < 2; ++cb)
#pragma unroll
            for (int s = 0; s < 4; ++s) Qf[cb][s] = *(const bf16x8*)(qb + (size_t)(seqrow0 + qpos0 + cb * 32 + l31) * 1024 + h * 64 + 16 * s + 8 * lh);
        float mrun[2], lrun[2]; f32x16 ot[2][2];
        const float sk = sink[h] * LOG2E;
        mrun[0] = sk; mrun[1] = sk; lrun[0] = lh == 0 ? 1.f : 0.f; lrun[1] = lrun[0];
#pragma unroll
        for (int i = 0; i < 2; ++i)
#pragma unroll
            for (int j = 0; j < 2; ++j)
#pragma unroll
                for (int r = 0; r < 16; ++r) ot[i][j][r] = 0.f;
        int ti = 0; while (ti < nlat && latk0 + 64 * ti < 0) ++ti;
        u32x4 kr0, vr0, kr1, vr1;
#define ATT_NEXT(tt) (((tt) + 1 < nlat && latk0 + 64 * ((tt) + 1) >= T) ? nlat : (tt) + 1)
#define ATT_LD(tt, KR, VR) do { const bf16_t *kp_, *vp_; if ((tt) < nlat) { const size_t o_ = (size_t)(seqrow0 + latk0 + 64 * (tt) + skey) * 256 + hk * 64 + sdc * 8; kp_ = kb + o_; vp_ = vb + o_; } \
            else { const size_t o_ = ((size_t)b * 1024 + 64 * ((tt) - nlat) + skey) * 256 + hk * 64 + sdc * 8; kp_ = ck + o_; vp_ = cv + o_; } KR = *(const u32x4*)kp_; VR = *(const u32x4*)vp_; } while (0)
#define ATT_FLAGS(cur_, SK, NM, KP) const bool SK##l_ = (cur_) < nlat; const int KP = latk0 + 64 * (cur_); bool SK = false, NM = false; \
            if (masked && SK##l_) { SK = (KP > qpos0 + 63 + 128) || (KP + 63 < qpos0 - 128); NM = (KP < qpos0 - 64) || (KP > qpos0 + 64); }
        int tp = ti, tq = ATT_NEXT(tp);
        ATT_LD(tp, kr0, vr0); ATT_LD(tq, kr1, vr1);
        while (tp < ntiles) {
            __syncthreads();
            *(LAS u32x4*)(Ks + skey * 72 + sdc * 8) = kr0; *(LAS u32x4*)(Vs + skey * 72 + sdc * 8) = vr0;
            *(LAS u32x4*)(Ks + 9216 + skey * 72 + sdc * 8) = kr1; *(LAS u32x4*)(Vs + 9216 + skey * 72 + sdc * 8) = vr1;
            __syncthreads();
            const int c0 = tp, c1 = tq;
            tp = ATT_NEXT(tq); tq = ATT_NEXT(tp);
            if (tp < ntiles) { ATT_LD(tp, kr0, vr0); ATT_LD(tq, kr1, vr1); }
            { ATT_FLAGS(c0, sk0, nm0, kp0) att_tile(Ks, Vs, Qf, ot, mrun, lrun, sk0, nm0, kp0, qpos0, l31, lh, q4, p4, blk); }
            { ATT_FLAGS(c1, sk1, nm1, kp1) att_tile(Ks + 9216, Vs + 9216, Qf, ot, mrun, lrun, sk1, nm1, kp1, qpos0, l31, lh, q4, p4, blk); }
        }
#undef ATT_NEXT
#undef ATT_LD
#undef ATT_FLAGS
#pragma unroll
        for (int cb = 0; cb < 2; ++cb) {
            const float lt = lrun[cb] + __shfl_xor(lrun[cb], 32), inv = 1.f / lt;
            bf16_t* orow = ob + (size_t)(seqrow0 + qpos0 + cb * 32 + l31) * 1024 + h * 64;
#pragma unroll
            for (int db = 0; db < 2; ++db)
#pragma unroll
                for (int rg = 0; rg < 4; ++rg) { const f32x4 v = {ot[db][cb][4 * rg] * inv, ot[db][cb][4 * rg + 1] * inv, ot[db][cb][4 * rg + 2] * inv, ot[db][cb][4 * rg + 3] * inv};
                    st4(orow + db * 32 + 8 * rg + 4 * lh, v); }
        }
    }
}

__device__ __forceinline__ void ret_scan_phase(LAS unsigned char* lds, const bf16_t* qb, const bf16_t* kb, const bf16_t* vb, bf16_t* ob, float* statp, const float* logdec, const float* state_in, float* state_out, const int wv) {
    constexpr int QST = 264, VST = 72;
    LAS bf16_t* Qs = (LAS bf16_t*)lds; LAS bf16_t* Ks = (LAS bf16_t*)(lds + 33792); LAS bf16_t* ST = (LAS bf16_t*)(lds + 67584);
    LAS bf16_t* Vs0 = (LAS bf16_t*)(lds + 101376); LAS bf16_t* Vw = (LAS bf16_t*)(lds + 110592); LAS bf16_t* Ps = (LAS bf16_t*)(lds + 119808);
    const int w = wv, lane = lane_id_v(), tid = w * 64 + lane, c16 = lane & 15, g = lane >> 4, q4 = (lane & 15) >> 2, p4 = lane & 3;
    const int itl = w >> 1, eb = 2 * (w & 1);
    for (int rnd = 0; rnd < 3; ++rnd) {
        const int bid = bid_s(), xx = bid & 7, ss = bid >> 3;
        const bool samp = rnd == 0; const int gidx = (samp ? 0 : (rnd - 1) * 32) + xx * 4 + (ss >> 3); const int b = gidx >> 2, head = gidx & 3, sl = ss & 7;
        const int seqrow0 = samp ? NPROMPT + b * 4096 : b * 256, T = samp ? 4096 : 256, nc = T / 64;
        for (int dir = 0; dir < 2; ++dir) {
            const float lg2 = logdec[dir * 4 + head] * LOG2E;
            f32x4 sacc[2][4];
#pragma unroll
            for (int dd = 0; dd < 2; ++dd)
#pragma unroll
                for (int et = 0; et < 4; ++et)
#pragma unroll
                    for (int r = 0; r < 4; ++r)
                        sacc[dd][et][r] = samp ? state_in[((((size_t)b * 2 + dir) * 4 + head) * 256 + 32 * w + 16 * dd + 4 * g + r) * 512 + sl * 64 + 16 * et + c16] : 0.f;
            __syncthreads();
#pragma unroll
            for (int dd = 0; dd < 2; ++dd)
#pragma unroll
                for (int et = 0; et < 4; ++et) { u32x2 wv; wv.x = cvt_pk_bf16(sacc[dd][et][0], sacc[dd][et][1]); wv.y = cvt_pk_bf16(sacc[dd][et][2], sacc[dd][et][3]);
                    *(LAS u32x2*)(ST + (16 * et + c16) * QST + 32 * w + 16 * dd + 4 * g) = wv; }
            u32x4 qreg[4], kreg[4], vreg;
#define RET_LOAD(cc_) do { const int t0_ = 64 * (cc_); _Pragma("unroll") for (int p = 0; p < 4; ++p) { const int idx = tid + 512 * p, row = idx >> 5, ch = idx & 31; \
                const size_t o_ = (size_t)(seqrow0 + t0_ + row) * 1024 + head * 256 + ch * 8; qreg[p] = *(const u32x4*)(qb + o_); kreg[p] = *(const u32x4*)(kb + o_); } \
                vreg = *(const u32x4*)(vb + (size_t)(seqrow0 + t0_ + (tid >> 3)) * 2048 + head * 512 + sl * 64 + (tid & 7) * 8); } while (0)
            RET_LOAD(dir ? nc - 1 : 0);
            const float gC = fexp2(lg2 * 64.f);
            float dec[2][4];
#pragma unroll
            for (int x = 0; x < 2; ++x)
#pragma unroll
                for (int r = 0; r < 4; ++r) { const int i = itl * 16 + c16, j = (eb + x) * 16 + 4 * g + r; const int df = dir ? j - i : i - j; const bool ok = dir ? df > 0 : df >= 0; dec[x][r] = ok ? fexp2(lg2 * (float)df) : 0.f; }
            const float wq_c = fexp2(lg2 * (float)(dir ? 64 - (itl * 16 + c16) : (itl * 16 + c16) + 1));
            const float wsj_c = fexp2(lg2 * (float)(dir ? (tid >> 3) : 63 - (tid >> 3)));
            for (int cc = 0; cc < nc; ++cc) {
                const int c = dir ? nc - 1 - cc : cc, t0 = 64 * c;
                LAS bf16_t* Vs = Vs0 + (cc & 1) * 13824;
#pragma unroll
                for (int p = 0; p < 4; ++p) { const int idx = tid + 512 * p, row = idx >> 5, ch = idx & 31; *(LAS u32x4*)(Qs + row * QST + ch * 8) = qreg[p]; *(LAS u32x4*)(Ks + row * QST + ch * 8) = kreg[p]; }
                { const int row = tid >> 3, ch = tid & 7; *(LAS u32x4*)(Vs + row * VST + ch * 8) = vreg;
                  const float wsj = wsj_c; u32x4 sv;
                  sv.x = cvt_pk_bf16(bflo(vreg.x) * wsj, bfhi(vreg.x) * wsj); sv.y = cvt_pk_bf16(bflo(vreg.y) * wsj, bfhi(vreg.y) * wsj);
                  sv.z = cvt_pk_bf16(bflo(vreg.z) * wsj, bfhi(vreg.z) * wsj); sv.w = cvt_pk_bf16(bflo(vreg.w) * wsj, bfhi(vreg.w) * wsj);
                  *(LAS u32x4*)(Vw + row * VST + ch * 8) = sv; }
                __syncthreads();
                if (cc + 1 < nc) RET_LOAD(dir ? nc - 2 - cc : cc + 1);
                const int orow = seqrow0 + t0 + itl * 16 + c16; bf16_t* op = ob + (size_t)orow * 2048 + head * 512 + sl * 64 + 4 * g;
                u32x2 pw0 = {0u, 0u}, pw1 = {0u, 0u};
                if (dir) { pw0 = *(const u32x2*)(op + eb * 16); pw1 = *(const u32x2*)(op + (eb + 1) * 16); }
                bf16x8 qf[8];
#pragma unroll
                for (int ks = 0; ks < 8; ++ks) qf[ks] = *(const LAS bf16x8*)(Qs + (itl * 16 + c16) * QST + 32 * ks + 8 * g);
#pragma unroll
                for (int x = 0; x < 2; ++x) {
                    const int jt = eb + x; f32x4 pt = {0.f, 0.f, 0.f, 0.f};
#pragma unroll
                    for (int ks = 0; ks < 8; ++ks) pt = mfma16(*(const LAS bf16x8*)(Ks + (jt * 16 + c16) * QST + 32 * ks + 8 * g), qf[ks], pt);
                    const int i = itl * 16 + c16; f32x4 pv;
#pragma unroll
                    for (int r = 0; r < 4; ++r) pv[r] = pt[r] * dec[x][r];
                    u32x2 wv; wv.x = cvt_pk_bf16(pv[0], pv[1]); wv.y = cvt_pk_bf16(pv[2], pv[3]);
                    *(LAS u32x2*)(Ps + i * VST + jt * 16 + 4 * g) = wv;
                }
                f32x4 oc[2];
                { const float wq = wq_c;
#pragma unroll
                  for (int x = 0; x < 2; ++x) { const int et = eb + x; f32x4 o = {0.f, 0.f, 0.f, 0.f};
#pragma unroll
                      for (int ks = 0; ks < 8; ++ks) o = mfma16(*(const LAS bf16x8*)(ST + (et * 16 + c16) * QST + 32 * ks + 8 * g), qf[ks], o);
                      oc[x] = o * wq; } }
#pragma unroll
                for (int dd = 0; dd < 2; ++dd)
#pragma unroll
                    for (int et = 0; et < 4; ++et) sacc[dd][et] = sacc[dd][et] * gC;
#pragma unroll
                for (int ks = 0; ks < 2; ++ks) {
                    bf16x8 bfr[4];
#pragma unroll
                    for (int et = 0; et < 4; ++et) { const LAS bf16_t* vp = Vw + (32 * ks + 8 * g + q4) * VST + 16 * et + 4 * p4; bfr[et] = tr8(vp, vp + 4 * VST); }
#pragma unroll
                    for (int dd = 0; dd < 2; ++dd) { const LAS bf16_t* kp = Ks + (32 * ks + 8 * g + q4) * QST + 32 * w + 16 * dd + 4 * p4; const bf16x8 af = tr8(kp, kp + 4 * QST);
#pragma unroll
                        for (int et = 0; et < 4; ++et) sacc[dd][et] = mfma16(af, bfr[et], sacc[dd][et]); }
                }
                __syncthreads();
#pragma unroll
                for (int x = 0; x < 2; ++x) { const int et = eb + x;
#pragma unroll
                    for (int ks = 0; ks < 2; ++ks) { const LAS bf16_t* vp = Vs + (32 * ks + 8 * g + q4) * VST + 16 * et + 4 * p4;
                        oc[x] = mfma16(tr8(vp, vp + 4 * VST), *(const LAS bf16x8*)(Ps + (itl * 16 + c16) * VST + 32 * ks + 8 * g), oc[x]); } }
                { const int row = orow;
                  if (dir == 0) { st4(op + eb * 16, oc[0]); st4(op + (eb + 1) * 16, oc[1]); }
                  else { float s1 = 0.f, s2 = 0.f;
#pragma unroll
                      for (int x = 0; x < 2; ++x) { bf16_t* o2 = op + (eb + x) * 16; const u32x2 pw = x ? pw1 : pw0; f32x4 f = oc[x];
                          f[0] += bflo(pw.x); f[1] += bfhi(pw.x); f[2] += bflo(pw.y); f[3] += bfhi(pw.y); st4(o2, f);
                          s1 += f[0] + f[1] + f[2] + f[3]; s2 += f[0] * f[0] + f[1] * f[1] + f[2] * f[2] + f[3] * f[3]; }
                      s1 += __shfl_xor(s1, 16); s1 += __shfl_xor(s1, 32); s2 += __shfl_xor(s2, 16); s2 += __shfl_xor(s2, 32);
                      if (g == 0) *(f32x2*)(statp + (((size_t)row * 4 + head) * 16 + sl * 2 + (w & 1)) * 2) = (f32x2){s1, s2}; } }
#pragma unroll
                for (int dd = 0; dd < 2; ++dd)
#pragma unroll
                    for (int et = 0; et < 4; ++et) { u32x2 wv; wv.x = cvt_pk_bf16(sacc[dd][et][0], sacc[dd][et][1]); wv.y = cvt_pk_bf16(sacc[dd][et][2], sacc[dd][et][3]);
                        *(LAS u32x2*)(ST + (16 * et + c16) * QST + 32 * w + 16 * dd + 4 * g) = wv; }
            }
#undef RET_LOAD
            if (!samp) {
#pragma unroll
                for (int dd = 0; dd < 2; ++dd)
#pragma unroll
                    for (int et = 0; et < 4; ++et)
#pragma unroll
                        for (int r = 0; r < 4; ++r)
                            state_out[((((size_t)b * 2 + dir) * 4 + head) * 256 + 32 * w + 16 * dd + 4 * g + r) * 512 + sl * 64 + 16 * et + c16] = sacc[dd][et][r];
            }
        }
    }
}
__device__ __forceinline__ void ret_fin_phase(const float* statp, float* fin, const int wv) {
    for (int i = bid_s() * 512 + (wv * 64 + lane_id_v()); i < MTOK * 4; i += gridDim.x * 512) {
        float s1 = 0.f, s2 = 0.f;
#pragma unroll
        for (int p = 0; p < 16; ++p) { const f32x2 v = *(const f32x2*)(statp + ((size_t)i * 16 + p) * 2); s1 += v.x; s2 += v.y; }
        const float mu = s1 * (1.f / 512.f), var = fmaxf(s2 * (1.f / 512.f) - mu * mu, 0.f);
        *(f32x2*)(fin + (size_t)i * 2) = (f32x2){mu, rsqrtf(var + 1e-6f)};
    }
}

__device__ __forceinline__ void lru_conv_phase(const bf16_t* xr, bf16_t* xc, const float* cw, const float* cbias, const int wv) {
    for (size_t i = (size_t)bid_s() * 512 + (wv * 64 + lane_id_v()); i < (size_t)MTOK * 128; i += (size_t)gridDim.x * 512) {
        const int r = (int)(i >> 7), c8 = (int)(i & 127) * 8;
        const int t = r < NPROMPT ? (r & 255) : ((r - NPROMPT) & 4095), T = r < NPROMPT ? 256 : 4096;
        float acc[8];
        { const f32x4 b0 = *(const f32x4*)(cbias + c8), b1 = *(const f32x4*)(cbias + c8 + 4); acc[0] = b0[0]; acc[1] = b0[1]; acc[2] = b0[2]; acc[3] = b0[3]; acc[4] = b1[0]; acc[5] = b1[1]; acc[6] = b1[2]; acc[7] = b1[3]; }
#pragma unroll
        for (int jj = 0; jj < 4; ++jj) { const int tt = t - 2 + jj;
            if (tt >= 0 && tt < T) { const u32x4 xw = *(const u32x4*)(xr + (size_t)(r - 2 + jj) * 1024 + c8); const f32x4 w0 = *(const f32x4*)(cw + jj * 1024 + c8), w1 = *(const f32x4*)(cw + jj * 1024 + c8 + 4);
                acc[0] += w0[0] * bflo(xw.x); acc[1] += w0[1] * bfhi(xw.x); acc[2] += w0[2] * bflo(xw.y); acc[3] += w0[3] * bfhi(xw.y);
                acc[4] += w1[0] * bflo(xw.z); acc[5] += w1[1] * bfhi(xw.z); acc[6] += w1[2] * bflo(xw.w); acc[7] += w1[3] * bfhi(xw.w); } }
        u32x4 o; o.x = cvt_pk_bf16(acc[0], acc[1]); o.y = cvt_pk_bf16(acc[2], acc[3]); o.z = cvt_pk_bf16(acc[4], acc[5]); o.w = cvt_pk_bf16(acc[6], acc[7]);
        *(u32x4*)(xc + (size_t)r * 1024 + c8) = o;
    }
}
__device__ __forceinline__ void lru_scanA_phase(const bf16_t* __restrict__ la, const bf16_t* __restrict__ uu, float* __restrict__ agg, const int wv) {
    constexpr int NS = 8 * 2 * 32 * 512, NP = 16 * 2 * 2 * 512;
    for (int idx = bid_s() * 512 + (wv * 64 + lane_id_v()); idx < NS + NP; idx += gridDim.x * 512) {
        int cp, dir, row0, segidx;
        if (idx < NS) { cp = idx & 511; const int seg = (idx >> 9) & 31; dir = (idx >> 14) & 1; const int b = idx >> 15; row0 = NPROMPT + b * 4096 + seg * 128; segidx = (b * 2 + dir) * 32 + seg; }
        else { const int i2 = idx - NS; cp = i2 & 511; const int seg = (i2 >> 9) & 1; dir = (i2 >> 10) & 1; const int b = i2 >> 11; row0 = b * 256 + seg * 128; segidx = 512 + (b * 2 + dir) * 2 + seg; }
        float L0 = 0.f, L1 = 0.f, H0 = 0.f, H1 = 0.f;
        for (int s0 = 0; s0 < 128; s0 += 16) {
            unsigned lw[16], uw[16];
#pragma unroll
            for (int j = 0; j < 16; ++j) { const int r = row0 + (dir ? 127 - (s0 + j) : s0 + j); const size_t o = ((size_t)r * 2 + dir) * 1024 + 2 * cp; lw[j] = *(const unsigned*)(la + o); uw[j] = *(const unsigned*)(uu + o); }
#pragma unroll
            for (int j = 0; j < 16; ++j) { const float l0 = bflo(lw[j]), l1 = bfhi(lw[j]); H0 = __expf(l0) * H0 + bflo(uw[j]); H1 = __expf(l1) * H1 + bfhi(uw[j]); L0 += l0; L1 += l1; }
        }
        *(f32x4*)(agg + ((size_t)segidx * 1024 + 2 * cp) * 2) = (f32x4){L0, H0, L1, H1};
    }
}
__device__ __forceinline__ void lru_scanC_phase(const bf16_t* __restrict__ la, const bf16_t* __restrict__ uu, const float* __restrict__ agg, bf16_t* __restrict__ rec, const float* __restrict__ st_in, float* __restrict__ st_out, const int wv) {
    constexpr int NS = 8 * 32 * 512, NP = 16 * 2 * 512;
    for (int idx = bid_s() * 512 + (wv * 64 + lane_id_v()); idx < NS + NP; idx += gridDim.x * 512) {
        int cp, seg, b, row0, nseg, segb; const bool samp = idx < NS;
        if (samp) { cp = idx & 511; seg = (idx >> 9) & 31; b = idx >> 14; row0 = NPROMPT + b * 4096 + seg * 128; nseg = 32; segb = b * 64; }
        else { const int i2 = idx - NS; cp = i2 & 511; seg = (i2 >> 9) & 1; b = i2 >> 10; row0 = b * 256 + seg * 128; nseg = 2; segb = 512 + b * 4; }
        float h0 = 0.f, h1 = 0.f;
        if (samp) { const f32x2 v = *(const f32x2*)(st_in + (b * 2 + 0) * 1024 + 2 * cp); h0 = v.x; h1 = v.y; }
        for (int s2 = 0; s2 < seg; ++s2) { const f32x4 v = *(const f32x4*)(agg + ((size_t)(segb + s2) * 1024 + 2 * cp) * 2); h0 = __expf(v[0]) * h0 + v[1]; h1 = __expf(v[2]) * h1 + v[3]; }
        for (int s0 = 0; s0 < 128; s0 += 16) {
            unsigned lw[16], uw[16];
#pragma unroll
            for (int j = 0; j < 16; ++j) { const size_t o = ((size_t)(row0 + s0 + j) * 2 + 0) * 1024 + 2 * cp; lw[j] = *(const unsigned*)(la + o); uw[j] = *(const unsigned*)(uu + o); }
#pragma unroll
            for (int j = 0; j < 16; ++j) { h0 = __expf(bflo(lw[j])) * h0 + bflo(uw[j]); h1 = __expf(bfhi(lw[j])) * h1 + bfhi(uw[j]); *(unsigned*)(rec + (size_t)(row0 + s0 + j) * 1024 + 2 * cp) = cvt_pk_bf16(h0, h1); }
        }
        if (!samp && seg == nseg - 1) *(f32x2*)(st_out + (b * 2 + 0) * 1024 + 2 * cp) = (f32x2){h0, h1};
        h0 = 0.f; h1 = 0.f;
        if (samp) { const f32x2 v = *(const f32x2*)(st_in + (b * 2 + 1) * 1024 + 2 * cp); h0 = v.x; h1 = v.y; }
        for (int s2 = nseg - 1; s2 > seg; --s2) { const f32x4 v = *(const f32x4*)(agg + ((size_t)(segb + nseg + s2) * 1024 + 2 * cp) * 2); h0 = __expf(v[0]) * h0 + v[1]; h1 = __expf(v[2]) * h1 + v[3]; }
        for (int s0 = 0; s0 < 128; s0 += 16) {
            unsigned lw[16], uw[16], rw[16];
#pragma unroll
            for (int j = 0; j < 16; ++j) { const int r = row0 + 127 - (s0 + j); const size_t o = ((size_t)r * 2 + 1) * 1024 + 2 * cp; lw[j] = *(const unsigned*)(la + o); uw[j] = *(const unsigned*)(uu + o); rw[j] = *(const unsigned*)(rec + (size_t)r * 1024 + 2 * cp); }
#pragma unroll
            for (int j = 0; j < 16; ++j) { const int r = row0 + 127 - (s0 + j); h0 = __expf(bflo(lw[j])) * h0 + bflo(uw[j]); h1 = __expf(bfhi(lw[j])) * h1 + bfhi(uw[j]);
                *(unsigned*)(rec + (size_t)r * 1024 + 2 * cp) = cvt_pk_bf16(bflo(rw[j]) + h0, bfhi(rw[j]) + h1); }
        }
        if (!samp && seg == 0) *(f32x2*)(st_out + (b * 2 + 1) * 1024 + 2 * cp) = (f32x2){h0, h1};
    }
}

#ifndef REP_BAR
#define REP_BAR 1
#endif
#ifndef REP_ATT
#define REP_ATT 1
#endif
#ifndef REP_RET
#define REP_RET 1
#endif
#ifndef REP_LRU
#define REP_LRU 1
#endif
#ifndef REP_UP
#define REP_UP 1
#endif
#ifndef REP_NORM
#define REP_NORM 1
#endif
__device__ __forceinline__ int opq(int n) { asm volatile("" : "+s"(n)); return n; }
constexpr int LDS_BYTES = 147456;
constexpr size_t WS_BAR = 4096;
#define XB_TMO      128
#define XB_XCNT(j)  (256  + 64 * (j))
#define XB_XSUB(j)  (1280 + 64 * (j))
#define XB_XGEN(j)  (2304 + 64 * (j))
#define XB_TOP      3328
#define XB_TOPGEN   3392
#define XCD_BAR_WORDS 3456
#define XB_SPIN_CAP (1u << 22)
__device__ __forceinline__ unsigned xb_ld(unsigned* p)              { return __hip_atomic_load(p, __ATOMIC_RELAXED, __HIP_MEMORY_SCOPE_AGENT); }
__device__ __forceinline__ unsigned xb_add(unsigned* p, unsigned v) { return __hip_atomic_fetch_add(p, v, __ATOMIC_RELAXED, __HIP_MEMORY_SCOPE_AGENT); }
__device__ __forceinline__ unsigned xb_xcc_id() { return (unsigned)__builtin_amdgcn_s_getreg((3 << 11) | 20) & 0xFu; }
#define XB_SPIN(cond, bar) do { unsigned _sp = 0; while (cond) { __builtin_amdgcn_s_sleep(1); \
    if ((++_sp & 255u) == 0u) { if (xb_ld(&(bar)[XB_TMO])) break; if (_sp > XB_SPIN_CAP) { atomicAdd(&(bar)[XB_TMO], 1u); break; } } } } while (0)
__device__ __forceinline__ void xcd_barrier_complete(unsigned* bar, unsigned x, unsigned& nloc, unsigned& nx) {
    const unsigned G = gridDim.x;
    unsigned sum, cnt, mine, sp = 0u;
    for (;;) {
        sum = 0u; cnt = 0u; mine = 0u;
#pragma unroll
        for (unsigned j = 0; j < 16; ++j) { const unsigned c = xb_ld(&bar[XB_XCNT(j)]); sum += c; cnt += (c > 0u) ? 1u : 0u; mine = (j == x) ? c : mine; }
        if (sum == G) break;
        __builtin_amdgcn_s_sleep(1);
        if ((++sp & 255u) == 0u) { if (xb_ld(&bar[XB_TMO])) break; if (sp > XB_SPIN_CAP) { atomicAdd(&bar[XB_TMO], 1u); break; } }
    }
    nloc = mine > 0u ? mine : 1u; nx = cnt > 0u ? cnt : 1u;
}
__device__ __forceinline__ void gbar(unsigned* bar, volatile LAS unsigned* st, const int wv) {
    asm volatile("s_waitcnt vmcnt(0) lgkmcnt(0)" ::: "memory");
    __syncthreads();
    if (wv == 0) {
      if (lane_id_v() == 0) {
        const unsigned x = xb_xcc_id();
        unsigned nloc = st[0], nx = st[1];
        if (nloc == 0u) { xcd_barrier_complete(bar, x, nloc, nx); st[0] = nloc; st[1] = nx; }
        const unsigned old = xb_add(&bar[XB_XSUB(x)], 1u);
        const unsigned gen = old / nloc;
        if (old + 1u == (gen + 1u) * nloc) {
            __builtin_amdgcn_fence(__ATOMIC_RELEASE, "agent");
            asm volatile("s_waitcnt vmcnt(0)" ::: "memory");
            const unsigned og = xb_add(&bar[XB_TOP], 1u);
            const unsigned tg = og / nx;
            if (og + 1u == (tg + 1u) * nx) xb_add(&bar[XB_TOPGEN], 1u);
            else XB_SPIN(xb_ld(&bar[XB_TOPGEN]) == tg, bar);
            __builtin_amdgcn_fence(__ATOMIC_ACQUIRE, "agent");
            xb_add(&bar[XB_XGEN(x)], 1u);
            asm volatile("s_waitcnt vmcnt(0)" ::: "memory");
        } else {
            XB_SPIN(xb_ld(&bar[XB_XGEN(x)]) == gen, bar);
            __builtin_amdgcn_fence(__ATOMIC_ACQUIRE, "agent");
            asm volatile("s_waitcnt vmcnt(0)" ::: "memory");
        }
      }
    }
    __syncthreads();
}
__global__ void __launch_bounds__(512, 2) fwd_mega(KArgs a) {
    extern __shared__ __attribute__((aligned(16))) unsigned char lds_raw[];
    LAS unsigned char* lds = (LAS unsigned char*)lds_raw;
    cg::this_grid().sync();
    volatile LAS unsigned* bst = (volatile LAS unsigned*)(lds + 143360);
    if (wave_id_s() == 0 && lane_id_v() == 0) { bst[0] = 0u; bst[1] = 0u; const unsigned xc_ = xb_xcc_id();
        const unsigned slot_ = xb_add(&((unsigned*)(karg_ptr(264) + WS_BAR))[XB_XCNT(xc_)], 1u); bst[2] = blockIdx.x; bst[3] = (xc_ << 8) | slot_; }
    __syncthreads();
    const int wave = wave_id_s(), lane = 0, G = gridDim.x, gw = bid_s() * 8 + wave, NGW = G * 8;
#define ws karg_ptr(264)
#define XR ((float*)karg_ptr(256))
#define modt ((float*)(ws + WS_MOD))
#define hbuf ((bf16_t*)(ws + WS_H))
#define WUP ((bf16_t*)(ws + WS_WUP))
#define WDN ((bf16_t*)(ws + WS_WDN))
#define WIN ((bf16_t*)(ws + WS_WIN))
#define WOUT ((bf16_t*)(ws + WS_WOUT))
#define WX ((bf16_t*)(ws + WS_WX))
#define WX2 ((bf16_t*)(ws + WS_WX2))
    mod_phase(a, lds, wave); __syncthreads();
    cache_phase(a, wave);
    convert_layer_weights(a, ws, 0, lds, wave, lane, gw, NGW);
    if (bid_s() == 0 && wave == 0) { const int l_ = lane_id_v(); if (l_ < 32) ((const float**)ws)[l_] = a.in[l_]; }
    for (int rb_ = opq(REP_BAR); rb_ > 0; --rb_) gbar((unsigned*)(ws + WS_BAR), bst, wave);
    if (wave == 0 && lane_id_v() == 0) {
        unsigned* bar_ = (unsigned*)(ws + WS_BAR); bool ok_ = gridDim.x == 256;
        for (unsigned j = 0; j < 16; ++j) { const unsigned c_ = xb_ld(&bar_[XB_XCNT(j)]); ok_ = ok_ && (c_ == (j < 8 ? 32u : 0u)); }
        const unsigned v_ = bst[3]; if (ok_) bst[2] = (v_ & 255u) * 8u + (v_ >> 8);
    }
    __syncthreads();
#define tb (KTab{(const float* const*)ws})
    constexpr int KS = 1;
    for (int layer = 0; layer < 4; ++layer) {
        const int kind = layer % 3, slot = layer / 3;
#define modl (modt + (size_t)layer * 9 * 6144)
        pg8::StaticOrder S;
        if (layer == 0) norm_phase<true>(inp(tb, 0), inp(tb, 1), XR, inp(tb, 8), modl, 0, hbuf, lane, gw, NGW);
        else { norm_phase<false>(nullptr, nullptr, XR, inp(tb, 8) + layer * DM, modl, 0, hbuf, lane, gw, NGW, KS ? (const float*)(ws + WS_PART_M) : nullptr, modl - 9 * 6144 + 5 * 1024); __syncthreads(); convert_layer_weights(tb, ws, layer, lds, wave, lane, gw, NGW); }
        for (int rb_ = opq(REP_BAR); rb_ > 0; --rb_) gbar((unsigned*)(ws + WS_BAR), bst, wave);
        if (kind == 0) {
            bf16_t *q = (bf16_t*)(ws + WS_AQ), *k = (bf16_t*)(ws + WS_AK), *v = (bf16_t*)(ws + WS_AV), *o = (bf16_t*)(ws + WS_AO);
            { pg8::Gemm g{hbuf, WIN, MTOK, 1536, 1024, 1024, 1024, 31, 0}; S.init(MTOK, 1536, G, bid_s());
              pg8::EpiAttnQKV E{q, k, v, XR + OUT_K, XR + OUT_V, inp(tb, 16) + slot * 64, inp(tb, 17) + slot * 64, slot};
              pg8::gemm_phase(lds, g, S, E, wave); }
            for (int rb_ = opq(REP_BAR); rb_ > 0; --rb_) gbar((unsigned*)(ws + WS_BAR), bst, wave);
            for (int rp_ = opq(REP_ATT); rp_ > 0; --rp_) attn_phase(lds, q, k, v, (const bf16_t*)(ws + WS_CK) + (size_t)slot * 512 * 256, (const bf16_t*)(ws + WS_CV) + (size_t)slot * 512 * 256, o, inp(tb, 18) + slot * 16, wave);
            for (int rb_ = opq(REP_BAR); rb_ > 0; --rb_) gbar((unsigned*)(ws + WS_BAR), bst, wave);
            { pg8::Gemm g{o, WOUT, MTOK, 1024, 1024, 1024, 1024, 31, 0}; S.init(MTOK, 1024, G, bid_s(), KS); pg8::EpiResid E{XR, modl + 2 * 1024, (float*)(ws + WS_PART_A)}; pg8::gemm_phase(lds, g, S, E, wave); }
            for (int rb_ = opq(REP_BAR); rb_ > 0; --rb_) gbar((unsigned*)(ws + WS_BAR), bst, wave);
        } else if (kind == 1) {
            bf16_t *q = (bf16_t*)(ws + WS_RQ), *k = (bf16_t*)(ws + WS_RK), *v = (bf16_t*)(ws + WS_RV), *o = (bf16_t*)(ws + WS_RO);
            float* statp = (float*)(ws + WS_RSTP); float* fin = (float*)(ws + WS_RFIN);
            { pg8::Gemm g{hbuf, WIN, MTOK, 4096, 1024, 1024, 1024, 31, 0}; S.init(MTOK, 4096, G, bid_s()); pg8::EpiRetQKV E{q, k, v}; pg8::gemm_phase(lds, g, S, E, wave); }
            for (int rb_ = opq(REP_BAR); rb_ > 0; --rb_) gbar((unsigned*)(ws + WS_BAR), bst, wave);
            for (int rp_ = opq(REP_RET); rp_ > 0; --rp_) ret_scan_phase(lds, q, k, v, o, statp, inp(tb, 22) + slot * 8, inp(tb, 4), XR + OUT_RET, wave);
            for (int rb_ = opq(REP_BAR); rb_ > 0; --rb_) gbar((unsigned*)(ws + WS_BAR), bst, wave);
            bf16_t* h2 = (bf16_t*)(ws + WS_RQ);
            norm_phase<false>(nullptr, nullptr, XR, inp(tb, 8) + layer * DM, modl, 0, h2, lane, gw, NGW);
            ret_fin_phase(statp, fin, wave);
            for (int rb_ = opq(REP_BAR); rb_ > 0; --rb_) gbar((unsigned*)(ws + WS_BAR), bst, wave);
            { pg8::Gemm g{h2, WX, MTOK, 2048, 1024, 1024, 1024, 31, 0}; S.init(MTOK, 2048, G, bid_s()); pg8::EpiLateGate<0> E{o, 2048, fin, inp(tb, 21) + slot * 2048}; pg8::gemm_phase(lds, g, S, E, wave); }
            for (int rb_ = opq(REP_BAR); rb_ > 0; --rb_) gbar((unsigned*)(ws + WS_BAR), bst, wave);
            { pg8::Gemm g{o, WOUT, MTOK, 1024, 2048, 2048, 2048, 31, 0}; S.init(MTOK, 1024, G, bid_s(), KS); pg8::EpiResid E{XR, modl + 2 * 1024, (float*)(ws + WS_PART_R)}; pg8::gemm_phase(lds, g, S, E, wave); }
            for (int rb_ = opq(REP_BAR); rb_ > 0; --rb_) gbar((unsigned*)(ws + WS_BAR), bst, wave);
        } else {
            bf16_t *xr = (bf16_t*)(ws + WS_LXR), *xc = (bf16_t*)(ws + WS_LXC), *la = (bf16_t*)(ws + WS_LLA), *uu = (bf16_t*)(ws + WS_LU), *rec = (bf16_t*)(ws + WS_LREC);
            float* agg = (float*)(ws + WS_LAGG);
            { pg8::Gemm g{hbuf, WIN, MTOK, 1024, 1024, 1024, 1024, 31, 0}; S.init(MTOK, 1024, G, bid_s()); pg8::EpiStore<0> E{xr, 1024}; pg8::gemm_phase(lds, g, S, E, wave); }
            for (int rb_ = opq(REP_BAR); rb_ > 0; --rb_) gbar((unsigned*)(ws + WS_BAR), bst, wave);
            for (int rp_ = opq(REP_LRU); rp_ > 0; --rp_) lru_conv_phase(xr, xc, inp(tb, 24) + slot * 4096, inp(tb, 25) + slot * 1024, wave);
            for (int rb_ = opq(REP_BAR); rb_ > 0; --rb_) gbar((unsigned*)(ws + WS_BAR), bst, wave);
            { pg8::Gemm g{xc, WX2, MTOK, 4096, 128, 1024, 128, 1, 256}; S.init(MTOK, 4096, G, bid_s());
              pg8::EpiLruGates E{xc, la, uu, inp(tb, 27) + slot * 2048, inp(tb, 29) + slot * 2048, inp(tb, 30) + slot * 2048}; pg8::gemm_phase(lds, g, S, E, wave); }
            for (int rb_ = opq(REP_BAR); rb_ > 0; --rb_) gbar((unsigned*)(ws + WS_BAR), bst, wave);
            for (int rp_ = opq(REP_LRU); rp_ > 0; --rp_) lru_scanA_phase(la, uu, agg, wave);
            for (int rb_ = opq(REP_BAR); rb_ > 0; --rb_) gbar((unsigned*)(ws + WS_BAR), bst, wave);
            for (int rp_ = opq(REP_LRU); rp_ > 0; --rp_) lru_scanC_phase(la, uu, agg, rec, inp(tb, 5) + slot * 2048, XR + OUT_LRU, wave);
            for (int rb_ = opq(REP_BAR); rb_ > 0; --rb_) gbar((unsigned*)(ws + WS_BAR), bst, wave);
            { pg8::Gemm g{hbuf, WX, MTOK, 1024, 1024, 1024, 1024, 31, 0}; S.init(MTOK, 1024, G, bid_s()); pg8::EpiLateGate<1> E{rec, 1024, nullptr, nullptr}; pg8::gemm_phase(lds, g, S, E, wave); }
            for (int rb_ = opq(REP_BAR); rb_ > 0; --rb_) gbar((unsigned*)(ws + WS_BAR), bst, wave);
            { pg8::Gemm g{rec, WOUT, MTOK, 1024, 1024, 1024, 1024, 31, 0}; S.init(MTOK, 1024, G, bid_s(), KS); pg8::EpiResid E{XR, modl + 2 * 1024, (float*)(ws + WS_PART_L)}; pg8::gemm_phase(lds, g, S, E, wave); }
            for (int rb_ = opq(REP_BAR); rb_ > 0; --rb_) gbar((unsigned*)(ws + WS_BAR), bst, wave);
        }
        norm_phase<false>(nullptr, nullptr, XR, inp(tb, 9) + layer * DM, modl, 3, hbuf, lane, gw, NGW, KS ? (const float*)(ws + (kind == 0 ? WS_PART_A : kind == 1 ? WS_PART_R : WS_PART_L)) : nullptr, modl + 2 * 1024);
        for (int rb_ = opq(REP_BAR); rb_ > 0; --rb_) gbar((unsigned*)(ws + WS_BAR), bst, wave);
        bf16_t* hid = (bf16_t*)(ws + WS_HID);
        for (int rp_ = opq(REP_UP); rp_ > 0; --rp_) { pg8::Gemm g{hbuf, WUP, MTOK, 4096, 1024, 1024, 1024, 31, 0}; S.init(MTOK, 4096, G, bid_s()); pg8::EpiStore<2> E{hid, 4096}; pg8::gemm_phase(lds, g, S, E, wave); }
        for (int rb_ = opq(REP_BAR); rb_ > 0; --rb_) gbar((unsigned*)(ws + WS_BAR), bst, wave);
        { pg8::Gemm g{hid, WDN, MTOK, 1024, 4096, 4096, 4096, 31, 0}; S.init(MTOK, 1024, G, bid_s(), KS); pg8::EpiResid E{XR, modl + 5 * 1024, (float*)(ws + WS_PART_M)}; pg8::gemm_phase(lds, g, S, E, wave); }
        for (int rb_ = opq(REP_BAR); rb_ > 0; --rb_) gbar((unsigned*)(ws + WS_BAR), bst, wave);
    }
    {
        const int layer = 3; const float* gate = modl + 5 * 1024; const float* part = (const float*)(ws + WS_PART_M); float* xo = XR;
        const int l_ = lane_id_v();
        for (int r = gw; r < MTOK; r += NGW) { const bf16_t* xb = (const bf16_t*)xo + (size_t)r * 2048; f32x4 v[4];
#pragma unroll
            for (int j = 0; j < 4; ++j) { const u32x2 w = *(const u32x2*)(xb + 4 * l_ + 256 * j); v[j] = (f32x4){bflo(w.x), bfhi(w.x), bflo(w.y), bfhi(w.y)}; }
            if (KS && r >= 32768) { const float* gp = gate + (size_t)modidx(r) * 6144;
#pragma unroll
                for (int j = 0; j < 4; ++j) { const int c = 4 * l_ + 256 * j; const float* pp = part + (size_t)(r - 32768) * DM + c;
                    const f32x4 ps = ((*(const f32x4*)pp + *(const f32x4*)(pp + (size_t)4096 * DM)) + *(const f32x4*)(pp + (size_t)2 * 4096 * DM)) + *(const f32x4*)(pp + (size_t)3 * 4096 * DM);
                    v[j] = v[j] + *(const f32x4*)(gp + c) * ps; } }
            asm volatile("s_waitcnt vmcnt(0)" ::: "memory");
#pragma unroll
            for (int j = 0; j < 4; ++j) *(f32x4*)(xo + (size_t)r * DM + 4 * l_ + 256 * j) = v[j];
        }
    }
}

#undef ws
#undef XR
#undef modt
#undef hbuf
#undef WUP
#undef WDN
#undef WIN
#undef WOUT
#undef WX
#undef WX2
#undef modl
#undef tb
extern "C" void kernel_launch(void* const* d_in, const int* in_sizes, int n_in, void* d_out, int out_size, void* d_ws, size_t ws_size, hipStream_t stream) {
    static int grid = 0;
    if (grid == 0) {
        int dev = 0, cus = 0, per_cu = 0;
        hipGetDevice(&dev); hipDeviceGetAttribute(&cus, hipDeviceAttributeMultiprocessorCount, dev);
        if (hipFuncSetAttribute((const void*)fwd_mega, hipFuncAttributeMaxDynamicSharedMemorySize, LDS_BYTES) != hipSuccess) { fprintf(stderr, "hipFuncSetAttribute failed\n"); grid = -1; return; }
        if (hipOccupancyMaxActiveBlocksPerMultiprocessor(&per_cu, (const void*)fwd_mega, 512, LDS_BYTES) != hipSuccess || per_cu < 1) { fprintf(stderr, "occupancy query: %d\n", per_cu); per_cu = 1; }
        (void)hipGetLastError();
        grid = cus * per_cu;
        if (grid != 256) { fprintf(stderr, "kernel_launch: this build needs exactly 256 resident workgroups (got %d)\n", grid); grid = -1; return; }
        if (n_in != 32 || ws_size < 512 * MiB) { fprintf(stderr, "kernel_launch: unexpected n_in %d / ws %zu\n", n_in, ws_size); grid = -1; return; }
    }
    if (grid < 0) return;
    KArgs a{};
    for (int i = 0; i < 32; ++i) a.in[i] = (const float*)d_in[i];
    a.out = (float*)d_out; a.ws = (unsigned char*)d_ws;
    if (hipMemsetAsync((char*)d_ws + WS_BAR, 0, 16384, stream) != hipSuccess) { fprintf(stderr, "memset failed\n"); return; }
    void* args[] = {&a};
    hipError_t e = hipLaunchCooperativeKernel((const void*)fwd_mega, dim3(grid), dim3(512), args, LDS_BYTES, stream);
    if (e != hipSuccess) fprintf(stderr, "cooperative launch failed: %s (grid %d)\n", hipGetErrorString(e), grid);
}
```

```cpp
#include <hip/hip_runtime.h>
#include <hip/hip_cooperative_groups.h>
#include <cstdio>
#include <cstdint>
namespace cg = cooperative_groups;

#define LAS __attribute__((address_space(3)))
typedef unsigned short bf16_t;
typedef short bf16x8 __attribute__((ext_vector_type(8)));
typedef short s16x4 __attribute__((ext_vector_type(4)));
typedef float f32x4 __attribute__((ext_vector_type(4)));
typedef float f32x2 __attribute__((ext_vector_type(2)));
typedef float f32x16 __attribute__((ext_vector_type(16)));
typedef unsigned u32x4 __attribute__((ext_vector_type(4)));
typedef unsigned u32x2 __attribute__((ext_vector_type(2)));

#define LOG2E 1.4426950408889634f
constexpr int DM = 1024, NPROMPT = 4096, MTOK = 36864, DFF = 4096;
constexpr size_t MiB = 1u << 20;
constexpr size_t WS_MOD = 1 * MiB;
constexpr size_t WS_WUP = 2 * MiB, WS_WDN = 10 * MiB, WS_WIN = 18 * MiB, WS_WOUT = 26 * MiB, WS_WX = 30 * MiB, WS_WX2 = 32 * MiB;
constexpr size_t WS_CK = 34 * MiB, WS_CV = 38 * MiB;
constexpr size_t WS_A = 44 * MiB;
constexpr size_t WS_H = 440 * MiB;
constexpr size_t WS_AQ = 44 * MiB, WS_AK = 116 * MiB, WS_AV = 134 * MiB, WS_AO = 152 * MiB;
constexpr size_t WS_RQ = 44 * MiB, WS_RK = 116 * MiB, WS_RV = 188 * MiB, WS_RO = 332 * MiB, WS_RSTP = 476 * MiB, WS_RFIN = 494 * MiB;
constexpr size_t WS_LXR = 368 * MiB, WS_LXC = 44 * MiB, WS_LLA = 116 * MiB, WS_LU = 260 * MiB, WS_LAGG = 404 * MiB, WS_LREC = 44 * MiB;
constexpr size_t WS_HID = 44 * MiB;
constexpr size_t WS_PART_A = 224 * MiB, WS_PART_R = 44 * MiB, WS_PART_L = 116 * MiB, WS_PART_M = 332 * MiB;
constexpr size_t OUT_K = 37748736, OUT_V = 39845888, OUT_RET = 41943040, OUT_LRU = 58720256;

__device__ __forceinline__ unsigned cvt_pk_bf16(float lo, float hi) { unsigned r; asm volatile("v_cvt_pk_bf16_f32 %0, %1, %2" : "=v"(r) : "v"(lo), "v"(hi)); return r; }
__device__ __forceinline__ float bf2f(unsigned short b) { return __uint_as_float((unsigned)b << 16); }
__device__ __forceinline__ float bflo(unsigned w) { return __uint_as_float(w << 16); }
__device__ __forceinline__ float bfhi(unsigned w) { return __uint_as_float(w & 0xffff0000u); }
__device__ __forceinline__ f32x4 ld4bf(const bf16_t* p) { const u32x2 w = *(const u32x2*)p; return (f32x4){bflo(w.x), bfhi(w.x), bflo(w.y), bfhi(w.y)}; }
__device__ __forceinline__ float fsigmoid(float x) { return __builtin_amdgcn_rcpf(1.f + __expf(-x)); }
__device__ __forceinline__ float fsilu(float x) { return x * fsigmoid(x); }
__device__ __forceinline__ float fgelu_tanh(float x) { const float u = 0.7978845608028654f * (x + 0.044715f * x * x * x); return x * fsigmoid(2.f * u); }
__device__ __forceinline__ int launder(int v) { asm volatile("" : "+v"(v)); return v; }
__device__ __forceinline__ int lane_id_v() { int l; asm volatile("v_mbcnt_lo_u32_b32 %0, -1, 0\n\tv_mbcnt_hi_u32_b32 %0, -1, %0" : "=v"(l)); return l; }
__device__ __forceinline__ int bid_s() { const int b = *(volatile LAS int*)(uintptr_t)143368u; return __builtin_amdgcn_readfirstlane(b); }
__device__ __forceinline__ int wave_id_s() { return __builtin_amdgcn_readfirstlane(__builtin_amdgcn_workitem_id_x() >> 6); }
__device__ __forceinline__ unsigned char* karg_ptr(int off) {
#if defined(__HIP_DEVICE_COMPILE__)
    unsigned long long v; auto ka = __builtin_amdgcn_kernarg_segment_ptr();
    if (off == 256) asm volatile("s_load_dwordx2 %0, %1, 0x100\n\ts_waitcnt lgkmcnt(0)" : "=s"(v) : "s"(ka));
    else asm volatile("s_load_dwordx2 %0, %1, 0x108\n\ts_waitcnt lgkmcnt(0)" : "=s"(v) : "s"(ka));
    return (unsigned char*)v;
#else
    (void)off; return nullptr;
#endif
}
__device__ __forceinline__ int modidx(int r) { return r < NPROMPT ? 0 : 1 + ((r - NPROMPT) >> 12); }
__device__ __forceinline__ void rope_cs(float pos, float inv, float& c, float& s) {
    float rev = pos * inv * 0.15915494309189535f; rev -= rintf(rev);
    s = __builtin_amdgcn_sinf(rev); c = __builtin_amdgcn_cosf(rev);
}

namespace pg8 {
constexpr int BM = 256, BK = 64, HALF = 128, HTB = HALF * BK * 2, STAGE_BYTES = 8 * HTB, NXCD = 8, WGM = 8;
__host__ __device__ __forceinline__ int lds_byte(int r, int c) { const int st = (r >> 4) * 2 + (c >> 5), rr = r & 15, cc = c & 31, ob = rr * 64 + cc * 2; return st * 1024 + (ob ^ (((ob >> 9) & 1) << 5)); }
__host__ __device__ __forceinline__ void stage_rc(int b, int& R, int& C) { const int st = b / 1024, sb = b % 1024, swz = sb ^ (((sb >> 9) & 1) << 5); R = (st >> 1) * 16 + swz / 64; C = (st & 1) * 32 + (swz % 64) / 2; }
__host__ __device__ __forceinline__ int perm32(int rho) { const int n = rho >> 4, i = rho & 15; return 8 * (i >> 2) + 4 * n + (i & 3); }
struct Unit { int pm, pn, kq; };
struct Gemm { const bf16_t* A; const bf16_t* Bt; int M, N, K, lda, ldb, ash, astep; };
struct StaticOrder {
    int nM, nN, nwg, G, c, ks;
    __device__ void init(int M, int N, int G_, int c_, int ks_ = 0) { nM = M / BM; nN = N / BM; nwg = nM * nN; G = G_; c = c_; ks = ks_; }
    __device__ bool next(int i, Unit& u) const {
        if (ks) { if (i < 2) { const int j = i * 32 + (c >> 3), xx = c & 7; u.pm = 16 * xx + (j >> 2); u.pn = j & 3; u.kq = -1; return true; }
                  if (i == 2) { const int t = c >> 2; u.pm = 128 + (t >> 2); u.pn = t & 3; u.kq = c & 3; return true; } return false; }
        u.kq = -1;
        const int L = i * G + c; if (L >= nwg) return false;
        int wgid = L; { const int q = nwg / NXCD, r = nwg % NXCD, xcd = wgid % NXCD, off = wgid / NXCD; wgid = (xcd < r ? xcd * (q + 1) : r * (q + 1) + (xcd - r) * q) + off; }
        const int nig = WGM * nN, gid = wgid / nig, fm = gid * WGM, gsz = (nM - fm) < WGM ? (nM - fm) : WGM;
        u.pm = fm + ((wgid % nig) % gsz); u.pn = (wgid % nig) / gsz; return true;
    }
};

template <class Epi>
__device__ __forceinline__ void gemm_phase(LAS unsigned char* lds, const Gemm g, const StaticOrder& S, const Epi& E, const int wv) {
    const int wid = wv, lane = lane_id_v(), tid = wid * 64 + lane, wr = wid >> 2, wc = wid & 3, fr = lane & 15, fq = lane >> 4;
    int K_ = g.K; asm volatile("" : "+s"(K_));
    const int K = K_, nt = K / BK;
    unsigned voffA[2], voffB[2];
#pragma unroll
    for (int i = 0; i < 2; ++i) { int R, C; stage_rc(tid * 16 + i * 8192, R, C); const int Rb = Epi::PERM ? ((R & ~31) + perm32(R & 31)) : R;
        voffA[i] = (unsigned)(R * g.lda + C) * 2u; voffB[i] = (unsigned)(Rb * g.ldb + C) * 2u; }
    const unsigned kstep = (unsigned)(BK * 2);
    const unsigned hA = (unsigned)HALF * g.lda * 2u, hB = (unsigned)HALF * g.ldb * 2u, tA = 2u * hA, tB = 2u * hB;
    const unsigned ldsw = (unsigned)wid * 1024u;
    const int aoff = lds_byte(wr * 64 + fr, fq * 8), boff = lds_byte(wc * 32 + fr, fq * 8);
#define PG8_SA(b, h) (((b) * 2 + (h)) * HTB)
#define PG8_SB(b, h) ((4 + (b) * 2 + (h)) * HTB)
#define PG8_STAGE(bufoff, gbase, voff) do { _Pragma("unroll") for (int _i = 0; _i < 2; ++_i) \
        __builtin_amdgcn_global_load_lds((const unsigned*)((const char*)(gbase) + (voff)[_i]), (LAS unsigned*)(lds + (bufoff) + ldsw + _i * 8192), 16, 0, 0); } while (0)
#define PG8_LDA(dst, b, h) do { _Pragma("unroll") for (int m = 0; m < 4; ++m) _Pragma("unroll") for (int k = 0; k < 2; ++k) dst[m][k] = *(const LAS bf16x8*)(lds + PG8_SA(b, h) + aoff + m * 2048 + k * 1024); } while (0)
#define PG8_LDB(dst, b, h) do { _Pragma("unroll") for (int n = 0; n < 2; ++n) _Pragma("unroll") for (int k = 0; k < 2; ++k) dst[n][k] = *(const LAS bf16x8*)(lds + PG8_SB(b, h) + boff + n * 2048 + k * 1024); } while (0)
#define PG8_MMA(ai, bj, At, Bt) do { __builtin_amdgcn_s_setprio(1); _Pragma("unroll") for (int m = 0; m < 4; ++m) _Pragma("unroll") for (int n = 0; n < 2; ++n) _Pragma("unroll") for (int k = 0; k < 2; ++k) \
        acc[ai][bj][m][n] = __builtin_amdgcn_mfma_f32_16x16x32_bf16(Bt[n][k], At[m][k], acc[ai][bj][m][n], 0, 0, 0); __builtin_amdgcn_s_setprio(0); } while (0)
#define PG8_WAIT_V(n) asm volatile("s_waitcnt vmcnt(" #n ")" ::: "memory")
#define PG8_WAIT_L(n) asm volatile("s_waitcnt lgkmcnt(" #n ")" ::: "memory")
#define PG8_BAR __builtin_amdgcn_s_barrier()
#define PG8_SCHED __builtin_amdgcn_sched_barrier(0)
    Unit cur, nxt; int ui = 0;
    if (!S.next(0, cur)) return;
    f32x4 acc[2][2][4][2];
#pragma unroll
    for (int a = 0; a < 2; ++a)
#pragma unroll
        for (int b = 0; b < 2; ++b)
#pragma unroll
            for (int m = 0; m < 4; ++m)
#pragma unroll
                for (int n = 0; n < 2; ++n) acc[a][b][m][n] = (f32x4){0.f, 0.f, 0.f, 0.f};
    bf16x8 At[4][2], B0[2][2], B1[2][2];
    const int ntq = nt >> 2;
    int cnt = cur.kq >= 0 ? ntq : nt;
    const unsigned cko = cur.kq >= 0 ? (unsigned)(cur.kq * ntq) * kstep : 0u;
    const char* cA = (const char*)g.A + ((unsigned)cur.pm * tA + (unsigned)(cur.pn >> g.ash) * (unsigned)g.astep + cko);
    const char* cB = (const char*)g.Bt + ((unsigned)cur.pn * tB + cko);
    PG8_STAGE(PG8_SB(0, 0), cB, voffB); PG8_STAGE(PG8_SB(0, 1), cB + hB, voffB); PG8_STAGE(PG8_SA(0, 0), cA, voffA); PG8_STAGE(PG8_SA(0, 1), cA + hA, voffA);
    if (wr == 1) PG8_BAR;
    PG8_WAIT_V(2); PG8_BAR;
    PG8_STAGE(PG8_SB(1, 0), cB + kstep, voffB); PG8_STAGE(PG8_SA(1, 0), cA + kstep, voffA); PG8_STAGE(PG8_SB(1, 1), cB + hB + kstep, voffB);
    PG8_WAIT_V(6); PG8_BAR;
    for (;;) {
        const bool has_next = S.next(ui + 1, nxt);
        const unsigned nko = (has_next && nxt.kq >= 0) ? (unsigned)(nxt.kq * ntq) * kstep : 0u;
        const char* nA = has_next ? (const char*)g.A + ((unsigned)nxt.pm * tA + (unsigned)(nxt.pn >> g.ash) * (unsigned)g.astep + nko) : cA; const char* nB = has_next ? (const char*)g.Bt + ((unsigned)nxt.pn * tB + nko) : cB;
        for (int t = 0; t < cnt; t += 2) {
            const bool last = (t == cnt - 2);
            const char* a1 = cA + (unsigned)(t + 1) * kstep;
            const char* a2 = last ? nA : cA + (unsigned)(t + 2) * kstep; const char* b2 = last ? nB : cB + (unsigned)(t + 2) * kstep;
            const char* a3 = a2 + kstep; const char* b3 = b2 + kstep;
            PG8_LDB(B0, 0, 0); PG8_LDB(B1, 0, 1); PG8_SCHED; PG8_LDA(At, 0, 0); PG8_STAGE(PG8_SA(1, 1), a1 + hA, voffA);
            PG8_WAIT_V(8); PG8_WAIT_L(0); PG8_BAR; PG8_MMA(0, 0, At, B0); PG8_MMA(0, 1, At, B1); PG8_BAR; PG8_SCHED;
            PG8_LDA(At, 0, 1); PG8_STAGE(PG8_SB(0, 0), b2, voffB); PG8_STAGE(PG8_SB(0, 1), b2 + hB, voffB); PG8_STAGE(PG8_SA(0, 0), a2, voffA);
            PG8_WAIT_V(8); PG8_WAIT_L(0); PG8_BAR; PG8_MMA(1, 0, At, B0); PG8_MMA(1, 1, At, B1); PG8_BAR; PG8_SCHED;
            PG8_LDB(B0, 1, 0); PG8_LDB(B1, 1, 1); PG8_SCHED; PG8_LDA(At, 1, 0); PG8_STAGE(PG8_SA(0, 1), a2 + hA, voffA);
            PG8_WAIT_V(8); PG8_WAIT_L(0); PG8_BAR; PG8_MMA(0, 0, At, B0); PG8_MMA(0, 1, At, B1); PG8_BAR; PG8_SCHED;
            PG8_LDA(At, 1, 1); PG8_STAGE(PG8_SB(1, 0), b3, voffB); PG8_STAGE(PG8_SB(1, 1), b3 + hB, voffB); PG8_STAGE(PG8_SA(1, 0), a3, voffA);
            PG8_WAIT_V(8); PG8_WAIT_L(0); PG8_BAR; PG8_MMA(1, 0, At, B0); PG8_MMA(1, 1, At, B1); PG8_BAR; PG8_SCHED;
        }
        if (wr == 0) PG8_BAR;
        E(acc, cur, wr, wc, fr, fq);
        if (!has_next) break;
#pragma unroll
        for (int a = 0; a < 2; ++a)
#pragma unroll
            for (int b = 0; b < 2; ++b)
#pragma unroll
                for (int m = 0; m < 4; ++m)
#pragma unroll
                    for (int n = 0; n < 2; ++n) acc[a][b][m][n] = (f32x4){0.f, 0.f, 0.f, 0.f};
        cur = nxt; cA = nA; cB = nB; ++ui; cnt = cur.kq >= 0 ? ntq : nt;
        if (wr == 1) PG8_BAR;
    }
    PG8_WAIT_V(0);
    PG8_BAR;
#undef PG8_SA
#undef PG8_SB
#undef PG8_STAGE
#undef PG8_LDA
#undef PG8_LDB
#undef PG8_MMA
#undef PG8_WAIT_V
#undef PG8_WAIT_L
#undef PG8_BAR
#undef PG8_SCHED
}

template <int ACT> struct EpiStore {
    static constexpr bool PERM = true;
    bf16_t* O; int ldc;
    __device__ __forceinline__ void operator()(const f32x4 (&acc)[2][2][4][2], const Unit& u, int wr, int wc, int fr, int fq) const {
        fr = launder(fr); fq = launder(fq);
        const int row0 = u.pm * BM + wr * 64 + fr, col0 = u.pn * BM + wc * 32 + 8 * fq;
#pragma unroll
        for (int ai = 0; ai < 2; ++ai)
#pragma unroll
            for (int m = 0; m < 4; ++m) { bf16_t* rowp = O + (size_t)(row0 + ai * HALF + m * 16) * ldc + col0;
#pragma unroll
                for (int bj = 0; bj < 2; ++bj) { f32x4 v0 = acc[ai][bj][m][0], v1 = acc[ai][bj][m][1];
                    if (ACT == 2) {
#pragma unroll
                        for (int e = 0; e < 4; ++e) { const float a = fmaxf(v0[e], 0.f), b = fmaxf(v1[e], 0.f); v0[e] = a * a; v1[e] = b * b; } }
                    u32x4 w; w.x = cvt_pk_bf16(v0[0], v0[1]); w.y = cvt_pk_bf16(v0[2], v0[3]); w.z = cvt_pk_bf16(v1[0], v1[1]); w.w = cvt_pk_bf16(v1[2], v1[3]);
                    *(u32x4*)(rowp + bj * HALF) = w; } asm volatile("" ::: "memory"); }
    }
};
struct EpiResid {
    static constexpr bool PERM = true;
    float* x; const float* gate; float* part;
    __device__ __forceinline__ void operator()(const f32x4 (&acc)[2][2][4][2], const Unit& u, int wr, int wc, int fr, int fq) const {
        fr = launder(fr); fq = launder(fq);
        const int row0 = u.pm * BM + wr * 64 + fr, col0 = u.pn * BM + wc * 32 + 8 * fq;
        if (u.kq >= 0) {
#pragma unroll
            for (int ai = 0; ai < 2; ++ai)
#pragma unroll
                for (int m = 0; m < 4; ++m) { bf16_t* rowp = (bf16_t*)part + ((size_t)u.kq * 4096 + (row0 + ai * HALF + m * 16 - 32768)) * DM + col0;
#pragma unroll
                    for (int bj = 0; bj < 2; ++bj) { const f32x4 a0 = acc[ai][bj][m][0], a1 = acc[ai][bj][m][1];
                        u32x4 o; o.x = cvt_pk_bf16(a0[0], a0[1]); o.y = cvt_pk_bf16(a0[2], a0[3]); o.z = cvt_pk_bf16(a1[0], a1[1]); o.w = cvt_pk_bf16(a1[2], a1[3]); *(u32x4*)(rowp + bj * HALF) = o; } }
            return;
        }
        const float* gp = gate + (size_t)modidx(u.pm * BM) * 6144 + col0;
        f32x4 gv[2][2];
#pragma unroll
        for (int bj = 0; bj < 2; ++bj)
#pragma unroll
            for (int n = 0; n < 2; ++n) gv[bj][n] = *(const f32x4*)(gp + bj * HALF + 4 * n);
#pragma unroll
        for (int ai = 0; ai < 2; ++ai)
#pragma unroll
            for (int m = 0; m < 4; ++m) { bf16_t* rowp = (bf16_t*)x + (size_t)(row0 + ai * HALF + m * 16) * 2048 + col0;
#pragma unroll
                for (int bj = 0; bj < 2; ++bj) { u32x4* p = (u32x4*)(rowp + bj * HALF); const u32x4 w = *p;
                    const f32x4 xa = (f32x4){bflo(w.x), bfhi(w.x), bflo(w.y), bfhi(w.y)} + gv[bj][0] * acc[ai][bj][m][0], xb = (f32x4){bflo(w.z), bfhi(w.z), bflo(w.w), bfhi(w.w)} + gv[bj][1] * acc[ai][bj][m][1];
                    u32x4 o; o.x = cvt_pk_bf16(xa[0], xa[1]); o.y = cvt_pk_bf16(xa[2], xa[3]); o.z = cvt_pk_bf16(xb[0], xb[1]); o.w = cvt_pk_bf16(xb[2], xb[3]); *p = o; }
                asm volatile("" ::: "memory"); }
    }
};
__device__ __forceinline__ void st4(bf16_t* p, const f32x4 v) { u32x2 w; w.x = cvt_pk_bf16(v[0], v[1]); w.y = cvt_pk_bf16(v[2], v[3]); *(u32x2*)p = w; }
struct EpiAttnQKV {
    static constexpr bool PERM = false;
    bf16_t *q, *k, *v; float *nk, *nv; const float *qg, *kg; int slot;
    __device__ __forceinline__ void operator()(const f32x4 (&acc)[2][2][4][2], const Unit& u, int wr, int wc, int fr, int fq) const {
        fr = launder(fr); fq = launder(fq);
        const int pn = u.pn;
#pragma unroll
        for (int ai = 0; ai < 2; ++ai)
#pragma unroll
            for (int m = 0; m < 4; ++m) {
                const int r = u.pm * BM + ai * HALF + wr * 64 + m * 16 + fr;
                f32x4 v00 = acc[ai][0][m][0], v01 = acc[ai][0][m][1], v10 = acc[ai][1][m][0], v11 = acc[ai][1][m][1];
                if (pn < 5) {
                    float ss = 0.f;
#pragma unroll
                    for (int e = 0; e < 4; ++e) ss += v00[e] * v00[e] + v01[e] * v01[e] + v10[e] * v10[e] + v11[e] * v11[e];
                    ss += __shfl_xor(ss, 16); ss += __shfl_xor(ss, 32);
                    const float rs = rsqrtf(ss * (1.f / 64.f) + 1e-6f);
                    const float* gn = (pn < 4 ? qg : kg) + 4 * fq;
                    v00 = v00 * rs * *(const f32x4*)(gn); v01 = v01 * rs * *(const f32x4*)(gn + 16); v10 = v10 * rs * *(const f32x4*)(gn + 32); v11 = v11 * rs * *(const f32x4*)(gn + 48);
                    if (r >= NPROMPT) {
                        const int t = (r - NPROMPT) & 4095; const float rp = (float)(t >> 6), cp = (float)(t & 63);
#pragma unroll
                        for (int e = 0; e < 4; ++e) {
                            const float inv = __builtin_amdgcn_exp2f(-(float)(4 * fq + e) * (13.287712379549449f / 16.f)); float c, s;
                            rope_cs(rp, inv, c, s); { const float x1 = v00[e], x2 = v01[e]; v00[e] = x1 * c - x2 * s; v01[e] = x2 * c + x1 * s; }
                            rope_cs(cp, inv, c, s); { const float x1 = v10[e], x2 = v11[e]; v10[e] = x1 * c - x2 * s; v11[e] = x2 * c + x1 * s; }
                        }
                    }
                }
                if (pn < 4) {
                    bf16_t* d = q + (size_t)r * 1024 + (4 * pn + wc) * 64 + 4 * fq;
                    constexpr float QS = 0.125f * LOG2E; st4(d, v00 * QS); st4(d + 16, v01 * QS); st4(d + 32, v10 * QS); st4(d + 48, v11 * QS);
                } else {
                    bf16_t* d = (pn == 4 ? k : v) + (size_t)r * 256 + wc * 64 + 4 * fq;
                    st4(d, v00); st4(d + 16, v01); st4(d + 32, v10); st4(d + 48, v11);
                    if (r < NPROMPT) { const int b = r >> 8, t = r & 255; float* o = (pn == 4 ? nk : nv) + ((size_t)(b * 2 + slot) * 256 + t) * 256 + wc * 64 + 4 * fq;
                        *(f32x4*)o = v00; *(f32x4*)(o + 16) = v01; *(f32x4*)(o + 32) = v10; *(f32x4*)(o + 48) = v11; }
                }
            }
    }
};
struct EpiRetQKV {
    static constexpr bool PERM = false;
    bf16_t *q, *k, *v;
    __device__ __forceinline__ void operator()(const f32x4 (&acc)[2][2][4][2], const Unit& u, int wr, int wc, int fr, int fq) const {
        fr = launder(fr); fq = launder(fq);
        const int pn = u.pn;
#pragma unroll
        for (int ai = 0; ai < 2; ++ai)
#pragma unroll
            for (int m = 0; m < 4; ++m) {
                const int r = u.pm * BM + ai * HALF + wr * 64 + m * 16 + fr;
                f32x4 v00 = acc[ai][0][m][0], v01 = acc[ai][0][m][1], v10 = acc[ai][1][m][0], v11 = acc[ai][1][m][1];
                if (pn < 8) {
                    if (r >= NPROMPT) {
                        const int t = (r - NPROMPT) & 4095; const float rp = (float)(t >> 6), cp = (float)(t & 63);
#pragma unroll
                        for (int e = 0; e < 4; ++e) {
                            const float inv = __builtin_amdgcn_exp2f(-(float)(16 * wc + 4 * fq + e) * (13.287712379549449f / 64.f)); float c, s;
                            rope_cs(rp, inv, c, s); { const float x1 = v00[e], x2 = v01[e]; v00[e] = x1 * c - x2 * s; v01[e] = x2 * c + x1 * s; }
                            rope_cs(cp, inv, c, s); { const float x1 = v10[e], x2 = v11[e]; v10[e] = x1 * c - x2 * s; v11[e] = x2 * c + x1 * s; }
                        }
                    }
                    if (pn >= 4) { v00 = v00 * 0.0625f; v01 = v01 * 0.0625f; v10 = v10 * 0.0625f; v11 = v11 * 0.0625f; }
                }
                bf16_t* d = (pn < 4 ? q + (size_t)r * 1024 + pn * 256 : pn < 8 ? k + (size_t)r * 1024 + (pn - 4) * 256 : v + (size_t)r * 2048 + (pn - 8) * 256) + 16 * wc + 4 * fq;
                st4(d, v00); st4(d + 64, v01); st4(d + 128, v10); st4(d + 192, v11);
            }
    }
};
template <int MODE> struct EpiLateGate {
    static constexpr bool PERM = true;
    bf16_t* Z; int ldz; const float* fin; const float* gn;
    __device__ __forceinline__ void operator()(const f32x4 (&acc)[2][2][4][2], const Unit& u, int wr, int wc, int fr, int fq) const {
        fr = launder(fr); fq = launder(fq);
        const int row0 = u.pm * BM + wr * 64 + fr, col0 = u.pn * BM + wc * 32 + 8 * fq;
#pragma unroll
        for (int ai = 0; ai < 2; ++ai)
#pragma unroll
            for (int m = 0; m < 4; ++m) { const int r = row0 + ai * HALF + m * 16;
#pragma unroll
                for (int bj = 0; bj < 2; ++bj) { const int c0 = col0 + bj * HALF; bf16_t* zp = Z + (size_t)r * ldz + c0;
                    const u32x4 zw = *(const u32x4*)zp; float z[8] = {bflo(zw.x), bfhi(zw.x), bflo(zw.y), bfhi(zw.y), bflo(zw.z), bfhi(zw.z), bflo(zw.w), bfhi(zw.w)};
                    float a[8]; { const f32x4 a0 = acc[ai][bj][m][0], a1 = acc[ai][bj][m][1]; a[0] = a0[0]; a[1] = a0[1]; a[2] = a0[2]; a[3] = a0[3]; a[4] = a1[0]; a[5] = a1[1]; a[6] = a1[2]; a[7] = a1[3]; }
                    float y[8];
                    if (MODE == 0) { const f32x2 st = *(const f32x2*)(fin + ((size_t)r * 4 + (c0 >> 9)) * 2); const f32x4 g0 = *(const f32x4*)(gn + c0), g1 = *(const f32x4*)(gn + c0 + 4);
                        const float gg[8] = {g0[0], g0[1], g0[2], g0[3], g1[0], g1[1], g1[2], g1[3]};
#pragma unroll
                        for (int e = 0; e < 8; ++e) y[e] = fsilu(a[e]) * ((z[e] - st.x) * st.y * gg[e]);
                    } else {
#pragma unroll
                        for (int e = 0; e < 8; ++e) y[e] = fgelu_tanh(a[e]) * z[e];
                    }
                    u32x4 w; w.x = cvt_pk_bf16(y[0], y[1]); w.y = cvt_pk_bf16(y[2], y[3]); w.z = cvt_pk_bf16(y[4], y[5]); w.w = cvt_pk_bf16(y[6], y[7]);
                    *(u32x4*)zp = w; asm volatile("" ::: "memory"); } }
    }
};
struct EpiLruGates {
    static constexpr bool PERM = false;
    const bf16_t* xc; bf16_t *la, *uu; const float *br, *bi, *lam;
    __device__ __forceinline__ void operator()(const f32x4 (&acc)[2][2][4][2], const Unit& u, int wr, int wc, int fr, int fq) const {
        fr = launder(fr); fq = launder(fq);
        const int nb = u.pn >> 1, dir = u.pn & 1;
#pragma unroll
        for (int bj = 0; bj < 2; ++bj) {
            const int ch = nb * 128 + 64 * bj + 16 * wc + 4 * fq;
            const f32x4 brv = *(const f32x4*)(br + dir * 1024 + ch), biv = *(const f32x4*)(bi + dir * 1024 + ch), lv = *(const f32x4*)(lam + dir * 1024 + ch);
            f32x4 sp;
#pragma unroll
            for (int e = 0; e < 4; ++e) sp[e] = -8.f * __logf(1.f + __expf(-lv[e]));
#pragma unroll
            for (int ai = 0; ai < 2; ++ai)
#pragma unroll
                for (int m = 0; m < 4; ++m) {
                    const int r = u.pm * BM + ai * HALF + wr * 64 + m * 16 + fr;
                    const u32x2 xw = *(const u32x2*)(xc + (size_t)r * 1024 + ch); const float xv[4] = {bflo(xw.x), bfhi(xw.x), bflo(xw.y), bfhi(xw.y)};
                    const f32x4 rp = acc[ai][bj][m][0], ip = acc[ai][bj][m][1]; f32x4 lo, uo;
#pragma unroll
                    for (int e = 0; e < 4; ++e) { const float pa = 1.f + __expf(-(rp[e] + brv[e])), pb = 1.f + __expf(-(ip[e] + biv[e])); const float inv = __builtin_amdgcn_rcpf(pa * pb);
                        const float rg = pb * inv, ig = pa * inv; const float l = rg * sp[e]; lo[e] = l; uo[e] = __builtin_amdgcn_sqrtf(fmaxf(1.f - __expf(2.f * l), 0.f)) * ig * xv[e]; }
                    st4(la + ((size_t)r * 2 + dir) * 1024 + ch, lo); st4(uu + ((size_t)r * 2 + dir) * 1024 + ch, uo);
                    asm volatile("" ::: "memory");
                }
        }
    }
};
}
using pg8::st4;

struct KArgs { const float* in[32]; float* out; unsigned char* ws; };
struct KTab { const float* const* t; };
__device__ __forceinline__ const float* inp(const KTab& a, int k) { return a.t[k]; }
__device__ __forceinline__ const float* inp(const KArgs& a, int k) { return a.in[k]; }

__device__ __forceinline__ float wave_sum(float v) {
#pragma unroll
    for (int o = 1; o < 64; o <<= 1) v += __shfl_xor(v, o);
    return v;
}
__device__ __forceinline__ float wave_max(float v) {
#pragma unroll
    for (int o = 1; o < 64; o <<= 1) v = fmaxf(v, __shfl_xor(v, o));
    return v;
}

template <int MODE>
__device__ __forceinline__ const float* wcol(const float* s0, const float* s1, int n) {
    if (MODE == 0) return s0 + n;
    if (MODE == 1) { const int gp = (n >> 5) & 7, bj = gp >> 2, wc = gp & 3; return s0 + (n & ~255) + (2 * wc + bj) * 32 + (n & 31); }
    if (MODE == 2) { const int p = n & 255, bj = p >> 7, wc = (p >> 5) & 3, nn = (p >> 4) & 1, r = p & 15; return s0 + (n & ~255) + 128 * bj + 64 * nn + 16 * wc + r; }
    { const int pn = n >> 8, nb = pn >> 1, dir = pn & 1, p = n & 255, bj = p >> 7, wc = (p >> 5) & 3, nn = (p >> 4) & 1, r = p & 15; const int cb = 64 * bj + 16 * wc + r;
      return (nn ? s1 : s0) + (size_t)(dir * 8 + nb) * 16384 + cb; }
}
template <int MODE>
__device__ __forceinline__ void wconv(const float* s0, const float* s1, int ld, int K, int N, bf16_t* WT, LAS float* scr, int lane_, int gw, int NGW) {
    const int lane = lane_id_v(); (void)lane_; asm volatile("" : "+s"(gw));
    const int nblk = N / 32, nitems = (K / 64) * nblk;
    for (int item = gw; item < nitems; item += NGW) {
        const int kb = item / nblk, nb = item % nblk, k0 = 64 * kb, n0 = 32 * nb;
        const float* cp = wcol<MODE>(s0, s1, n0 + (lane & 31));
#pragma unroll 8
        for (int i = 0; i < 32; ++i) { const int kk = 2 * i + (lane >> 5); scr[kk * 33 + (lane & 31)] = cp[(size_t)(k0 + kk) * ld]; }
        asm volatile("s_waitcnt lgkmcnt(0)" ::: "memory");
        const int c = lane & 7;
#pragma unroll
        for (int j = 0; j < 4; ++j) { const int n = (lane >> 3) + 8 * j; const LAS float* s = scr + (8 * c) * 33 + n;
            u32x4 o; o.x = cvt_pk_bf16(s[0 * 33], s[1 * 33]); o.y = cvt_pk_bf16(s[2 * 33], s[3 * 33]); o.z = cvt_pk_bf16(s[4 * 33], s[5 * 33]); o.w = cvt_pk_bf16(s[6 * 33], s[7 * 33]);
            *(u32x4*)(WT + (size_t)(n0 + n) * K + k0 + 8 * c) = o; }
        asm volatile("s_waitcnt lgkmcnt(0)" ::: "memory");
    }
}
template <class AT>
__device__ __forceinline__ void convert_layer_weights(const AT& a, unsigned char* ws, int layer, LAS unsigned char* lds, int wave, int lane, int gw, int NGW) {
    LAS float* scr = (LAS float*)(lds + wave * 8448);
    wconv<0>(inp(a, 12) + (size_t)layer * DM * DFF, nullptr, DFF, DM, DFF, (bf16_t*)(ws + WS_WUP), scr, lane, gw, NGW);
    wconv<0>(inp(a, 13) + (size_t)layer * DFF * DM, nullptr, DM, DFF, DM, (bf16_t*)(ws + WS_WDN), scr, lane, gw, NGW);
    const int kind = layer % 3, slot = layer / 3;
    if (kind == 0) {
        wconv<1>(inp(a, 14) + (size_t)slot * DM * 1536, nullptr, 1536, DM, 1536, (bf16_t*)(ws + WS_WIN), scr, lane, gw, NGW);
        wconv<0>(inp(a, 15) + (size_t)slot * DM * DM, nullptr, DM, DM, DM, (bf16_t*)(ws + WS_WOUT), scr, lane, gw, NGW);
    } else if (kind == 1) {
        wconv<2>(inp(a, 19) + (size_t)slot * DM * 6144, nullptr, 6144, DM, 4096, (bf16_t*)(ws + WS_WIN), scr, lane, gw, NGW);
        wconv<0>(inp(a, 19) + (size_t)slot * DM * 6144 + 4096, nullptr, 6144, DM, 2048, (bf16_t*)(ws + WS_WX), scr, lane, gw, NGW);
        wconv<0>(inp(a, 20) + (size_t)slot * 2048 * DM, nullptr, DM, 2048, DM, (bf16_t*)(ws + WS_WOUT), scr, lane, gw, NGW);
    } else {
        wconv<0>(inp(a, 23) + (size_t)slot * DM * 2048 + 1024, nullptr, 2048, DM, 1024, (bf16_t*)(ws + WS_WIN), scr, lane, gw, NGW);
        wconv<0>(inp(a, 23) + (size_t)slot * DM * 2048, nullptr, 2048, DM, 1024, (bf16_t*)(ws + WS_WX), scr, lane, gw, NGW);
        wconv<3>(inp(a, 26) + (size_t)slot * 2 * 8 * 16384, inp(a, 28) + (size_t)slot * 2 * 8 * 16384, 128, 128, 4096, (bf16_t*)(ws + WS_WX2), scr, lane, gw, NGW);
        wconv<0>(inp(a, 31) + (size_t)slot * DM * DM, nullptr, DM, DM, DM, (bf16_t*)(ws + WS_WOUT), scr, lane, gw, NGW);
    }
}

__device__ __forceinline__ void mod_phase(const KArgs& a, LAS unsigned char* lds, const int wv) {
    LAS float* sc = (LAS float*)lds;
    LAS float* red = (LAS float*)(lds + 36864);
    const int tid = (wv * 64 + lane_id_v());
    if (bid_s() >= 384) return;
    for (int i = tid; i < 9 * 1024; i += 512) { const int j = i >> 10, k = i & 1023; const float v = j == 0 ? inp(a, 7)[k] : inp(a, 6)[(j - 1) * 1024 + k]; sc[i] = fsilu(v); }
    __syncthreads();
    float* modt = (float*)(a.ws + WS_MOD);
    const int cl = tid & 63, ks = tid >> 6;
    for (int item = bid_s(); item < 384; item += gridDim.x) {
        const int l = item / 96, cg_ = item % 96, col = cg_ * 64 + cl;
        const float* w = inp(a, 10) + (size_t)l * DM * 6144 + col;
        float acc[9];
#pragma unroll
        for (int j = 0; j < 9; ++j) acc[j] = 0.f;
        for (int k0 = ks * 128; k0 < ks * 128 + 128; k0 += 16) {
            float wv[16];
#pragma unroll
            for (int u = 0; u < 16; ++u) wv[u] = w[(size_t)(k0 + u) * 6144];
#pragma unroll
            for (int u = 0; u < 16; ++u)
#pragma unroll
                for (int j = 0; j < 9; ++j) acc[j] += sc[j * 1024 + k0 + u] * wv[u];
        }
#pragma unroll
        for (int j = 0; j < 9; ++j) red[(ks * 9 + j) * 64 + cl] = acc[j];
        __syncthreads();
        for (int idx = tid; idx < 576; idx += 512) { const int j = idx >> 6, c2 = idx & 63; float s = inp(a, 11)[(size_t)l * 6144 + cg_ * 64 + c2];
#pragma unroll
            for (int q = 0; q < 8; ++q) s += red[(q * 9 + j) * 64 + c2];
            modt[((size_t)l * 9 + j) * 6144 + cg_ * 64 + c2] = s; }
        __syncthreads();
    }
}
__device__ __forceinline__ void cache_phase(const KArgs& a, const int wv) {
    const size_t n4 = (size_t)8 * 2 * 512 * 256 / 4;
    for (size_t i = (size_t)bid_s() * 512 + (wv * 64 + lane_id_v()); i < 2 * n4; i += (size_t)gridDim.x * 512) {
        const bool isv = i >= n4; const size_t j = isv ? i - n4 : i;
        const f32x4 v = *(const f32x4*)((isv ? inp(a, 3) : inp(a, 2)) + j * 4);
        st4((bf16_t*)(a.ws + (isv ? WS_CV : WS_CK)) + j * 4, v);
    }
}
template <bool FIRST>
__device__ __forceinline__ void norm_phase(const float* xp_, const float* xs_, float* xres, const float* gain, const float* modl, int sh_chunk, bf16_t* hout, int lane_, int gw, int NGW, const float* part = nullptr, const float* fixgate = nullptr) {
    const int lane = lane_id_v(); (void)lane_; asm volatile("" : "+s"(gw));
    for (int r = gw; r < MTOK; r += NGW) {
        const float* xr = FIRST ? (r < NPROMPT ? xp_ + (size_t)r * DM : xs_ + (size_t)(r - NPROMPT) * DM) : nullptr;
        bf16_t* xb = (bf16_t*)xres + (size_t)r * 2048;
        f32x4 v[4]; float s = 0.f;
#pragma unroll
        for (int j = 0; j < 4; ++j) {
            if (FIRST) v[j] = *(const f32x4*)(xr + 4 * lane + 256 * j);
            else { const u32x2 w = *(const u32x2*)(xb + 4 * lane + 256 * j); v[j] = (f32x4){bflo(w.x), bfhi(w.x), bflo(w.y), bfhi(w.y)}; }
            s += v[j][0] * v[j][0] + v[j][1] * v[j][1] + v[j][2] * v[j][2] + v[j][3] * v[j][3]; }
        if (FIRST) {
#pragma unroll
            for (int j = 0; j < 4; ++j) st4(xb + 4 * lane + 256 * j, v[j]);
        }
        if (!FIRST && part != nullptr && r >= 32768) {
            const float* gp = fixgate + (size_t)modidx(r) * 6144; s = 0.f;
#pragma unroll
            for (int j = 0; j < 4; ++j) { const int c = 4 * lane + 256 * j; const bf16_t* pp = (const bf16_t*)part + (size_t)(r - 32768) * DM + c;
                const f32x4 ps = ((ld4bf(pp) + ld4bf(pp + (size_t)4096 * DM)) + ld4bf(pp + (size_t)2 * 4096 * DM)) + ld4bf(pp + (size_t)3 * 4096 * DM);
                v[j] = v[j] + *(const f32x4*)(gp + c) * ps; st4(xb + c, v[j]);
                s += v[j][0] * v[j][0] + v[j][1] * v[j][1] + v[j][2] * v[j][2] + v[j][3] * v[j][3]; }
        }
        const float rs = rsqrtf(wave_sum(s) * (1.f / DM) + 1e-6f);
        const float* mp = modl + (size_t)modidx(r) * 6144 + sh_chunk * 1024;
#pragma unroll
        for (int j = 0; j < 4; ++j) { const int c = 4 * lane + 256 * j; const f32x4 g = *(const f32x4*)(gain + c), sh = *(const f32x4*)(mp + c), sc = *(const f32x4*)(mp + 1024 + c);
            const f32x4 y = v[j] * rs * g * (1.f + sc) + sh; st4(hout + (size_t)r * DM + c, y); }
    }
}

__device__ __forceinline__ bf16x8 tr8(const LAS bf16_t* p0, const LAS bf16_t* p1) {
    const s16x4 a = __builtin_amdgcn_ds_read_tr16_b64_v4i16((LAS s16x4*)p0);
    const s16x4 b = __builtin_amdgcn_ds_read_tr16_b64_v4i16((LAS s16x4*)p1);
    return (bf16x8){a[0], a[1], a[2], a[3], b[0], b[1], b[2], b[3]};
}
__device__ __forceinline__ f32x16 mfma32(bf16x8 a, bf16x8 b, f32x16 c) { return __builtin_amdgcn_mfma_f32_32x32x16_bf16(a, b, c, 0, 0, 0); }
__device__ __forceinline__ f32x4 mfma16(bf16x8 a, bf16x8 b, f32x4 c) { return __builtin_amdgcn_mfma_f32_16x16x32_bf16(a, b, c, 0, 0, 0); }
__device__ __forceinline__ float fexp2(float x) { return __builtin_amdgcn_exp2f(x); }

__device__ __forceinline__ void att_tile(const LAS bf16_t* Ks, const LAS bf16_t* Vs, const bf16x8 (&Qf)[2][4], f32x16 (&ot)[2][2], float (&mrun)[2], float (&lrun)[2],
                                         bool skipw, bool needmask, int kpos0, int qpos0, int l31, int lh, int q4, int p4, int blk) {
            if (!skipw) {
                f32x16 sc[2][2];
#pragma unroll
                for (int cb = 0; cb < 2; ++cb)
#pragma unroll
                    for (int kk = 0; kk < 2; ++kk)
#pragma unroll
                        for (int r = 0; r < 16; ++r) sc[cb][kk][r] = 0.f;
#pragma unroll
                for (int s = 0; s < 4; ++s) {
                    const bf16x8 k0 = *(const LAS bf16x8*)(Ks + l31 * 72 + 16 * s + 8 * lh), k1 = *(const LAS bf16x8*)(Ks + (32 + l31) * 72 + 16 * s + 8 * lh);
                    sc[0][0] = mfma32(k0, Qf[0][s], sc[0][0]); sc[0][1] = mfma32(k1, Qf[0][s], sc[0][1]);
                    sc[1][0] = mfma32(k0, Qf[1][s], sc[1][0]); sc[1][1] = mfma32(k1, Qf[1][s], sc[1][1]);
                }
                bf16x8 pf[2][2][2];
#pragma unroll
                for (int cb = 0; cb < 2; ++cb) {
                    const int qpos = qpos0 + cb * 32 + l31;
                    float mx = -3.0e38f;
                    if (needmask) {
#pragma unroll
                        for (int r = 0; r < 16; ++r) { const int d0 = kpos0 + (r & 3) + 8 * (r >> 2) + 4 * lh - qpos, d1 = d0 + 32;
                            if (d0 > 128 || d0 < -128) sc[cb][0][r] = -1e30f; if (d1 > 128 || d1 < -128) sc[cb][1][r] = -1e30f; }
                    }
#pragma unroll
                    for (int r = 0; r < 16; ++r) mx = fmaxf(mx, fmaxf(sc[cb][0][r], sc[cb][1][r]));
                    mx = fmaxf(mx, __shfl_xor(mx, 32));
                    const float mnew = fmaxf(mrun[cb], mx), alpha = fexp2(mrun[cb] - mnew); mrun[cb] = mnew;
                    float ls = 0.f;
#pragma unroll
                    for (int r = 0; r < 16; ++r) { sc[cb][0][r] = fexp2(sc[cb][0][r] - mnew); sc[cb][1][r] = fexp2(sc[cb][1][r] - mnew); ls += sc[cb][0][r] + sc[cb][1][r]; }
                    lrun[cb] = lrun[cb] * alpha + ls;
                    if (__builtin_amdgcn_ballot_w64(alpha != 1.f) != 0ull) { ot[0][cb] = ot[0][cb] * alpha; ot[1][cb] = ot[1][cb] * alpha; }
#pragma unroll
                    for (int kk = 0; kk < 2; ++kk)
#pragma unroll
                        for (int s2 = 0; s2 < 2; ++s2) {
                            u32x4 w0;
                            w0.x = cvt_pk_bf16(sc[cb][kk][8 * s2 + 0], sc[cb][kk][8 * s2 + 1]); w0.y = cvt_pk_bf16(sc[cb][kk][8 * s2 + 2], sc[cb][kk][8 * s2 + 3]);
                            w0.z = cvt_pk_bf16(sc[cb][kk][8 * s2 + 4], sc[cb][kk][8 * s2 + 5]); w0.w = cvt_pk_bf16(sc[cb][kk][8 * s2 + 6], sc[cb][kk][8 * s2 + 7]);
                            pf[cb][kk][s2] = __builtin_bit_cast(bf16x8, w0);
                        }
                }
#pragma unroll
                for (int db = 0; db < 2; ++db)
#pragma unroll
                    for (int kbk = 0; kbk < 2; ++kbk)
#pragma unroll
                        for (int s2 = 0; s2 < 2; ++s2) {
                            const LAS bf16_t* vp = Vs + (kbk * 32 + 16 * s2 + 4 * lh + q4) * 72 + 32 * db + 16 * blk + 4 * p4;
                            const bf16x8 vf = tr8(vp, vp + 8 * 72);
                            ot[db][0] = mfma32(vf, pf[0][kbk][s2], ot[db][0]);
                            ot[db][1] = mfma32(vf, pf[1][kbk][s2], ot[db][1]);
                        }
            }
}
__device__ __forceinline__ void attn_phase(LAS unsigned char* lds, const bf16_t* qb, const bf16_t* kb, const bf16_t* vb, const bf16_t* ck, const bf16_t* cv, bf16_t* ob, const float* sink, const int wv) {
    LAS bf16_t* Ks = (LAS bf16_t*)lds; LAS bf16_t* Vs = (LAS bf16_t*)(lds + 9216);
    const int wid = wv, lane = lane_id_v(), tid = wid * 64 + lane, g = wid >> 1, qh = wid & 1;
    const int l31 = lane & 31, lh = lane >> 5, q4 = (lane & 15) >> 2, p4 = lane & 3, blk = (lane >> 4) & 1;
    const int skey = tid >> 3, sdc = tid & 7;
    for (int it = bid_s(); it < 1152; it += gridDim.x) {
        int b, hk, seqrow0, T, qbase, nlat, latk0, nctx; bool masked;
        if (it < 1024) { b = it >> 7; const int n = (it >> 2) & 31; hk = it & 3; seqrow0 = NPROMPT + b * 4096; T = 4096; qbase = n * 128; nlat = 6; latk0 = qbase - 128; nctx = 8; masked = true; }
        else { const int i2 = it - 1024; b = i2 >> 3; hk = (i2 >> 1) & 3; seqrow0 = b * 256; T = 256; qbase = (i2 & 1) * 128; nlat = 4; latk0 = 0; nctx = 0; masked = false; }
        const int h = hk * 4 + g, qpos0 = qbase + 64 * qh, ntiles = nlat + nctx;
        bf16x8 Qf[2][4];
#pragma unroll
        for (int cb = 0; cb < 2; ++cb)
#pragma unroll
            for (int s = 0; s < 4; ++s) Qf[cb][s] = *(const bf16x8*)(qb + (size_t)(seqrow0 + qpos0 + cb * 32 + l31) * 1024 + h * 64 + 16 * s + 8 * lh);
        float mrun[2], lrun[2]; f32x16 ot[2][2];
        const float sk = sink[h] * LOG2E;
        mrun[0] = sk; mrun[1] = sk; lrun[0] = lh == 0 ? 1.f : 0.f; lrun[1] = lrun[0];
#pragma unroll
        for (int i = 0; i < 2; ++i)
#pragma unroll
            for (int j = 0; j < 2; ++j)
#pragma unroll
                for (int r = 0; r < 16; ++r) ot[i][j][r] = 0.f;
        int ti = 0; while (ti < nlat && latk0 + 64 * ti < 0) ++ti;
        u32x4 kr0, vr0, kr1, vr1;
#define ATT_NEXT(tt) (((tt) + 1 < nlat && latk0 + 64 * ((tt) + 1) >= T) ? nlat : (tt) + 1)
#define ATT_LD(tt, KR, VR) do { const bf16_t *kp_, *vp_; if ((tt) < nlat) { const size_t o_ = (size_t)(seqrow0 + latk0 + 64 * (tt) + skey) * 256 + hk * 64 + sdc * 8; kp_ = kb + o_; vp_ = vb + o_; } \
            else { const size_t o_ = ((size_t)b * 1024 + 64 * ((tt) - nlat) + skey) * 256 + hk * 64 + sdc * 8; kp_ = ck + o_; vp_ = cv + o_; } KR = *(const u32x4*)kp_; VR = *(const u32x4*)vp_; } while (0)
#define ATT_FLAGS(cur_, SK, NM, KP) const bool SK##l_ = (cur_) < nlat; const int KP = latk0 + 64 * (cur_); bool SK = false, NM = false; \
            if (masked && SK##l_) { SK = (KP > qpos0 + 63 + 128) || (KP + 63 < qpos0 - 128); NM = (KP < qpos0 - 64) || (KP > qpos0 + 64); }
        int tp = ti, tq = ATT_NEXT(tp);
        ATT_LD(tp, kr0, vr0); ATT_LD(tq, kr1, vr1);
        while (tp < ntiles) {
            __syncthreads();
            *(LAS u32x4*)(Ks + skey * 72 + sdc * 8) = kr0; *(LAS u32x4*)(Vs + skey * 72 + sdc * 8) = vr0;
            *(LAS u32x4*)(Ks + 9216 + skey * 72 + sdc * 8) = kr1; *(LAS u32x4*)(Vs + 9216 + skey * 72 + sdc * 8) = vr1;
            __syncthreads();
            const int c0 = tp, c1 = tq;
            tp = ATT_NEXT(tq); tq = ATT_NEXT(tp);
            if (tp < ntiles) { ATT_LD(tp, kr0, vr0); ATT_LD(tq, kr1, vr1); }
            { ATT_FLAGS(c0, sk0, nm0, kp0) att_tile(Ks, Vs, Qf, ot, mrun, lrun, sk0, nm0, kp0, qpos0, l31, lh, q4, p4, blk); }
            { ATT_FLAGS(c1, sk1, nm1, kp1) att_tile(Ks + 9216, Vs + 9216, Qf, ot, mrun, lrun, sk1, nm1, kp1, qpos0, l31, lh, q4, p4, blk); }
        }
#undef ATT_NEXT
#undef ATT_LD
#undef ATT_FLAGS
#pragma unroll
        for (int cb = 0; cb < 2; ++cb) {
            const float lt = lrun[cb] + __shfl_xor(lrun[cb], 32), inv = 1.f / lt;
            bf16_t* orow = ob + (size_t)(seqrow0 + qpos0 + cb * 32 + l31) * 1024 + h * 64;
#pragma unroll
            for (int db = 0; db < 2; ++db)
#pragma unroll
                for (int rg = 0; rg < 4; ++rg) { const f32x4 v = {ot[db][cb][4 * rg] * inv, ot[db][cb][4 * rg + 1] * inv, ot[db][cb][4 * rg + 2] * inv, ot[db][cb][4 * rg + 3] * inv};
                    st4(orow + db * 32 + 8 * rg + 4 * lh, v); }
        }
    }
}

__device__ __forceinline__ void ret_scan_phase(LAS unsigned char* lds, const bf16_t* qb, const bf16_t* kb, const bf16_t* vb, bf16_t* ob, float* statp, const float* logdec, const float* state_in, float* state_out, const int wv) {
    constexpr int QST = 264, VST = 72;
    LAS bf16_t* Qs = (LAS bf16_t*)lds; LAS bf16_t* Ks = (LAS bf16_t*)(lds + 33792); LAS bf16_t* ST = (LAS bf16_t*)(lds + 67584);
    LAS bf16_t* Vs0 = (LAS bf16_t*)(lds + 101376); LAS bf16_t* Vw = (LAS bf16_t*)(lds + 110592); LAS bf16_t* Ps = (LAS bf16_t*)(lds + 119808);
    const int w = wv, lane = lane_id_v(), tid = w * 64 + lane, c16 = lane & 15, g = lane >> 4, q4 = (lane & 15) >> 2, p4 = lane & 3;
    const int itl = w >> 1, eb = 2 * (w & 1);
    for (int rnd = 0; rnd < 3; ++rnd) {
        const int bid = bid_s(), xx = bid & 7, ss = bid >> 3;
        const bool samp = rnd == 0; const int gidx = (samp ? 0 : (rnd - 1) * 32) + xx * 4 + (ss >> 3); const int b = gidx >> 2, head = gidx & 3, sl = ss & 7;
        const int seqrow0 = samp ? NPROMPT + b * 4096 : b * 256, T = samp ? 4096 : 256, nc = T / 64;
        for (int dir = 0; dir < 2; ++dir) {
            const float lg2 = logdec[dir * 4 + head] * LOG2E;
            f32x4 sacc[2][4];
#pragma unroll
            for (int dd = 0; dd < 2; ++dd)
#pragma unroll
                for (int et = 0; et < 4; ++et)
#pragma unroll
                    for (int r = 0; r < 4; ++r)
                        sacc[dd][et][r] = samp ? state_in[((((size_t)b * 2 + dir) * 4 + head) * 256 + 32 * w + 16 * dd + 4 * g + r) * 512 + sl * 64 + 16 * et + c16] : 0.f;
            __syncthreads();
#pragma unroll
            for (int dd = 0; dd < 2; ++dd)
#pragma unroll
                for (int et = 0; et < 4; ++et) { u32x2 wv; wv.x = cvt_pk_bf16(sacc[dd][et][0], sacc[dd][et][1]); wv.y = cvt_pk_bf16(sacc[dd][et][2], sacc[dd][et][3]);
                    *(LAS u32x2*)(ST + (16 * et + c16) * QST + 32 * w + 16 * dd + 4 * g) = wv; }
            u32x4 qreg[4], kreg[4], vreg;
#define RET_LOAD(cc_) do { const int t0_ = 64 * (cc_); _Pragma("unroll") for (int p = 0; p < 4; ++p) { const int idx = tid + 512 * p, row = idx >> 5, ch = idx & 31; \
                const size_t o_ = (size_t)(seqrow0 + t0_ + row) * 1024 + head * 256 + ch * 8; qreg[p] = *(const u32x4*)(qb + o_); kreg[p] = *(const u32x4*)(kb + o_); } \
                vreg = *(const u32x4*)(vb + (size_t)(seqrow0 + t0_ + (tid >> 3)) * 2048 + head * 512 + sl * 64 + (tid & 7) * 8); } while (0)
            RET_LOAD(dir ? nc - 1 : 0);
            const float gC = fexp2(lg2 * 64.f);
            float dec[2][4];
#pragma unroll
            for (int x = 0; x < 2; ++x)
#pragma unroll
                for (int r = 0; r < 4; ++r) { const int i = itl * 16 + c16, j = (eb + x) * 16 + 4 * g + r; const int df = dir ? j - i : i - j; const bool ok = dir ? df > 0 : df >= 0; dec[x][r] = ok ? fexp2(lg2 * (float)df) : 0.f; }
            const float wq_c = fexp2(lg2 * (float)(dir ? 64 - (itl * 16 + c16) : (itl * 16 + c16) + 1));
            const float wsj_c = fexp2(lg2 * (float)(dir ? (tid >> 3) : 63 - (tid >> 3)));
            for (int cc = 0; cc < nc; ++cc) {
                const int c = dir ? nc - 1 - cc : cc, t0 = 64 * c;
                LAS bf16_t* Vs = Vs0 + (cc & 1) * 13824;
#pragma unroll
                for (int p = 0; p < 4; ++p) { const int idx = tid + 512 * p, row = idx >> 5, ch = idx & 31; *(LAS u32x4*)(Qs + row * QST + ch * 8) = qreg[p]; *(LAS u32x4*)(Ks + row * QST + ch * 8) = kreg[p]; }
                { const int row = tid >> 3, ch = tid & 7; *(LAS u32x4*)(Vs + row * VST + ch * 8) = vreg;
                  const float wsj = wsj_c; u32x4 sv;
                  sv.x = cvt_pk_bf16(bflo(vreg.x) * wsj, bfhi(vreg.x) * wsj); sv.y = cvt_pk_bf16(bflo(vreg.y) * wsj, bfhi(vreg.y) * wsj);
                  sv.z = cvt_pk_bf16(bflo(vreg.z) * wsj, bfhi(vreg.z) * wsj); sv.w = cvt_pk_bf16(bflo(vreg.w) * wsj, bfhi(vreg.w) * wsj);
                  *(LAS u32x4*)(Vw + row * VST + ch * 8) = sv; }
                __syncthreads();
                if (cc + 1 < nc) RET_LOAD(dir ? nc - 2 - cc : cc + 1);
                const int orow = seqrow0 + t0 + itl * 16 + c16; bf16_t* op = ob + (size_t)orow * 2048 + head * 512 + sl * 64 + 4 * g;
                u32x2 pw0 = {0u, 0u}, pw1 = {0u, 0u};
                if (dir) { pw0 = *(const u32x2*)(op + eb * 16); pw1 = *(const u32x2*)(op + (eb + 1) * 16); }
                bf16x8 qf[8];
#pragma unroll
                for (int ks = 0; ks < 8; ++ks) qf[ks] = *(const LAS bf16x8*)(Qs + (itl * 16 + c16) * QST + 32 * ks + 8 * g);
#pragma unroll
                for (int x = 0; x < 2; ++x) {
                    const int jt = eb + x; f32x4 pt = {0.f, 0.f, 0.f, 0.f};
#pragma unroll
                    for (int ks = 0; ks < 8; ++ks) pt = mfma16(*(const LAS bf16x8*)(Ks + (jt * 16 + c16) * QST + 32 * ks + 8 * g), qf[ks], pt);
                    const int i = itl * 16 + c16; f32x4 pv;
#pragma unroll
                    for (int r = 0; r < 4; ++r) pv[r] = pt[r] * dec[x][r];
                    u32x2 wv; wv.x = cvt_pk_bf16(pv[0], pv[1]); wv.y = cvt_pk_bf16(pv[2], pv[3]);
                    *(LAS u32x2*)(Ps + i * VST + jt * 16 + 4 * g) = wv;
                }
                f32x4 oc[2];
                { const float wq = wq_c;
#pragma unroll
                  for (int x = 0; x < 2; ++x) { const int et = eb + x; f32x4 o = {0.f, 0.f, 0.f, 0.f};
#pragma unroll
                      for (int ks = 0; ks < 8; ++ks) o = mfma16(*(const LAS bf16x8*)(ST + (et * 16 + c16) * QST + 32 * ks + 8 * g), qf[ks], o);
                      oc[x] = o * wq; } }
#pragma unroll
                for (int dd = 0; dd < 2; ++dd)
#pragma unroll
                    for (int et = 0; et < 4; ++et) sacc[dd][et] = sacc[dd][et] * gC;
#pragma unroll
                for (int ks = 0; ks < 2; ++ks) {
                    bf16x8 bfr[4];
#pragma unroll
                    for (int et = 0; et < 4; ++et) { const LAS bf16_t* vp = Vw + (32 * ks + 8 * g + q4) * VST + 16 * et + 4 * p4; bfr[et] = tr8(vp, vp + 4 * VST); }
#pragma unroll
                    for (int dd = 0; dd < 2; ++dd) { const LAS bf16_t* kp = Ks + (32 * ks + 8 * g + q4) * QST + 32 * w + 16 * dd + 4 * p4; const bf16x8 af = tr8(kp, kp + 4 * QST);
#pragma unroll
                        for (int et = 0; et < 4; ++et) sacc[dd][et] = mfma16(af, bfr[et], sacc[dd][et]); }
                }
                __syncthreads();
#pragma unroll
                for (int x = 0; x < 2; ++x) { const int et = eb + x;
#pragma unroll
                    for (int ks = 0; ks < 2; ++ks) { const LAS bf16_t* vp = Vs + (32 * ks + 8 * g + q4) * VST + 16 * et + 4 * p4;
                        oc[x] = mfma16(tr8(vp, vp + 4 * VST), *(const LAS bf16x8*)(Ps + (itl * 16 + c16) * VST + 32 * ks + 8 * g), oc[x]); } }
                { const int row = orow;
                  if (dir == 0) { st4(op + eb * 16, oc[0]); st4(op + (eb + 1) * 16, oc[1]); }
                  else { float s1 = 0.f, s2 = 0.f;
#pragma unroll
                      for (int x = 0; x < 2; ++x) { bf16_t* o2 = op + (eb + x) * 16; const u32x2 pw = x ? pw1 : pw0; f32x4 f = oc[x];
                          f[0] += bflo(pw.x); f[1] += bfhi(pw.x); f[2] += bflo(pw.y); f[3] += bfhi(pw.y); st4(o2, f);
                          s1 += f[0] + f[1] + f[2] + f[3]; s2 += f[0] * f[0] + f[1] * f[1] + f[2] * f[2] + f[3] * f[3]; }
                      s1 += __shfl_xor(s1, 16); s1 += __shfl_xor(s1, 32); s2 += __shfl_xor(s2, 16); s2 += __shfl_xor(s2, 32);
                      if (g == 0) *(f32x2*)(statp + (((size_t)row * 4 + head) * 16 + sl * 2 + (w & 1)) * 2) = (f32x2){s1, s2}; } }
#pragma unroll
                for (int dd = 0; dd < 2; ++dd)
#pragma unroll
                    for (int et = 0; et < 4; ++et) { u32x2 wv; wv.x = cvt_pk_bf16(sacc[dd][et][0], sacc[dd][et][1]); wv.y = cvt_pk_bf16(sacc[dd][et][2], sacc[dd][et][3]);
                        *(LAS u32x2*)(ST + (16 * et + c16) * QST + 32 * w + 16 * dd + 4 * g) = wv; }
            }
#undef RET_LOAD
            if (!samp) {
#pragma unroll
                for (int dd = 0; dd < 2; ++dd)
#pragma unroll
                    for (int et = 0; et < 4; ++et)
#pragma unroll
                        for (int r = 0; r < 4; ++r)
                            state_out[((((size_t)b * 2 + dir) * 4 + head) * 256 + 32 * w + 16 * dd + 4 * g + r) * 512 + sl * 64 + 16 * et + c16] = sacc[dd][et][r];
            }
        }
    }
}
__device__ __forceinline__ void ret_fin_phase(const float* statp, float* fin, const int wv) {
    for (int i = bid_s() * 512 + (wv * 64 + lane_id_v()); i < MTOK * 4; i += gridDim.x * 512) {
        float s1 = 0.f, s2 = 0.f;
#pragma unroll
        for (int p = 0; p < 16; ++p) { const f32x2 v = *(const f32x2*)(statp + ((size_t)i * 16 + p) * 2); s1 += v.x; s2 += v.y; }
        const float mu = s1 * (1.f / 512.f), var = fmaxf(s2 * (1.f / 512.f) - mu * mu, 0.f);
        *(f32x2*)(fin + (size_t)i * 2) = (f32x2){mu, rsqrtf(var + 1e-6f)};
    }
}

__device__ __forceinline__ void lru_conv_phase(const bf16_t* xr, bf16_t* xc, const float* cw, const float* cbias, const int wv) {
    for (size_t i = (size_t)bid_s() * 512 + (wv * 64 + lane_id_v()); i < (size_t)MTOK * 128; i += (size_t)gridDim.x * 512) {
        const int r = (int)(i >> 7), c8 = (int)(i & 127) * 8;
        const int t = r < NPROMPT ? (r & 255) : ((r - NPROMPT) & 4095), T = r < NPROMPT ? 256 : 4096;
        float acc[8];
        { const f32x4 b0 = *(const f32x4*)(cbias + c8), b1 = *(const f32x4*)(cbias + c8 + 4); acc[0] = b0[0]; acc[1] = b0[1]; acc[2] = b0[2]; acc[3] = b0[3]; acc[4] = b1[0]; acc[5] = b1[1]; acc[6] = b1[2]; acc[7] = b1[3]; }
#pragma unroll
        for (int jj = 0; jj < 4; ++jj) { const int tt = t - 2 + jj;
            if (tt >= 0 && tt < T) { const u32x4 xw = *(const u32x4*)(xr + (size_t)(r - 2 + jj) * 1024 + c8); const f32x4 w0 = *(const f32x4*)(cw + jj * 1024 + c8), w1 = *(const f32x4*)(cw + jj * 1024 + c8 + 4);
                acc[0] += w0[0] * bflo(xw.x); acc[1] += w0[1] * bfhi(xw.x); acc[2] += w0[2] * bflo(xw.y); acc[3] += w0[3] * bfhi(xw.y);
                acc[4] += w1[0] * bflo(xw.z); acc[5] += w1[1] * bfhi(xw.z); acc[6] += w1[2] * bflo(xw.w); acc[7] += w1[3] * bfhi(xw.w); } }
        u32x4 o; o.x = cvt_pk_bf16(acc[0], acc[1]); o.y = cvt_pk_bf16(acc[2], acc[3]); o.z = cvt_pk_bf16(acc[4], acc[5]); o.w = cvt_pk_bf16(acc[6], acc[7]);
        *(u32x4*)(xc + (size_t)r * 1024 + c8) = o;
    }
}
__device__ __forceinline__ void lru_scanA_phase(const bf16_t* __restrict__ la, const bf16_t* __restrict__ uu, float* __restrict__ agg, const int wv) {
    constexpr int NS = 8 * 2 * 32 * 512, NP = 16 * 2 * 2 * 512;
    for (int idx = bid_s() * 512 + (wv * 64 + lane_id_v()); idx < NS + NP; idx += gridDim.x * 512) {
        int cp, dir, row0, segidx;
        if (idx < NS) { cp = idx & 511; const int seg = (idx >> 9) & 31; dir = (idx >> 14) & 1; const int b = idx >> 15; row0 = NPROMPT + b * 4096 + seg * 128; segidx = (b * 2 + dir) * 32 + seg; }
        else { const int i2 = idx - NS; cp = i2 & 511; const int seg = (i2 >> 9) & 1; dir = (i2 >> 10) & 1; const int b = i2 >> 11; row0 = b * 256 + seg * 128; segidx = 512 + (b * 2 + dir) * 2 + seg; }
        float L0 = 0.f, L1 = 0.f, H0 = 0.f, H1 = 0.f;
        for (int s0 = 0; s0 < 128; s0 += 16) {
            unsigned lw[16], uw[16];
#pragma unroll
            for (int j = 0; j < 16; ++j) { const int r = row0 + (dir ? 127 - (s0 + j) : s0 + j); const size_t o = ((size_t)r * 2 + dir) * 1024 + 2 * cp; lw[j] = *(const unsigned*)(la + o); uw[j] = *(const unsigned*)(uu + o); }
#pragma unroll
            for (int j = 0; j < 16; ++j) { const float l0 = bflo(lw[j]), l1 = bfhi(lw[j]); H0 = __expf(l0) * H0 + bflo(uw[j]); H1 = __expf(l1) * H1 + bfhi(uw[j]); L0 += l0; L1 += l1; }
        }
        *(f32x4*)(agg + ((size_t)segidx * 1024 + 2 * cp) * 2) = (f32x4){L0, H0, L1, H1};
    }
}
__device__ __forceinline__ void lru_scanC_phase(const bf16_t* __restrict__ la, const bf16_t* __restrict__ uu, const float* __restrict__ agg, bf16_t* __restrict__ rec, const float* __restrict__ st_in, float* __restrict__ st_out, const int wv) {
    constexpr int NS = 8 * 32 * 512, NP = 16 * 2 * 512;
    for (int idx = bid_s() * 512 + (wv * 64 + lane_id_v()); idx < NS + NP; idx += gridDim.x * 512) {
        int cp, seg, b, row0, nseg, segb; const bool samp = idx < NS;
        if (samp) { cp = idx & 511; seg = (idx >> 9) & 31; b = idx >> 14; row0 = NPROMPT + b * 4096 + seg * 128; nseg = 32; segb = b * 64; }
        else { const int i2 = idx - NS; cp = i2 & 511; seg = (i2 >> 9) & 1; b = i2 >> 10; row0 = b * 256 + seg * 128; nseg = 2; segb = 512 + b * 4; }
        float h0 = 0.f, h1 = 0.f;
        if (samp) { const f32x2 v = *(const f32x2*)(st_in + (b * 2 + 0) * 1024 + 2 * cp); h0 = v.x; h1 = v.y; }
        for (int s2 = 0; s2 < seg; ++s2) { const f32x4 v = *(const f32x4*)(agg + ((size_t)(segb + s2) * 1024 + 2 * cp) * 2); h0 = __expf(v[0]) * h0 + v[1]; h1 = __expf(v[2]) * h1 + v[3]; }
        for (int s0 = 0; s0 < 128; s0 += 16) {
            unsigned lw[16], uw[16];
#pragma unroll
            for (int j = 0; j < 16; ++j) { const size_t o = ((size_t)(row0 + s0 + j) * 2 + 0) * 1024 + 2 * cp; lw[j] = *(const unsigned*)(la + o); uw[j] = *(const unsigned*)(uu + o); }
#pragma unroll
            for (int j = 0; j < 16; ++j) { h0 = __expf(bflo(lw[j])) * h0 + bflo(uw[j]); h1 = __expf(bfhi(lw[j])) * h1 + bfhi(uw[j]); *(unsigned*)(rec + (size_t)(row0 + s0 + j) * 1024 + 2 * cp) = cvt_pk_bf16(h0, h1); }
        }
        if (!samp && seg == nseg - 1) *(f32x2*)(st_out + (b * 2 + 0) * 1024 + 2 * cp) = (f32x2){h0, h1};
        h0 = 0.f; h1 = 0.f;
        if (samp) { const f32x2 v = *(const f32x2*)(st_in + (b * 2 + 1) * 1024 + 2 * cp); h0 = v.x; h1 = v.y; }
        for (int s2 = nseg - 1; s2 > seg; --s2) { const f32x4 v = *(const f32x4*)(agg + ((size_t)(segb + nseg + s2) * 1024 + 2 * cp) * 2); h0 = __expf(v[0]) * h0 + v[1]; h1 = __expf(v[2]) * h1 + v[3]; }
        for (int s0 = 0; s0 < 128; s0 += 16) {
            unsigned lw[16], uw[16], rw[16];
#pragma unroll
            for (int j = 0; j < 16; ++j) { const int r = row0 + 127 - (s0 + j); const size_t o = ((size_t)r * 2 + 1) * 1024 + 2 * cp; lw[j] = *(const unsigned*)(la + o); uw[j] = *(const unsigned*)(uu + o); rw[j] = *(const unsigned*)(rec + (size_t)r * 1024 + 2 * cp); }
#pragma unroll
            for (int j = 0; j < 16; ++j) { const int r = row0 + 127 - (s0 + j); h0 = __expf(bflo(lw[j])) * h0 + bflo(uw[j]); h1 = __expf(bfhi(lw[j])) * h1 + bfhi(uw[j]);
                *(unsigned*)(rec + (size_t)r * 1024 + 2 * cp) = cvt_pk_bf16(bflo(rw[j]) + h0, bfhi(rw[j]) + h1); }
        }
        if (!samp && seg == 0) *(f32x2*)(st_out + (b * 2 + 1) * 1024 + 2 * cp) = (f32x2){h0, h1};
    }
}

#ifndef REP_BAR
#define REP_BAR 1
#endif
#ifndef REP_ATT
#define REP_ATT 1
#endif
#ifndef REP_RET
#define REP_RET 1
#endif
#ifndef REP_LRU
#define REP_LRU 1
#endif
#ifndef REP_UP
#define REP_UP 1
#endif
#ifndef REP_NORM
#define REP_NORM 1
#endif
__device__ __forceinline__ int opq(int n) { asm volatile("" : "+s"(n)); return n; }
constexpr int LDS_BYTES = 147456;
constexpr size_t WS_BAR = 4096;
#define XB_TMO      128
#define XB_XCNT(j)  (256  + 64 * (j))
#define XB_XSUB(j)  (1280 + 64 * (j))
#define XB_XGEN(j)  (2304 + 64 * (j))
#define XB_TOP      3328
#define XB_TOPGEN   3392
#define XCD_BAR_WORDS 3456
#define XB_SPIN_CAP (1u << 22)
__device__ __forceinline__ unsigned xb_ld(unsigned* p)              { return __hip_atomic_load(p, __ATOMIC_RELAXED, __HIP_MEMORY_SCOPE_AGENT); }
__device__ __forceinline__ unsigned xb_add(unsigned* p, unsigned v) { return __hip_atomic_fetch_add(p, v, __ATOMIC_RELAXED, __HIP_MEMORY_SCOPE_AGENT); }
__device__ __forceinline__ unsigned xb_xcc_id() { return (unsigned)__builtin_amdgcn_s_getreg((3 << 11) | 20) & 0xFu; }
#define XB_SPIN(cond, bar) do { unsigned _sp = 0; while (cond) { __builtin_amdgcn_s_sleep(1); \
    if ((++_sp & 255u) == 0u) { if (xb_ld(&(bar)[XB_TMO])) break; if (_sp > XB_SPIN_CAP) { atomicAdd(&(bar)[XB_TMO], 1u); break; } } } } while (0)
__device__ __forceinline__ void xcd_barrier_complete(unsigned* bar, unsigned x, unsigned& nloc, unsigned& nx) {
    const unsigned G = gridDim.x;
    unsigned sum, cnt, mine, sp = 0u;
    for (;;) {
        sum = 0u; cnt = 0u; mine = 0u;
#pragma unroll
        for (unsigned j = 0; j < 16; ++j) { const unsigned c = xb_ld(&bar[XB_XCNT(j)]); sum += c; cnt += (c > 0u) ? 1u : 0u; mine = (j == x) ? c : mine; }
        if (sum == G) break;
        __builtin_amdgcn_s_sleep(1);
        if ((++sp & 255u) == 0u) { if (xb_ld(&bar[XB_TMO])) break; if (sp > XB_SPIN_CAP) { atomicAdd(&bar[XB_TMO], 1u); break; } }
    }
    nloc = mine > 0u ? mine : 1u; nx = cnt > 0u ? cnt : 1u;
}
__device__ __forceinline__ void gbar(unsigned* bar, volatile LAS unsigned* st, const int wv) {
    asm volatile("s_waitcnt vmcnt(0) lgkmcnt(0)" ::: "memory");
    __syncthreads();
    if (wv == 0) {
      if (lane_id_v() == 0) {
        const unsigned x = xb_xcc_id();
        unsigned nloc = st[0], nx = st[1];
        if (nloc == 0u) { xcd_barrier_complete(bar, x, nloc, nx); st[0] = nloc; st[1] = nx; }
        const unsigned old = xb_add(&bar[XB_XSUB(x)], 1u);
        const unsigned gen = old / nloc;
        if (old + 1u == (gen + 1u) * nloc) {
            __builtin_amdgcn_fence(__ATOMIC_RELEASE, "agent");
            asm volatile("s_waitcnt vmcnt(0)" ::: "memory");
            const unsigned og = xb_add(&bar[XB_TOP], 1u);
            const unsigned tg = og / nx;
            if (og + 1u == (tg + 1u) * nx) xb_add(&bar[XB_TOPGEN], 1u);
            else XB_SPIN(xb_ld(&bar[XB_TOPGEN]) == tg, bar);
            __builtin_amdgcn_fence(__ATOMIC_ACQUIRE, "agent");
            xb_add(&bar[XB_XGEN(x)], 1u);
            asm volatile("s_waitcnt vmcnt(0)" ::: "memory");
        } else {
            XB_SPIN(xb_ld(&bar[XB_XGEN(x)]) == gen, bar);
            __builtin_amdgcn_fence(__ATOMIC_ACQUIRE, "agent");
            asm volatile("s_waitcnt vmcnt(0)" ::: "memory");
        }
      }
    }
    __syncthreads();
}
__global__ void __launch_bounds__(512, 2) fwd_mega(KArgs a) {
    extern __shared__ __attribute__((aligned(16))) unsigned char lds_raw[];
    LAS unsigned char* lds = (LAS unsigned char*)lds_raw;
    cg::this_grid().sync();
    volatile LAS unsigned* bst = (volatile LAS unsigned*)(lds + 143360);
    if (wave_id_s() == 0 && lane_id_v() == 0) { bst[0] = 0u; bst[1] = 0u; const unsigned xc_ = xb_xcc_id();
        const unsigned slot_ = xb_add(&((unsigned*)(karg_ptr(264) + WS_BAR))[XB_XCNT(xc_)], 1u); bst[2] = blockIdx.x; bst[3] = (xc_ << 8) | slot_; }
    __syncthreads();
    const int wave = wave_id_s(), lane = 0, G = gridDim.x, gw = bid_s() * 8 + wave, NGW = G * 8;
#define ws karg_ptr(264)
#define XR ((float*)karg_ptr(256))
#define modt ((float*)(ws + WS_MOD))
#define hbuf ((bf16_t*)(ws + WS_H))
#define WUP ((bf16_t*)(ws + WS_WUP))
#define WDN ((bf16_t*)(ws + WS_WDN))
#define WIN ((bf16_t*)(ws + WS_WIN))
#define WOUT ((bf16_t*)(ws + WS_WOUT))
#define WX ((bf16_t*)(ws + WS_WX))
#define WX2 ((bf16_t*)(ws + WS_WX2))
    mod_phase(a, lds, wave); __syncthreads();
    cache_phase(a, wave);
    convert_layer_weights(a, ws, 0, lds, wave, lane, gw, NGW);
    if (bid_s() == 0 && wave == 0) { const int l_ = lane_id_v(); if (l_ < 32) ((const float**)ws)[l_] = a.in[l_]; }
    for (int rb_ = opq(REP_BAR); rb_ > 0; --rb_) gbar((unsigned*)(ws + WS_BAR), bst, wave);
    if (wave == 0 && lane_id_v() == 0) {
        unsigned* bar_ = (unsigned*)(ws + WS_BAR); bool ok_ = gridDim.x == 256;
        for (unsigned j = 0; j < 16; ++j) { const unsigned c_ = xb_ld(&bar_[XB_XCNT(j)]); ok_ = ok_ && (c_ == (j < 8 ? 32u : 0u)); }
        const unsigned v_ = bst[3]; if (ok_) bst[2] = (v_ & 255u) * 8u + (v_ >> 8);
    }
    __syncthreads();
#define tb (KTab{(const float* const*)ws})
    constexpr int KS = 1;
    for (int layer = 0; layer < 4; ++layer) {
        const int kind = layer % 3, slot = layer / 3;
#define modl (modt + (size_t)layer * 9 * 6144)
        pg8::StaticOrder S;
        if (layer == 0) norm_phase<true>(inp(tb, 0), inp(tb, 1), XR, inp(tb, 8), modl, 0, hbuf, lane, gw, NGW);
        else { norm_phase<false>(nullptr, nullptr, XR, inp(tb, 8) + layer * DM, modl, 0, hbuf, lane, gw, NGW, KS ? (const float*)(ws + WS_PART_M) : nullptr, modl - 9 * 6144 + 5 * 1024); __syncthreads(); convert_layer_weights(tb, ws, layer, lds, wave, lane, gw, NGW); }
        for (int rb_ = opq(REP_BAR); rb_ > 0; --rb_) gbar((unsigned*)(ws + WS_BAR), bst, wave);
        if (kind == 0) {
            bf16_t *q = (bf16_t*)(ws + WS_AQ), *k = (bf16_t*)(ws + WS_AK), *v = (bf16_t*)(ws + WS_AV), *o = (bf16_t*)(ws + WS_AO);
            { pg8::Gemm g{hbuf, WIN, MTOK, 1536, 1024, 1024, 1024, 31, 0}; S.init(MTOK, 1536, G, bid_s());
              pg8::EpiAttnQKV E{q, k, v, XR + OUT_K, XR + OUT_V, inp(tb, 16) + slot * 64, inp(tb, 17) + slot * 64, slot};
              pg8::gemm_phase(lds, g, S, E, wave); }
            for (int rb_ = opq(REP_BAR); rb_ > 0; --rb_) gbar((unsigned*)(ws + WS_BAR), bst, wave);
            for (int rp_ = opq(REP_ATT); rp_ > 0; --rp_) attn_phase(lds, q, k, v, (const bf16_t*)(ws + WS_CK) + (size_t)slot * 512 * 256, (const bf16_t*)(ws + WS_CV) + (size_t)slot * 512 * 256, o, inp(tb, 18) + slot * 16, wave);
            for (int rb_ = opq(REP_BAR); rb_ > 0; --rb_) gbar((unsigned*)(ws + WS_BAR), bst, wave);
            { pg8::Gemm g{o, WOUT, MTOK, 1024, 1024, 1024, 1024, 31, 0}; S.init(MTOK, 1024, G, bid_s(), KS); pg8::EpiResid E{XR, modl + 2 * 1024, (float*)(ws + WS_PART_A)}; pg8::gemm_phase(lds, g, S, E, wave); }
            for (int rb_ = opq(REP_BAR); rb_ > 0; --rb_) gbar((unsigned*)(ws + WS_BAR), bst, wave);
        } else if (kind == 1) {
            bf16_t *q = (bf16_t*)(ws + WS_RQ), *k = (bf16_t*)(ws + WS_RK), *v = (bf16_t*)(ws + WS_RV), *o = (bf16_t*)(ws + WS_RO);
            float* statp = (float*)(ws + WS_RSTP); float* fin = (float*)(ws + WS_RFIN);
            { pg8::Gemm g{hbuf, WIN, MTOK, 4096, 1024, 1024, 1024, 31, 0}; S.init(MTOK, 4096, G, bid_s()); pg8::EpiRetQKV E{q, k, v}; pg8::gemm_phase(lds, g, S, E, wave); }
            for (int rb_ = opq(REP_BAR); rb_ > 0; --rb_) gbar((unsigned*)(ws + WS_BAR), bst, wave);
            for (int rp_ = opq(REP_RET); rp_ > 0; --rp_) ret_scan_phase(lds, q, k, v, o, statp, inp(tb, 22) + slot * 8, inp(tb, 4), XR + OUT_RET, wave);
            for (int rb_ = opq(REP_BAR); rb_ > 0; --rb_) gbar((unsigned*)(ws + WS_BAR), bst, wave);
            bf16_t* h2 = (bf16_t*)(ws + WS_RQ);
            norm_phase<false>(nullptr, nullptr, XR, inp(tb, 8) + layer * DM, modl, 0, h2, lane, gw, NGW);
            ret_fin_phase(statp, fin, wave);
            for (int rb_ = opq(REP_BAR); rb_ > 0; --rb_) gbar((unsigned*)(ws + WS_BAR), bst, wave);
            { pg8::Gemm g{h2, WX, MTOK, 2048, 1024, 1024, 1024, 31, 0}; S.init(MTOK, 2048, G, bid_s()); pg8::EpiLateGate<0> E{o, 2048, fin, inp(tb, 21) + slot * 2048}; pg8::gemm_phase(lds, g, S, E, wave); }
            for (int rb_ = opq(REP_BAR); rb_ > 0; --rb_) gbar((unsigned*)(ws + WS_BAR), bst, wave);
            { pg8::Gemm g{o, WOUT, MTOK, 1024, 2048, 2048, 2048, 31, 0}; S.init(MTOK, 1024, G, bid_s(), KS); pg8::EpiResid E{XR, modl + 2 * 1024, (float*)(ws + WS_PART_R)}; pg8::gemm_phase(lds, g, S, E, wave); }
            for (int rb_ = opq(REP_BAR); rb_ > 0; --rb_) gbar((unsigned*)(ws + WS_BAR), bst, wave);
        } else {
            bf16_t *xr = (bf16_t*)(ws + WS_LXR), *xc = (bf16_t*)(ws + WS_LXC), *la = (bf16_t*)(ws + WS_LLA), *uu = (bf16_t*)(ws + WS_LU), *rec = (bf16_t*)(ws + WS_LREC);
            float* agg = (float*)(ws + WS_LAGG);
            { pg8::Gemm g{hbuf, WIN, MTOK, 1024, 1024, 1024, 1024, 31, 0}; S.init(MTOK, 1024, G, bid_s()); pg8::EpiStore<0> E{xr, 1024}; pg8::gemm_phase(lds, g, S, E, wave); }
            for (int rb_ = opq(REP_BAR); rb_ > 0; --rb_) gbar((unsigned*)(ws + WS_BAR), bst, wave);
            for (int rp_ = opq(REP_LRU); rp_ > 0; --rp_) lru_conv_phase(xr, xc, inp(tb, 24) + slot * 4096, inp(tb, 25) + slot * 1024, wave);
            for (int rb_ = opq(REP_BAR); rb_ > 0; --rb_) gbar((unsigned*)(ws + WS_BAR), bst, wave);
            { pg8::Gemm g{xc, WX2, MTOK, 4096, 128, 1024, 128, 1, 256}; S.init(MTOK, 4096, G, bid_s());
              pg8::EpiLruGates E{xc, la, uu, inp(tb, 27) + slot * 2048, inp(tb, 29) + slot * 2048, inp(tb, 30) + slot * 2048}; pg8::gemm_phase(lds, g, S, E, wave); }
            for (int rb_ = opq(REP_BAR); rb_ > 0; --rb_) gbar((unsigned*)(ws + WS_BAR), bst, wave);
            for (int rp_ = opq(REP_LRU); rp_ > 0; --rp_) lru_scanA_phase(la, uu, agg, wave);
            for (int rb_ = opq(REP_BAR); rb_ > 0; --rb_) gbar((unsigned*)(ws + WS_BAR), bst, wave);
            for (int rp_ = opq(REP_LRU); rp_ > 0; --rp_) lru_scanC_phase(la, uu, agg, rec, inp(tb, 5) + slot * 2048, XR + OUT_LRU, wave);
            for (int rb_ = opq(REP_BAR); rb_ > 0; --rb_) gbar((unsigned*)(ws + WS_BAR), bst, wave);
            { pg8::Gemm g{hbuf, WX, MTOK, 1024, 1024, 1024, 1024, 31, 0}; S.init(MTOK, 1024, G, bid_s()); pg8::EpiLateGate<1> E{rec, 1024, nullptr, nullptr}; pg8::gemm_phase(lds, g, S, E, wave); }
            for (int rb_ = opq(REP_BAR); rb_ > 0; --rb_) gbar((unsigned*)(ws + WS_BAR), bst, wave);
            { pg8::Gemm g{rec, WOUT, MTOK, 1024, 1024, 1024, 1024, 31, 0}; S.init(MTOK, 1024, G, bid_s(), KS); pg8::EpiResid E{XR, modl + 2 * 1024, (float*)(ws + WS_PART_L)}; pg8::gemm_phase(lds, g, S, E, wave); }
            for (int rb_ = opq(REP_BAR); rb_ > 0; --rb_) gbar((unsigned*)(ws + WS_BAR), bst, wave);
        }
        norm_phase<false>(nullptr, nullptr, XR, inp(tb, 9) + layer * DM, modl, 3, hbuf, lane, gw, NGW, KS ? (const float*)(ws + (kind == 0 ? WS_PART_A : kind == 1 ? WS_PART_R : WS_PART_L)) : nullptr, modl + 2 * 1024);
        for (int rb_ = opq(REP_BAR); rb_ > 0; --rb_) gbar((unsigned*)(ws + WS_BAR), bst, wave);
        bf16_t* hid = (bf16_t*)(ws + WS_HID);
        for (int rp_ = opq(REP_UP); rp_ > 0; --rp_) { pg8::Gemm g{hbuf, WUP, MTOK, 4096, 1024, 1024, 1024, 31, 0}; S.init(MTOK, 4096, G, bid_s()); pg8::EpiStore<2> E{hid, 4096}; pg8::gemm_phase(lds, g, S, E, wave); }
        for (int rb_ = opq(REP_BAR); rb_ > 0; --rb_) gbar((unsigned*)(ws + WS_BAR), bst, wave);
        { pg8::Gemm g{hid, WDN, MTOK, 1024, 4096, 4096, 4096, 31, 0}; S.init(MTOK, 1024, G, bid_s(), KS); pg8::EpiResid E{XR, modl + 5 * 1024, (float*)(ws + WS_PART_M)}; pg8::gemm_phase(lds, g, S, E, wave); }
        for (int rb_ = opq(REP_BAR); rb_ > 0; --rb_) gbar((unsigned*)(ws + WS_BAR), bst, wave);
    }
    {
        const int layer = 3; const float* gate = modl + 5 * 1024; const float* part = (const float*)(ws + WS_PART_M); float* xo = XR;
        const int l_ = lane_id_v();
        for (int r = gw; r < MTOK; r += NGW) { const bf16_t* xb = (const bf16_t*)xo + (size_t)r * 2048; f32x4 v[4];
#pragma unroll
            for (int j = 0; j < 4; ++j) { const u32x2 w = *(const u32x2*)(xb + 4 * l_ + 256 * j); v[j] = (f32x4){bflo(w.x), bfhi(w.x), bflo(w.y), bfhi(w.y)}; }
            if (KS && r >= 32768) { const float* gp = gate + (size_t)modidx(r) * 6144;
#pragma unroll
                for (int j = 0; j < 4; ++j) { const int c = 4 * l_ + 256 * j; const bf16_t* pp = (const bf16_t*)part + (size_t)(r - 32768) * DM + c;
                    const f32x4 ps = ((ld4bf(pp) + ld4bf(pp + (size_t)4096 * DM)) + ld4bf(pp + (size_t)2 * 4096 * DM)) + ld4bf(pp + (size_t)3 * 4096 * DM);
                    v[j] = v[j] + *(const f32x4*)(gp + c) * ps; } }
            asm volatile("s_waitcnt vmcnt(0)" ::: "memory");
#pragma unroll
            for (int j = 0; j < 4; ++j) *(f32x4*)(xo + (size_t)r * DM + 4 * l_ + 256 * j) = v[j];
        }
    }
}

#undef ws
#undef XR
#undef modt
#undef hbuf
#undef WUP
#undef WDN
#undef WIN
#undef WOUT
#undef WX
#undef WX2
#undef modl
#undef tb
extern "C" void kernel_launch(void* const* d_in, const int* in_sizes, int n_in, void* d_out, int out_size, void* d_ws, size_t ws_size, hipStream_t stream) {
    static int grid = 0;
    if (grid == 0) {
        int dev = 0, cus = 0, per_cu = 0;
        hipGetDevice(&dev); hipDeviceGetAttribute(&cus, hipDeviceAttributeMultiprocessorCount, dev);
        if (hipFuncSetAttribute((const void*)fwd_mega, hipFuncAttributeMaxDynamicSharedMemorySize, LDS_BYTES) != hipSuccess) { fprintf(stderr, "hipFuncSetAttribute failed\n"); grid = -1; return; }
        if (hipOccupancyMaxActiveBlocksPerMultiprocessor(&per_cu, (const void*)fwd_mega, 512, LDS_BYTES) != hipSuccess || per_cu < 1) { fprintf(stderr, "occupancy query: %d\n", per_cu); per_cu = 1; }
        (void)hipGetLastError();
        grid = cus * per_cu;
        if (grid != 256) { fprintf(stderr, "kernel_launch: this build needs exactly 256 resident workgroups (got %d)\n", grid); grid = -1; return; }
        if (n_in != 32 || ws_size < 512 * MiB) { fprintf(stderr, "kernel_launch: unexpected n_in %d / ws %zu\n", n_in, ws_size); grid = -1; return; }
    }
    if (grid < 0) return;
    KArgs a{};
    for (int i = 0; i < 32; ++i) a.in[i] = (const float*)d_in[i];
    a.out = (float*)d_out; a.ws = (unsigned char*)d_ws;
    if (hipMemsetAsync((char*)d_ws + WS_BAR, 0, 16384, stream) != hipSuccess) { fprintf(stderr, "memset failed\n"); return; }
    void* args[] = {&a};
    hipError_t e = hipLaunchCooperativeKernel((const void*)fwd_mega, dim3(grid), dim3(512), args, LDS_BYTES, stream);
    if (e != hipSuccess) fprintf(stderr, "cooperative launch failed: %s (grid %d)\n", hipGetErrorString(e), grid);
}
```

```cpp
#include <hip/hip_runtime.h>
#include <hip/hip_cooperative_groups.h>
#include <cstdio>
#include <cstdint>
namespace cg = cooperative_groups;

#define LAS __attribute__((address_space(3)))
typedef unsigned short bf16_t;
typedef short bf16x8 __attribute__((ext_vector_type(8)));
typedef short s16x4 __attribute__((ext_vector_type(4)));
typedef float f32x4 __attribute__((ext_vector_type(4)));
typedef float f32x2 __attribute__((ext_vector_type(2)));
typedef float f32x16 __attribute__((ext_vector_type(16)));
typedef unsigned u32x4 __attribute__((ext_vector_type(4)));
typedef unsigned u32x2 __attribute__((ext_vector_type(2)));

#define LOG2E 1.4426950408889634f
constexpr int DM = 1024, NPROMPT = 4096, MTOK = 36864, DFF = 4096;
constexpr size_t MiB = 1u << 20;
constexpr size_t WS_MOD = 1 * MiB;
constexpr size_t WS_WUP = 2 * MiB, WS_WDN = 10 * MiB, WS_WIN = 18 * MiB, WS_WOUT = 26 * MiB, WS_WX = 30 * MiB, WS_WX2 = 32 * MiB;
constexpr size_t WS_CK = 34 * MiB, WS_CV = 38 * MiB;
constexpr size_t WS_A = 44 * MiB;
constexpr size_t WS_H = 440 * MiB;
constexpr size_t WS_AQ = 44 * MiB, WS_AK = 116 * MiB, WS_AV = 134 * MiB, WS_AO = 152 * MiB;
constexpr size_t WS_RQ = 44 * MiB, WS_RK = 116 * MiB, WS_RV = 188 * MiB, WS_RO = 332 * MiB, WS_RSTP = 476 * MiB, WS_RFIN = 494 * MiB;
constexpr size_t WS_LXR = 368 * MiB, WS_LXC = 44 * MiB, WS_LLA = 116 * MiB, WS_LU = 260 * MiB, WS_LAGG = 404 * MiB, WS_LREC = 44 * MiB;
constexpr size_t WS_HID = 44 * MiB;
constexpr size_t WS_PART_A = 224 * MiB, WS_PART_R = 44 * MiB, WS_PART_L = 116 * MiB, WS_PART_M = 332 * MiB;
constexpr size_t OUT_K = 37748736, OUT_V = 39845888, OUT_RET = 41943040, OUT_LRU = 58720256;

__device__ __forceinline__ unsigned cvt_pk_bf16(float lo, float hi) { unsigned r; asm volatile("v_cvt_pk_bf16_f32 %0, %1, %2" : "=v"(r) : "v"(lo), "v"(hi)); return r; }
__device__ __forceinline__ float bf2f(unsigned short b) { return __uint_as_float((unsigned)b << 16); }
__device__ __forceinline__ float bflo(unsigned w) { return __uint_as_float(w << 16); }
__device__ __forceinline__ float bfhi(unsigned w) { return __uint_as_float(w & 0xffff0000u); }
__device__ __forceinline__ f32x4 ld4bf(const bf16_t* p) { const u32x2 w = *(const u32x2*)p; return (f32x4){bflo(w.x), bfhi(w.x), bflo(w.y), bfhi(w.y)}; }
__device__ __forceinline__ float fsigmoid(float x) { return __builtin_amdgcn_rcpf(1.f + __expf(-x)); }
__device__ __forceinline__ float fsilu(float x) { return x * fsigmoid(x); }
__device__ __forceinline__ float fgelu_tanh(float x) { const float u = 0.7978845608028654f * (x + 0.044715f * x * x * x); return x * fsigmoid(2.f * u); }
__device__ __forceinline__ int launder(int v) { asm volatile("" : "+v"(v)); return v; }
__device__ __forceinline__ int lane_id_v() { int l; asm volatile("v_mbcnt_lo_u32_b32 %0, -1, 0\n\tv_mbcnt_hi_u32_b32 %0, -1, %0" : "=v"(l)); return l; }
__device__ __forceinline__ int bid_s() { const int b = *(volatile LAS int*)(uintptr_t)143368u; return __builtin_amdgcn_readfirstlane(b); }
__device__ __forceinline__ int wave_id_s() { return __builtin_amdgcn_readfirstlane(__builtin_amdgcn_workitem_id_x() >> 6); }
__device__ __forceinline__ unsigned char* karg_ptr(int off) {
#if defined(__HIP_DEVICE_COMPILE__)
    unsigned long long v; auto ka = __builtin_amdgcn_kernarg_segment_ptr();
    if (off == 256) asm volatile("s_load_dwordx2 %0, %1, 0x100\n\ts_waitcnt lgkmcnt(0)" : "=s"(v) : "s"(ka));
    else asm volatile("s_load_dwordx2 %0, %1, 0x108\n\ts_waitcnt lgkmcnt(0)" : "=s"(v) : "s"(ka));
    return (unsigned char*)v;
#else
    (void)off; return nullptr;
#endif
}
__device__ __forceinline__ int modidx(int r) { return r < NPROMPT ? 0 : 1 + ((r - NPROMPT) >> 12); }
__device__ __forceinline__ void rope_cs(float pos, float inv, float& c, float& s) {
    float rev = pos * inv * 0.15915494309189535f; rev -= rintf(rev);
    s = __builtin_amdgcn_sinf(rev); c = __builtin_amdgcn_cosf(rev);
}

namespace pg8 {
constexpr int BM = 256, BK = 64, HALF = 128, HTB = HALF * BK * 2, STAGE_BYTES = 8 * HTB, NXCD = 8, WGM = 8;
__host__ __device__ __forceinline__ int lds_byte(int r, int c) { const int st = (r >> 4) * 2 + (c >> 5), rr = r & 15, cc = c & 31, ob = rr * 64 + cc * 2; return st * 1024 + (ob ^ (((ob >> 9) & 1) << 5)); }
__host__ __device__ __forceinline__ void stage_rc(int b, int& R, int& C) { const int st = b / 1024, sb = b % 1024, swz = sb ^ (((sb >> 9) & 1) << 5); R = (st >> 1) * 16 + swz / 64; C = (st & 1) * 32 + (swz % 64) / 2; }
__host__ __device__ __forceinline__ int perm32(int rho) { const int n = rho >> 4, i = rho & 15; return 8 * (i >> 2) + 4 * n + (i & 3); }
struct Unit { int pm, pn, kq; };
struct Gemm { const bf16_t* A; const bf16_t* Bt; int M, N, K, lda, ldb, ash, astep; };
struct StaticOrder {
    int nM, nN, nwg, G, c, ks;
    __device__ void init(int M, int N, int G_, int c_, int ks_ = 0) { nM = M / BM; nN = N / BM; nwg = nM * nN; G = G_; c = c_; ks = ks_; }
    __device__ bool next(int i, Unit& u) const {
        if (ks) { if (i < 2) { const int j = i * 32 + (c >> 3), xx = c & 7; u.pm = 16 * xx + (j >> 2); u.pn = j & 3; u.kq = -1; return true; }
                  if (i == 2) { const int t = c >> 2; u.pm = 128 + (t >> 2); u.pn = t & 3; u.kq = c & 3; return true; } return false; }
        u.kq = -1;
        const int L = i * G + c; if (L >= nwg) return false;
        int wgid = L; { const int q = nwg / NXCD, r = nwg % NXCD, xcd = wgid % NXCD, off = wgid / NXCD; wgid = (xcd < r ? xcd * (q + 1) : r * (q + 1) + (xcd - r) * q) + off; }
        const int nig = WGM * nN, gid = wgid / nig, fm = gid * WGM, gsz = (nM - fm) < WGM ? (nM - fm) : WGM;
        u.pm = fm + ((wgid % nig) % gsz); u.pn = (wgid % nig) / gsz; return true;
    }
};

template <class Epi>
__device__ __forceinline__ void gemm_phase(LAS unsigned char* lds, const Gemm g, const StaticOrder& S, const Epi& E, const int wv) {
    const int wid = wv, lane = lane_id_v(), tid = wid * 64 + lane, wr = wid >> 2, wc = wid & 3, fr = lane & 15, fq = lane >> 4;
    int K_ = g.K; asm volatile("" : "+s"(K_));
    const int K = K_, nt = K / BK;
    unsigned voffA[2], voffB[2];
#pragma unroll
    for (int i = 0; i < 2; ++i) { int R, C; stage_rc(tid * 16 + i * 8192, R, C); const int Rb = Epi::PERM ? ((R & ~31) + perm32(R & 31)) : R;
        voffA[i] = (unsigned)(R * g.lda + C) * 2u; voffB[i] = (unsigned)(Rb * g.ldb + C) * 2u; }
    const unsigned kstep = (unsigned)(BK * 2);
    const unsigned hA = (unsigned)HALF * g.lda * 2u, hB = (unsigned)HALF * g.ldb * 2u, tA = 2u * hA, tB = 2u * hB;
    const unsigned ldsw = (unsigned)wid * 1024u;
    const int aoff = lds_byte(wr * 64 + fr, fq * 8), boff = lds_byte(wc * 32 + fr, fq * 8);
#define PG8_SA(b, h) (((b) * 2 + (h)) * HTB)
#define PG8_SB(b, h) ((4 + (b) * 2 + (h)) * HTB)
#define PG8_STAGE(bufoff, gbase, voff) do { _Pragma("unroll") for (int _i = 0; _i < 2; ++_i) \
        __builtin_amdgcn_global_load_lds((const unsigned*)((const char*)(gbase) + (voff)[_i]), (LAS unsigned*)(lds + (bufoff) + ldsw + _i * 8192), 16, 0, 0); } while (0)
#define PG8_LDA(dst, b, h) do { _Pragma("unroll") for (int m = 0; m < 4; ++m) _Pragma("unroll") for (int k = 0; k < 2; ++k) dst[m][k] = *(const LAS bf16x8*)(lds + PG8_SA(b, h) + aoff + m * 2048 + k * 1024); } while (0)
#define PG8_LDB(dst, b, h) do { _Pragma("unroll") for (int n = 0; n < 2; ++n) _Pragma("unroll") for (int k = 0; k < 2; ++k) dst[n][k] = *(const LAS bf16x8*)(lds + PG8_SB(b, h) + boff + n * 2048 + k * 1024); } while (0)
#define PG8_MMA(ai, bj, At, Bt) do { __builtin_amdgcn_s_setprio(1); _Pragma("unroll") for (int m = 0; m < 4; ++m) _Pragma("unroll") for (int n = 0; n < 2; ++n) _Pragma("unroll") for (int k = 0; k < 2; ++k) \
        acc[ai][bj][m][n] = __builtin_amdgcn_mfma_f32_16x16x32_bf16(Bt[n][k], At[m][k], acc[ai][bj][m][n], 0, 0, 0); __builtin_amdgcn_s_setprio(0); } while (0)
#define PG8_WAIT_V(n) asm volatile("s_waitcnt vmcnt(" #n ")" ::: "memory")
#define PG8_WAIT_L(n) asm volatile("s_waitcnt lgkmcnt(" #n ")" ::: "memory")
#define PG8_BAR __builtin_amdgcn_s_barrier()
#define PG8_SCHED __builtin_amdgcn_sched_barrier(0)
    Unit cur, nxt; int ui = 0;
    if (!S.next(0, cur)) return;
    f32x4 acc[2][2][4][2];
#pragma unroll
    for (int a = 0; a < 2; ++a)
#pragma unroll
        for (int b = 0; b < 2; ++b)
#pragma unroll
            for (int m = 0; m < 4; ++m)
#pragma unroll
                for (int n = 0; n < 2; ++n) acc[a][b][m][n] = (f32x4){0.f, 0.f, 0.f, 0.f};
    bf16x8 At[4][2], B0[2][2], B1[2][2];
    const int ntq = nt >> 2;
    int cnt = cur.kq >= 0 ? ntq : nt;
    const unsigned cko = cur.kq >= 0 ? (unsigned)(cur.kq * ntq) * kstep : 0u;
    const char* cA = (const char*)g.A + ((unsigned)cur.pm * tA + (unsigned)(cur.pn >> g.ash) * (unsigned)g.astep + cko);
    const char* cB = (const char*)g.Bt + ((unsigned)cur.pn * tB + cko);
    PG8_STAGE(PG8_SB(0, 0), cB, voffB); PG8_STAGE(PG8_SB(0, 1), cB + hB, voffB); PG8_STAGE(PG8_SA(0, 0), cA, voffA); PG8_STAGE(PG8_SA(0, 1), cA + hA, voffA);
    if (wr == 1) PG8_BAR;
    PG8_WAIT_V(2); PG8_BAR;
    PG8_STAGE(PG8_SB(1, 0), cB + kstep, voffB); PG8_STAGE(PG8_SA(1, 0), cA + kstep, voffA); PG8_STAGE(PG8_SB(1, 1), cB + hB + kstep, voffB);
    PG8_WAIT_V(6); PG8_BAR;
    for (;;) {
        const bool has_next = S.next(ui + 1, nxt);
        const unsigned nko = (has_next && nxt.kq >= 0) ? (unsigned)(nxt.kq * ntq) * kstep : 0u;
        const char* nA = has_next ? (const char*)g.A + ((unsigned)nxt.pm * tA + (unsigned)(nxt.pn >> g.ash) * (unsigned)g.astep + nko) : cA; const char* nB = has_next ? (const char*)g.Bt + ((unsigned)nxt.pn * tB + nko) : cB;
        for (int t = 0; t < cnt; t += 2) {
            const bool last = (t == cnt - 2);
            const char* a1 = cA + (unsigned)(t + 1) * kstep;
            const char* a2 = last ? nA : cA + (unsigned)(t + 2) * kstep; const char* b2 = last ? nB : cB + (unsigned)(t + 2) * kstep;
            const char* a3 = a2 + kstep; const char* b3 = b2 + kstep;
            PG8_LDB(B0, 0, 0); PG8_LDB(B1, 0, 1); PG8_SCHED; PG8_LDA(At, 0, 0); PG8_STAGE(PG8_SA(1, 1), a1 + hA, voffA);
            PG8_WAIT_V(8); PG8_WAIT_L(0); PG8_BAR; PG8_MMA(0, 0, At, B0); PG8_MMA(0, 1, At, B1); PG8_BAR; PG8_SCHED;
            PG8_LDA(At, 0, 1); PG8_STAGE(PG8_SB(0, 0), b2, voffB); PG8_STAGE(PG8_SB(0, 1), b2 + hB, voffB); PG8_STAGE(PG8_SA(0, 0), a2, voffA);
            PG8_WAIT_V(8); PG8_WAIT_L(0); PG8_BAR; PG8_MMA(1, 0, At, B0); PG8_MMA(1, 1, At, B1); PG8_BAR; PG8_SCHED;
            PG8_LDB(B0, 1, 0); PG8_LDB(B1, 1, 1); PG8_SCHED; PG8_LDA(At, 1, 0); PG8_STAGE(PG8_SA(0, 1), a2 + hA, voffA);
            PG8_WAIT_V(8); PG8_WAIT_L(0); PG8_BAR; PG8_MMA(0, 0, At, B0); PG8_MMA(0, 1, At, B1); PG8_BAR; PG8_SCHED;
            PG8_LDA(At, 1, 1); PG8_STAGE(PG8_SB(1, 0), b3, voffB); PG8_STAGE(PG8_SB(1, 1), b3 + hB, voffB); PG8_STAGE(PG8_SA(1, 0), a3, voffA);
            PG8_WAIT_V(8); PG8_WAIT_L(0); PG8_BAR; PG8_MMA(1, 0, At, B0); PG8_MMA(1, 1, At, B1); PG8_BAR; PG8_SCHED;
        }
        if (wr == 0) PG8_BAR;
        E(acc, cur, wr, wc, fr, fq);
        if (!has_next) break;
#pragma unroll
        for (int a = 0; a < 2; ++a)
#pragma unroll
            for (int b = 0; b < 2; ++b)
#pragma unroll
                for (int m = 0; m < 4; ++m)
#pragma unroll
                    for (int n = 0; n < 2; ++n) acc[a][b][m][n] = (f32x4){0.f, 0.f, 0.f, 0.f};
        cur = nxt; cA = nA; cB = nB; ++ui; cnt = cur.kq >= 0 ? ntq : nt;
        if (wr == 1) PG8_BAR;
    }
    PG8_WAIT_V(0);
    PG8_BAR;
#undef PG8_SA
#undef PG8_SB
#undef PG8_STAGE
#undef PG8_LDA
#undef PG8_LDB
#undef PG8_MMA
#undef PG8_WAIT_V
#undef PG8_WAIT_L
#undef PG8_BAR
#undef PG8_SCHED
}

template <int ACT> struct EpiStore {
    static constexpr bool PERM = true;
    bf16_t* O; int ldc;
    __device__ __forceinline__ void operator()(const f32x4 (&acc)[2][2][4][2], const Unit& u, int wr, int wc, int fr, int fq) const {
        fr = launder(fr); fq = launder(fq);
        const int row0 = u.pm * BM + wr * 64 + fr, col0 = u.pn * BM + wc * 32 + 8 * fq;
#pragma unroll
        for (int ai = 0; ai < 2; ++ai)
#pragma unroll
            for (int m = 0; m < 4; ++m) { bf16_t* rowp = O + (size_t)(row0 + ai * HALF + m * 16) * ldc + col0;
#pragma unroll
                for (int bj = 0; bj < 2; ++bj) { f32x4 v0 = acc[ai][bj][m][0], v1 = acc[ai][bj][m][1];
                    if (ACT == 2) {
#pragma unroll
                        for (int e = 0; e < 4; ++e) { const float a = fmaxf(v0[e], 0.f), b = fmaxf(v1[e], 0.f); v0[e] = a * a; v1[e] = b * b; } }
                    u32x4 w; w.x = cvt_pk_bf16(v0[0], v0[1]); w.y = cvt_pk_bf16(v0[2], v0[3]); w.z = cvt_pk_bf16(v1[0], v1[1]); w.w = cvt_pk_bf16(v1[2], v1[3]);
                    *(u32x4*)(rowp + bj * HALF) = w; } asm volatile("" ::: "memory"); }
    }
};
struct EpiResid {
    static constexpr bool PERM = true;
    float* x; const float* gate; float* part;
    __device__ __forceinline__ void operator()(const f32x4 (&acc)[2][2][4][2], const Unit& u, int wr, int wc, int fr, int fq) const {
        fr = launder(fr); fq = launder(fq);
        const int row0 = u.pm * BM + wr * 64 + fr, col0 = u.pn * BM + wc * 32 + 8 * fq;
        if (u.kq >= 0) {
#pragma unroll
            for (int ai = 0; ai < 2; ++ai)
#pragma unroll
                for (int m = 0; m < 4; ++m) { bf16_t* rowp = (bf16_t*)part + ((size_t)u.kq * 4096 + (row0 + ai * HALF + m * 16 - 32768)) * DM + col0;
#pragma unroll
                    for (int bj = 0; bj < 2; ++bj) { const f32x4 a0 = acc[ai][bj][m][0], a1 = acc[ai][bj][m][1];
                        u32x4 o; o.x = cvt_pk_bf16(a0[0], a0[1]); o.y = cvt_pk_bf16(a0[2], a0[3]); o.z = cvt_pk_bf16(a1[0], a1[1]); o.w = cvt_pk_bf16(a1[2], a1[3]); *(u32x4*)(rowp + bj * HALF) = o; } }
            return;
        }
        const float* gp = gate + (size_t)modidx(u.pm * BM) * 6144 + col0;
        f32x4 gv[2][2];
#pragma unroll
        for (int bj = 0; bj < 2; ++bj)
#pragma unroll
            for (int n = 0; n < 2; ++n) gv[bj][n] = *(const f32x4*)(gp + bj * HALF + 4 * n);
#pragma unroll
        for (int ai = 0; ai < 2; ++ai) {
            u32x4 xw[4][2];
#pragma unroll
            for (int m = 0; m < 4; ++m)
#pragma unroll
                for (int bj = 0; bj < 2; ++bj) xw[m][bj] = *(const u32x4*)((const bf16_t*)x + (size_t)(row0 + ai * HALF + m * 16) * 2048 + col0 + bj * HALF);
#pragma unroll
            for (int m = 0; m < 4; ++m)
#pragma unroll
                for (int bj = 0; bj < 2; ++bj) { const u32x4 w = xw[m][bj];
                    const f32x4 xa = (f32x4){bflo(w.x), bfhi(w.x), bflo(w.y), bfhi(w.y)} + gv[bj][0] * acc[ai][bj][m][0], xb = (f32x4){bflo(w.z), bfhi(w.z), bflo(w.w), bfhi(w.w)} + gv[bj][1] * acc[ai][bj][m][1];
                    u32x4 o; o.x = cvt_pk_bf16(xa[0], xa[1]); o.y = cvt_pk_bf16(xa[2], xa[3]); o.z = cvt_pk_bf16(xb[0], xb[1]); o.w = cvt_pk_bf16(xb[2], xb[3]);
                    *(u32x4*)((bf16_t*)x + (size_t)(row0 + ai * HALF + m * 16) * 2048 + col0 + bj * HALF) = o; }
            asm volatile("" ::: "memory"); }
    }
};
__device__ __forceinline__ void st4(bf16_t* p, const f32x4 v) { u32x2 w; w.x = cvt_pk_bf16(v[0], v[1]); w.y = cvt_pk_bf16(v[2], v[3]); *(u32x2*)p = w; }
struct EpiAttnQKV {
    static constexpr bool PERM = false;
    bf16_t *q, *k, *v; float *nk, *nv; const float *qg, *kg; int slot;
    __device__ __forceinline__ void operator()(const f32x4 (&acc)[2][2][4][2], const Unit& u, int wr, int wc, int fr, int fq) const {
        fr = launder(fr); fq = launder(fq);
        const int pn = u.pn;
#pragma unroll
        for (int ai = 0; ai < 2; ++ai)
#pragma unroll
            for (int m = 0; m < 4; ++m) {
                const int r = u.pm * BM + ai * HALF + wr * 64 + m * 16 + fr;
                f32x4 v00 = acc[ai][0][m][0], v01 = acc[ai][0][m][1], v10 = acc[ai][1][m][0], v11 = acc[ai][1][m][1];
                if (pn < 5) {
                    float ss = 0.f;
#pragma unroll
                    for (int e = 0; e < 4; ++e) ss += v00[e] * v00[e] + v01[e] * v01[e] + v10[e] * v10[e] + v11[e] * v11[e];
                    ss += __shfl_xor(ss, 16); ss += __shfl_xor(ss, 32);
                    const float rs = rsqrtf(ss * (1.f / 64.f) + 1e-6f);
                    const float* gn = (pn < 4 ? qg : kg) + 4 * fq;
                    v00 = v00 * rs * *(const f32x4*)(gn); v01 = v01 * rs * *(const f32x4*)(gn + 16); v10 = v10 * rs * *(const f32x4*)(gn + 32); v11 = v11 * rs * *(const f32x4*)(gn + 48);
                    if (r >= NPROMPT) {
                        const int t = (r - NPROMPT) & 4095; const float rp = (float)(t >> 6), cp = (float)(t & 63);
#pragma unroll
                        for (int e = 0; e < 4; ++e) {
                            const float inv = __builtin_amdgcn_exp2f(-(float)(4 * fq + e) * (13.287712379549449f / 16.f)); float c, s;
                            rope_cs(rp, inv, c, s); { const float x1 = v00[e], x2 = v01[e]; v00[e] = x1 * c - x2 * s; v01[e] = x2 * c + x1 * s; }
                            rope_cs(cp, inv, c, s); { const float x1 = v10[e], x2 = v11[e]; v10[e] = x1 * c - x2 * s; v11[e] = x2 * c + x1 * s; }
                        }
                    }
                }
                if (pn < 4) {
                    bf16_t* d = q + (size_t)r * 1024 + (4 * pn + wc) * 64 + 4 * fq;
                    constexpr float QS = 0.125f * LOG2E; st4(d, v00 * QS); st4(d + 16, v01 * QS); st4(d + 32, v10 * QS); st4(d + 48, v11 * QS);
                } else {
                    bf16_t* d = (pn == 4 ? k : v) + (size_t)r * 256 + wc * 64 + 4 * fq;
                    st4(d, v00); st4(d + 16, v01); st4(d + 32, v10); st4(d + 48, v11);
                    if (r < NPROMPT) { const int b = r >> 8, t = r & 255; float* o = (pn == 4 ? nk : nv) + ((size_t)(b * 2 + slot) * 256 + t) * 256 + wc * 64 + 4 * fq;
                        *(f32x4*)o = v00; *(f32x4*)(o + 16) = v01; *(f32x4*)(o + 32) = v10; *(f32x4*)(o + 48) = v11; }
                }
            }
    }
};
struct EpiRetQKV {
    static constexpr bool PERM = false;
    bf16_t *q, *k, *v;
    __device__ __forceinline__ void operator()(const f32x4 (&acc)[2][2][4][2], const Unit& u, int wr, int wc, int fr, int fq) const {
        fr = launder(fr); fq = launder(fq);
        const int pn = u.pn;
#pragma unroll
        for (int ai = 0; ai < 2; ++ai)
#pragma unroll
            for (int m = 0; m < 4; ++m) {
                const int r = u.pm * BM + ai * HALF + wr * 64 + m * 16 + fr;
                f32x4 v00 = acc[ai][0][m][0], v01 = acc[ai][0][m][1], v10 = acc[ai][1][m][0], v11 = acc[ai][1][m][1];
                if (pn < 8) {
                    if (r >= NPROMPT) {
                        const int t = (r - NPROMPT) & 4095; const float rp = (float)(t >> 6), cp = (float)(t & 63);
#pragma unroll
                        for (int e = 0; e < 4; ++e) {
                            const float inv = __builtin_amdgcn_exp2f(-(float)(16 * wc + 4 * fq + e) * (13.287712379549449f / 64.f)); float c, s;
                            rope_cs(rp, inv, c, s); { const float x1 = v00[e], x2 = v01[e]; v00[e] = x1 * c - x2 * s; v01[e] = x2 * c + x1 * s; }
                            rope_cs(cp, inv, c, s); { const float x1 = v10[e], x2 = v11[e]; v10[e] = x1 * c - x2 * s; v11[e] = x2 * c + x1 * s; }
                        }
                    }
                    if (pn >= 4) { v00 = v00 * 0.0625f; v01 = v01 * 0.0625f; v10 = v10 * 0.0625f; v11 = v11 * 0.0625f; }
                }
                bf16_t* d = (pn < 4 ? q + (size_t)r * 1024 + pn * 256 : pn < 8 ? k + (size_t)r * 1024 + (pn - 4) * 256 : v + (size_t)r * 2048 + (pn - 8) * 256) + 16 * wc + 4 * fq;
                st4(d, v00); st4(d + 64, v01); st4(d + 128, v10); st4(d + 192, v11);
            }
    }
};
template <int MODE> struct EpiLateGate {
    static constexpr bool PERM = true;
    bf16_t* Z; int ldz; const float* fin; const float* gn;
    __device__ __forceinline__ void operator()(const f32x4 (&acc)[2][2][4][2], const Unit& u, int wr, int wc, int fr, int fq) const {
        fr = launder(fr); fq = launder(fq);
        const int row0 = u.pm * BM + wr * 64 + fr, col0 = u.pn * BM + wc * 32 + 8 * fq;
#pragma unroll
        for (int ai = 0; ai < 2; ++ai) {
            u32x4 zq[4][2];
#pragma unroll
            for (int m = 0; m < 4; ++m)
#pragma unroll
                for (int bj = 0; bj < 2; ++bj) zq[m][bj] = *(const u32x4*)(Z + (size_t)(row0 + ai * HALF + m * 16) * ldz + col0 + bj * HALF);
#pragma unroll
            for (int m = 0; m < 4; ++m) { const int r = row0 + ai * HALF + m * 16;
#pragma unroll
                for (int bj = 0; bj < 2; ++bj) { const int c0 = col0 + bj * HALF; bf16_t* zp = Z + (size_t)r * ldz + c0;
                    const u32x4 zw = zq[m][bj]; float z[8] = {bflo(zw.x), bfhi(zw.x), bflo(zw.y), bfhi(zw.y), bflo(zw.z), bfhi(zw.z), bflo(zw.w), bfhi(zw.w)};
                    float a[8]; { const f32x4 a0 = acc[ai][bj][m][0], a1 = acc[ai][bj][m][1]; a[0] = a0[0]; a[1] = a0[1]; a[2] = a0[2]; a[3] = a0[3]; a[4] = a1[0]; a[5] = a1[1]; a[6] = a1[2]; a[7] = a1[3]; }
                    float y[8];
                    if (MODE == 0) { const f32x2 st = *(const f32x2*)(fin + ((size_t)r * 4 + (c0 >> 9)) * 2); const f32x4 g0 = *(const f32x4*)(gn + c0), g1 = *(const f32x4*)(gn + c0 + 4);
                        const float gg[8] = {g0[0], g0[1], g0[2], g0[3], g1[0], g1[1], g1[2], g1[3]};
#pragma unroll
                        for (int e = 0; e < 8; ++e) y[e] = fsilu(a[e]) * ((z[e] - st.x) * st.y * gg[e]);
                    } else {
#pragma unroll
                        for (int e = 0; e < 8; ++e) y[e] = fgelu_tanh(a[e]) * z[e];
                    }
                    u32x4 w; w.x = cvt_pk_bf16(y[0], y[1]); w.y = cvt_pk_bf16(y[2], y[3]); w.z = cvt_pk_bf16(y[4], y[5]); w.w = cvt_pk_bf16(y[6], y[7]);
                    *(u32x4*)zp = w; } }
            asm volatile("" ::: "memory"); }
    }
};
struct EpiLruGates {
    static constexpr bool PERM = false;
    const bf16_t* xc; bf16_t *la, *uu; const float *br, *bi, *lam;
    __device__ __forceinline__ void operator()(const f32x4 (&acc)[2][2][4][2], const Unit& u, int wr, int wc, int fr, int fq) const {
        fr = launder(fr); fq = launder(fq);
        const int nb = u.pn >> 1, dir = u.pn & 1;
#pragma unroll
        for (int bj = 0; bj < 2; ++bj) {
            const int ch = nb * 128 + 64 * bj + 16 * wc + 4 * fq;
            const f32x4 brv = *(const f32x4*)(br + dir * 1024 + ch), biv = *(const f32x4*)(bi + dir * 1024 + ch), lv = *(const f32x4*)(lam + dir * 1024 + ch);
            f32x4 sp;
#pragma unroll
            for (int e = 0; e < 4; ++e) sp[e] = -8.f * __logf(1.f + __expf(-lv[e]));
#pragma unroll
            for (int ai = 0; ai < 2; ++ai)
#pragma unroll
                for (int m = 0; m < 4; ++m) {
                    const int r = u.pm * BM + ai * HALF + wr * 64 + m * 16 + fr;
                    const u32x2 xw = *(const u32x2*)(xc + (size_t)r * 1024 + ch); const float xv[4] = {bflo(xw.x), bfhi(xw.x), bflo(xw.y), bfhi(xw.y)};
                    const f32x4 rp = acc[ai][bj][m][0], ip = acc[ai][bj][m][1]; f32x4 lo, uo;
#pragma unroll
                    for (int e = 0; e < 4; ++e) { const float pa = 1.f + __expf(-(rp[e] + brv[e])), pb = 1.f + __expf(-(ip[e] + biv[e])); const float inv = __builtin_amdgcn_rcpf(pa * pb);
                        const float rg = pb * inv, ig = pa * inv; const float l = rg * sp[e]; lo[e] = l; uo[e] = __builtin_amdgcn_sqrtf(fmaxf(1.f - __expf(2.f * l), 0.f)) * ig * xv[e]; }
                    st4(la + ((size_t)r * 2 + dir) * 1024 + ch, lo); st4(uu + ((size_t)r * 2 + dir) * 1024 + ch, uo);
                    asm volatile("" ::: "memory");
                }
        }
    }
};
}
using pg8::st4;

struct KArgs { const float* in[32]; float* out; unsigned char* ws; };
struct KTab { const float* const* t; };
__device__ __forceinline__ const float* inp(const KTab& a, int k) { return a.t[k]; }
__device__ __forceinline__ const float* inp(const KArgs& a, int k) { return a.in[k]; }

__device__ __forceinline__ float wave_sum(float v) {
#pragma unroll
    for (int o = 1; o < 64; o <<= 1) v += __shfl_xor(v, o);
    return v;
}
__device__ __forceinline__ float wave_max(float v) {
#pragma unroll
    for (int o = 1; o < 64; o <<= 1) v = fmaxf(v, __shfl_xor(v, o));
    return v;
}

template <int MODE>
__device__ __forceinline__ const float* wcol(const float* s0, const float* s1, int n) {
    if (MODE == 0) return s0 + n;
    if (MODE == 1) { const int gp = (n >> 5) & 7, bj = gp >> 2, wc = gp & 3; return s0 + (n & ~255) + (2 * wc + bj) * 32 + (n & 31); }
    if (MODE == 2) { const int p = n & 255, bj = p >> 7, wc = (p >> 5) & 3, nn = (p >> 4) & 1, r = p & 15; return s0 + (n & ~255) + 128 * bj + 64 * nn + 16 * wc + r; }
    { const int pn = n >> 8, nb = pn >> 1, dir = pn & 1, p = n & 255, bj = p >> 7, wc = (p >> 5) & 3, nn = (p >> 4) & 1, r = p & 15; const int cb = 64 * bj + 16 * wc + r;
      return (nn ? s1 : s0) + (size_t)(dir * 8 + nb) * 16384 + cb; }
}
template <int MODE>
__device__ __forceinline__ void wconv(const float* s0, const float* s1, int ld, int K, int N, bf16_t* WT, LAS float* scr, int lane_, int gw, int NGW) {
    const int lane = lane_id_v(); (void)lane_; asm volatile("" : "+s"(gw));
    const int nblk = N / 32, nitems = (K / 64) * nblk;
    for (int item = gw; item < nitems; item += NGW) {
        const int kb = item / nblk, nb = item % nblk, k0 = 64 * kb, n0 = 32 * nb;
        const float* cp = wcol<MODE>(s0, s1, n0 + (lane & 31));
#pragma unroll 8
        for (int i = 0; i < 32; ++i) { const int kk = 2 * i + (lane >> 5); scr[kk * 33 + (lane & 31)] = cp[(size_t)(k0 + kk) * ld]; }
        asm volatile("s_waitcnt lgkmcnt(0)" ::: "memory");
        const int c = lane & 7;
#pragma unroll
        for (int j = 0; j < 4; ++j) { const int n = (lane >> 3) + 8 * j; const LAS float* s = scr + (8 * c) * 33 + n;
            u32x4 o; o.x = cvt_pk_bf16(s[0 * 33], s[1 * 33]); o.y = cvt_pk_bf16(s[2 * 33], s[3 * 33]); o.z = cvt_pk_bf16(s[4 * 33], s[5 * 33]); o.w = cvt_pk_bf16(s[6 * 33], s[7 * 33]);
            *(u32x4*)(WT + (size_t)(n0 + n) * K + k0 + 8 * c) = o; }
        asm volatile("s_waitcnt lgkmcnt(0)" ::: "memory");
    }
}
template <class AT>
__device__ __forceinline__ void convert_layer_weights(const AT& a, unsigned char* ws, int layer, LAS unsigned char* lds, int wave, int lane, int gw, int NGW) {
    LAS float* scr = (LAS float*)(lds + wave * 8448);
    wconv<0>(inp(a, 12) + (size_t)layer * DM * DFF, nullptr, DFF, DM, DFF, (bf16_t*)(ws + WS_WUP), scr, lane, gw, NGW);
    wconv<0>(inp(a, 13) + (size_t)layer * DFF * DM, nullptr, DM, DFF, DM, (bf16_t*)(ws + WS_WDN), scr, lane, gw, NGW);
    const int kind = layer % 3, slot = layer / 3;
    if (kind == 0) {
        wconv<1>(inp(a, 14) + (size_t)slot * DM * 1536, nullptr, 1536, DM, 1536, (bf16_t*)(ws + WS_WIN), scr, lane, gw, NGW);
        wconv<0>(inp(a, 15) + (size_t)slot * DM * DM, nullptr, DM, DM, DM, (bf16_t*)(ws + WS_WOUT), scr, lane, gw, NGW);
    } else if (kind == 1) {
        wconv<2>(inp(a, 19) + (size_t)slot * DM * 6144, nullptr, 6144, DM, 4096, (bf16_t*)(ws + WS_WIN), scr, lane, gw, NGW);
        wconv<0>(inp(a, 19) + (size_t)slot * DM * 6144 + 4096, nullptr, 6144, DM, 2048, (bf16_t*)(ws + WS_WX), scr, lane, gw, NGW);
        wconv<0>(inp(a, 20) + (size_t)slot * 2048 * DM, nullptr, DM, 2048, DM, (bf16_t*)(ws + WS_WOUT), scr, lane, gw, NGW);
    } else {
        wconv<0>(inp(a, 23) + (size_t)slot * DM * 2048 + 1024, nullptr, 2048, DM, 1024, (bf16_t*)(ws + WS_WIN), scr, lane, gw, NGW);
        wconv<0>(inp(a, 23) + (size_t)slot * DM * 2048, nullptr, 2048, DM, 1024, (bf16_t*)(ws + WS_WX), scr, lane, gw, NGW);
        wconv<3>(inp(a, 26) + (size_t)slot * 2 * 8 * 16384, inp(a, 28) + (size_t)slot * 2 * 8 * 16384, 128, 128, 4096, (bf16_t*)(ws + WS_WX2), scr, lane, gw, NGW);
        wconv<0>(inp(a, 31) + (size_t)slot * DM * DM, nullptr, DM, DM, DM, (bf16_t*)(ws + WS_WOUT), scr, lane, gw, NGW);
    }
}

__device__ __forceinline__ void mod_phase(const KArgs& a, LAS unsigned char* lds, const int wv) {
    LAS float* sc = (LAS float*)lds;
    LAS float* red = (LAS float*)(lds + 36864);
    const int tid = (wv * 64 + lane_id_v());
    if (bid_s() >= 384) return;
    for (int i = tid; i < 9 * 1024; i += 512) { const int j = i >> 10, k = i & 1023; const float v = j == 0 ? inp(a, 7)[k] : inp(a, 6)[(j - 1) * 1024 + k]; sc[i] = fsilu(v); }
    __syncthreads();
    float* modt = (float*)(a.ws + WS_MOD);
    const int cl = tid & 63, ks = tid >> 6;
    for (int item = bid_s(); item < 384; item += gridDim.x) {
        const int l = item / 96, cg_ = item % 96, col = cg_ * 64 + cl;
        const float* w = inp(a, 10) + (size_t)l * DM * 6144 + col;
        float acc[9];
#pragma unroll
        for (int j = 0; j < 9; ++j) acc[j] = 0.f;
        for (int k0 = ks * 128; k0 < ks * 128 + 128; k0 += 16) {
            float wv[16];
#pragma unroll
            for (int u = 0; u < 16; ++u) wv[u] = w[(size_t)(k0 + u) * 6144];
#pragma unroll
            for (int u = 0; u < 16; ++u)
#pragma unroll
                for (int j = 0; j < 9; ++j) acc[j] += sc[j * 1024 + k0 + u] * wv[u];
        }
#pragma unroll
        for (int j = 0; j < 9; ++j) red[(ks * 9 + j) * 64 + cl] = acc[j];
        __syncthreads();
        for (int idx = tid; idx < 576; idx += 512) { const int j = idx >> 6, c2 = idx & 63; float s = inp(a, 11)[(size_t)l * 6144 + cg_ * 64 + c2];
#pragma unroll
            for (int q = 0; q < 8; ++q) s += red[(q * 9 + j) * 64 + c2];
            modt[((size_t)l * 9 + j) * 6144 + cg_ * 64 + c2] = s; }
        __syncthreads();
    }
}
__device__ __forceinline__ void cache_phase(const KArgs& a, const int wv) {
    const size_t n4 = (size_t)8 * 2 * 512 * 256 / 4;
    for (size_t i = (size_t)bid_s() * 512 + (wv * 64 + lane_id_v()); i < 2 * n4; i += (size_t)gridDim.x * 512) {
        const bool isv = i >= n4; const size_t j = isv ? i - n4 : i;
        const f32x4 v = *(const f32x4*)((isv ? inp(a, 3) : inp(a, 2)) + j * 4);
        st4((bf16_t*)(a.ws + (isv ? WS_CV : WS_CK)) + j * 4, v);
    }
}
template <bool FIRST>
__device__ __forceinline__ void norm_phase(const float* xp_, const float* xs_, float* xres, const float* gain, const float* modl, int sh_chunk, bf16_t* hout, int lane_, int gw, int NGW, const float* part = nullptr, const float* fixgate = nullptr) {
    const int lane = lane_id_v(); (void)lane_; asm volatile("" : "+s"(gw));
    for (int r = gw; r < MTOK; r += NGW) {
        const float* xr = FIRST ? (r < NPROMPT ? xp_ + (size_t)r * DM : xs_ + (size_t)(r - NPROMPT) * DM) : nullptr;
        bf16_t* xb = (bf16_t*)xres + (size_t)r * 2048;
        f32x4 v[4]; float s = 0.f;
#pragma unroll
        for (int j = 0; j < 4; ++j) {
            if (FIRST) v[j] = *(const f32x4*)(xr + 4 * lane + 256 * j);
            else { const u32x2 w = *(const u32x2*)(xb + 4 * lane + 256 * j); v[j] = (f32x4){bflo(w.x), bfhi(w.x), bflo(w.y), bfhi(w.y)}; }
            s += v[j][0] * v[j][0] + v[j][1] * v[j][1] + v[j][2] * v[j][2] + v[j][3] * v[j][3]; }
        if (FIRST) {
#pragma unroll
            for (int j = 0; j < 4; ++j) st4(xb + 4 * lane + 256 * j, v[j]);
        }
        if (!FIRST && part != nullptr && r >= 32768) {
            const float* gp = fixgate + (size_t)modidx(r) * 6144; s = 0.f;
#pragma unroll
            for (int j = 0; j < 4; ++j) { const int c = 4 * lane + 256 * j; const bf16_t* pp = (const bf16_t*)part + (size_t)(r - 32768) * DM + c;
                const f32x4 ps = ((ld4bf(pp) + ld4bf(pp + (size_t)4096 * DM)) + ld4bf(pp + (size_t)2 * 4096 * DM)) + ld4bf(pp + (size_t)3 * 4096 * DM);
                v[j] = v[j] + *(const f32x4*)(gp + c) * ps; st4(xb + c, v[j]);
                s += v[j][0] * v[j][0] + v[j][1] * v[j][1] + v[j][2] * v[j][2] + v[j][3] * v[j][3]; }
        }
        const float rs = rsqrtf(wave_sum(s) * (1.f / DM) + 1e-6f);
        const float* mp = modl + (size_t)modidx(r) * 6144 + sh_chunk * 1024;
#pragma unroll
        for (int j = 0; j < 4; ++j) { const int c = 4 * lane + 256 * j; const f32x4 g = *(const f32x4*)(gain + c), sh = *(const f32x4*)(mp + c), sc = *(const f32x4*)(mp + 1024 + c);
            const f32x4 y = v[j] * rs * g * (1.f + sc) + sh; st4(hout + (size_t)r * DM + c, y); }
    }
}

__device__ __forceinline__ bf16x8 tr8(const LAS bf16_t* p0, const LAS bf16_t* p1) {
    const s16x4 a = __builtin_amdgcn_ds_read_tr16_b64_v4i16((LAS s16x4*)p0);
    const s16x4 b = __builtin_amdgcn_ds_read_tr16_b64_v4i16((LAS s16x4*)p1);
    return (bf16x8){a[0], a[1], a[2], a[3], b[0], b[1], b[2], b[3]};
}
__device__ __forceinline__ f32x16 mfma32(bf16x8 a, bf16x8 b, f32x16 c) { return __builtin_amdgcn_mfma_f32_32x32x16_bf16(a, b, c, 0, 0, 0); }
__device__ __forceinline__ f32x4 mfma16(bf16x8 a, bf16x8 b, f32x4 c) { return __builtin_amdgcn_mfma_f32_16x16x32_bf16(a, b, c, 0, 0, 0); }
__device__ __forceinline__ float fexp2(float x) { return __builtin_amdgcn_exp2f(x); }

__device__ __forceinline__ void att_tile(const LAS bf16_t* Ks, const LAS bf16_t* Vs, const bf16x8 (&Qf)[2][4], f32x16 (&ot)[2][2], float (&mrun)[2], float (&lrun)[2],
                                         bool skipw, bool needmask, int kpos0, int qpos0, int l31, int lh, int q4, int p4, int blk) {
            if (!skipw) {
                f32x16 sc[2][2];
#pragma unroll
                for (int cb = 0; cb < 2; ++cb)
#pragma unroll
                    for (int kk = 0; kk < 2; ++kk)
#pragma unroll
                        for (int r = 0; r < 16; ++r) sc[cb][kk][r] = 0.f;
#pragma unroll
                for (int s = 0; s < 4; ++s) {
                    const bf16x8 k0 = *(const LAS bf16x8*)(Ks + l31 * 72 + 16 * s + 8 * lh), k1 = *(const LAS bf16x8*)(Ks + (32 + l31) * 72 + 16 * s + 8 * lh);
                    sc[0][0] = mfma32(k0, Qf[0][s], sc[0][0]); sc[0][1] = mfma32(k1, Qf[0][s], sc[0][1]);
                    sc[1][0] = mfma32(k0, Qf[1][s], sc[1][0]); sc[1][1] = mfma32(k1, Qf[1][s], sc[1][1]);
                }
                bf16x8 pf[2][2][2];
#pragma unroll
                for (int cb = 0; cb < 2; ++cb) {
                    const int qpos = qpos0 + cb * 32 + l31;
                    float mx = -3.0e38f;
                    if (needmask) {
#pragma unroll
                        for (int r = 0; r < 16; ++r) { const int d0 = kpos0 + (r & 3) + 8 * (r >> 2) + 4 * lh - qpos, d1 = d0 + 32;
                            if (d0 > 128 || d0 < -128) sc[cb][0][r] = -1e30f; if (d1 > 128 || d1 < -128) sc[cb][1][r] = -1e30f; }
                    }
#pragma unroll
                    for (int r = 0; r < 16; ++r) mx = fmaxf(mx, fmaxf(sc[cb][0][r], sc[cb][1][r]));
                    mx = fmaxf(mx, __shfl_xor(mx, 32));
                    const float mnew = fmaxf(mrun[cb], mx), alpha = fexp2(mrun[cb] - mnew); mrun[cb] = mnew;
                    float ls = 0.f;
#pragma unroll
                    for (int r = 0; r < 16; ++r) { sc[cb][0][r] = fexp2(sc[cb][0][r] - mnew); sc[cb][1][r] = fexp2(sc[cb][1][r] - mnew); ls += sc[cb][0][r] + sc[cb][1][r]; }
                    lrun[cb] = lrun[cb] * alpha + ls;
                    if (__builtin_amdgcn_ballot_w64(alpha != 1.f) != 0ull) { ot[0][cb] = ot[0][cb] * alpha; ot[1][cb] = ot[1][cb] * alpha; }
#pragma unroll
                    for (int kk = 0; kk < 2; ++kk)
#pragma unroll
                        for (int s2 = 0; s2 < 2; ++s2) {
                            u32x4 w0;
                            w0.x = cvt_pk_bf16(sc[cb][kk][8 * s2 + 0], sc[cb][kk][8 * s2 + 1]); w0.y = cvt_pk_bf16(sc[cb][kk][8 * s2 + 2], sc[cb][kk][8 * s2 + 3]);
                            w0.z = cvt_pk_bf16(sc[cb][kk][8 * s2 + 4], sc[cb][kk][8 * s2 + 5]); w0.w = cvt_pk_bf16(sc[cb][kk][8 * s2 + 6], sc[cb][kk][8 * s2 + 7]);
                            pf[cb][kk][s2] = __builtin_bit_cast(bf16x8, w0);
                        }
                }
#pragma unroll
                for (int db = 0; db < 2; ++db)
#pragma unroll
                    for (int kbk = 0; kbk < 2; ++kbk)
#pragma unroll
                        for (int s2 = 0; s2 < 2; ++s2) {
                            const LAS bf16_t* vp = Vs + (kbk * 32 + 16 * s2 + 4 * lh + q4) * 72 + 32 * db + 16 * blk + 4 * p4;
                            const bf16x8 vf = tr8(vp, vp + 8 * 72);
                            ot[db][0] = mfma32(vf, pf[0][kbk][s2], ot[db][0]);
                            ot[db][1] = mfma32(vf, pf[1][kbk][s2], ot[db][1]);
                        }
            }
}
__device__ __forceinline__ void attn_phase(LAS unsigned char* lds, const bf16_t* qb, const bf16_t* kb, const bf16_t* vb, const bf16_t* ck, const bf16_t* cv, bf16_t* ob, const float* sink, const int wv) {
    LAS bf16_t* Ks = (LAS bf16_t*)lds; LAS bf16_t* Vs = (LAS bf16_t*)(lds + 9216);
    const int wid = wv, lane = lane_id_v(), tid = wid * 64 + lane, g = wid >> 1, qh = wid & 1;
    const int l31 = lane & 31, lh = lane >> 5, q4 = (lane & 15) >> 2, p4 = lane & 3, blk = (lane >> 4) & 1;
    const int skey = tid >> 3, sdc = tid & 7;
    for (int it = bid_s(); it < 1152; it += gridDim.x) {
        int b, hk, seqrow0, T, qbase, nlat, latk0, nctx; bool masked;
        if (it < 1024) { b = it >> 7; const int n = (it >> 2) & 31; hk = it & 3; seqrow0 = NPROMPT + b * 4096; T = 4096; qbase = n * 128; nlat = 6; latk0 = qbase - 128; nctx = 8; masked = true; }
        else { const int i2 = it - 1024; b = i2 >> 3; hk = (i2 >> 1) & 3; seqrow0 = b * 256; T = 256; qbase = (i2 & 1) * 128; nlat = 4; latk0 = 0; nctx = 0; masked = false; }
        const int h = hk * 4 + g, qpos0 = qbase + 64 * qh, ntiles = nlat + nctx;
        bf16x8 Qf[2][4];
#pragma unroll
        for (int cb = 0; cb < 2; ++cb)
#pragma unroll
            for (int s = 0; s < 4; ++s) Qf[cb][s] = *(const bf16x8*)(qb + (size_t)(seqrow0 + qpos0 + cb * 32 + l31) * 1024 + h * 64 + 16 * s + 8 * lh);
        float mrun[2], lrun[2]; f32x16 ot[2][2];
        const float sk = sink[h] * LOG2E;
        mrun[0] = sk; mrun[1] = sk; lrun[0] = lh == 0 ? 1.f : 0.f; lrun[1] = lrun[0];
#pragma unroll
        for (int i = 0; i < 2; ++i)
#pragma unroll
            for (int j = 0; j < 2; ++j)
#pragma unroll
                for (int r = 0; r < 16; ++r) ot[i][j][r] = 0.f;
        int ti = 0; while (ti < nlat && latk0 + 64 * ti < 0) ++ti;
        u32x4 kr0, vr0, kr1, vr1;
#define ATT_NEXT(tt) (((tt) + 1 < nlat && latk0 + 64 * ((tt) + 1) >= T) ? nlat : (tt) + 1)
#define ATT_LD(tt, KR, VR) do { const bf16_t *kp_, *vp_; if ((tt) < nlat) { const size_t o_ = (size_t)(seqrow0 + latk0 + 64 * (tt) + skey) * 256 + hk * 64 + sdc * 8; kp_ = kb + o_; vp_ = vb + o_; } \
            else { const size_t o_ = ((size_t)b * 1024 + 64 * ((tt) - nlat) + skey) * 256 + hk * 64 + sdc * 8; kp_ = ck + o_; vp_ = cv + o_; } KR = *(const u32x4*)kp_; VR = *(const u32x4*)vp_; } while (0)
#define ATT_FLAGS(cur_, SK, NM, KP) const bool SK##l_ = (cur_) < nlat; const int KP = latk0 + 64 * (cur_); bool SK = false, NM = false; \
            if (masked && SK##l_) { SK = (KP > qpos0 + 63 + 128) || (KP + 63 < qpos0 - 128); NM = (KP < qpos0 - 64) || (KP > qpos0 + 64); }
        int tp = ti, tq = ATT_NEXT(tp);
        ATT_LD(tp, kr0, vr0); ATT_LD(tq, kr1, vr1);
        while (tp < ntiles) {
            __syncthreads();
            *(LAS u32x4*)(Ks + skey * 72 + sdc * 8) = kr0; *(LAS u32x4*)(Vs + skey * 72 + sdc * 8) = vr0;
            *(LAS u32x4*)(Ks + 9216 + skey * 72 + sdc * 8) = kr1; *(LAS u32x4*)(Vs + 9216 + skey * 72 + sdc * 8) = vr1;
            __syncthreads();
            const int c0 = tp, c1 = tq;
            tp = ATT_NEXT(tq); tq = ATT_NEXT(tp);
            if (tp < ntiles) { ATT_LD(tp, kr0, vr0); ATT_LD(tq, kr1, vr1); }
            { ATT_FLAGS(c0, sk0, nm0, kp0) att_tile(Ks, Vs, Qf, ot, mrun, lrun, sk0, nm0, kp0, qpos0, l31, lh, q4, p4, blk); }
            { ATT_FLAGS(c1, sk1, nm1, kp1) att_tile(Ks + 9216, Vs + 9216, Qf, ot, mrun, lrun, sk1, nm1, kp1, qpos0, l31, lh, q4, p4, blk); }
        }
#undef ATT_NEXT
#undef ATT_LD
#undef ATT_FLAGS
#pragma unroll
        for (int cb = 0; cb < 2; ++cb) {
            const float lt = lrun[cb] + __shfl_xor(lrun[cb], 32), inv = 1.f / lt;
            bf16_t* orow = ob + (size_t)(seqrow0 + qpos0 + cb * 32 + l31) * 1024 + h * 64;
#pragma unroll
            for (int db = 0; db < 2; ++db)
#pragma unroll
                for (int rg = 0; rg < 4; ++rg) { const f32x4 v = {ot[db][cb][4 * rg] * inv, ot[db][cb][4 * rg + 1] * inv, ot[db][cb][4 * rg + 2] * inv, ot[db][cb][4 * rg + 3] * inv};
                    st4(orow + db * 32 + 8 * rg + 4 * lh, v); }
        }
    }
}

__device__ __forceinline__ void ret_scan_phase(LAS unsigned char* lds, const bf16_t* qb, const bf16_t* kb, const bf16_t* vb, bf16_t* ob, float* statp, const float* logdec, const float* state_in, float* state_out, const int wv) {
    constexpr int QST = 264, VST = 72;
    LAS bf16_t* Qs = (LAS bf16_t*)lds; LAS bf16_t* Ks = (LAS bf16_t*)(lds + 33792); LAS bf16_t* ST = (LAS bf16_t*)(lds + 67584);
    LAS bf16_t* Vs0 = (LAS bf16_t*)(lds + 101376); LAS bf16_t* Vw = (LAS bf16_t*)(lds + 110592); LAS bf16_t* Ps = (LAS bf16_t*)(lds + 119808);
    const int w = wv, lane = lane_id_v(), tid = w * 64 + lane, c16 = lane & 15, g = lane >> 4, q4 = (lane & 15) >> 2, p4 = lane & 3;
    const int itl = w >> 1, eb = 2 * (w & 1);
    for (int rnd = 0; rnd < 3; ++rnd) {
        const int bid = bid_s(), xx = bid & 7, ss = bid >> 3;
        const bool samp = rnd == 0; const int gidx = (samp ? 0 : (rnd - 1) * 32) + xx * 4 + (ss >> 3); const int b = gidx >> 2, head = gidx & 3, sl = ss & 7;
        const int seqrow0 = samp ? NPROMPT + b * 4096 : b * 256, T = samp ? 4096 : 256, nc = T / 64;
        for (int dir = 0; dir < 2; ++dir) {
            const float lg2 = logdec[dir * 4 + head] * LOG2E;
            f32x4 sacc[2][4];
#pragma unroll
            for (int dd = 0; dd < 2; ++dd)
#pragma unroll
                for (int et = 0; et < 4; ++et)
#pragma unroll
                    for (int r = 0; r < 4; ++r)
                        sacc[dd][et][r] = samp ? state_in[((((size_t)b * 2 + dir) * 4 + head) * 256 + 32 * w + 16 * dd + 4 * g + r) * 512 + sl * 64 + 16 * et + c16] : 0.f;
            __syncthreads();
#pragma unroll
            for (int dd = 0; dd < 2; ++dd)
#pragma unroll
                for (int et = 0; et < 4; ++et) { u32x2 wv; wv.x = cvt_pk_bf16(sacc[dd][et][0], sacc[dd][et][1]); wv.y = cvt_pk_bf16(sacc[dd][et][2], sacc[dd][et][3]);
                    *(LAS u32x2*)(ST + (16 * et + c16) * QST + 32 * w + 16 * dd + 4 * g) = wv; }
            u32x4 qreg[4], kreg[4], vreg;
#define RET_LOAD(cc_) do { const int t0_ = 64 * (cc_); _Pragma("unroll") for (int p = 0; p < 4; ++p) { const int idx = tid + 512 * p, row = idx >> 5, ch = idx & 31; \
                const size_t o_ = (size_t)(seqrow0 + t0_ + row) * 1024 + head * 256 + ch * 8; qreg[p] = *(const u32x4*)(qb + o_); kreg[p] = *(const u32x4*)(kb + o_); } \
                vreg = *(const u32x4*)(vb + (size_t)(seqrow0 + t0_ + (tid >> 3)) * 2048 + head * 512 + sl * 64 + (tid & 7) * 8); } while (0)
            RET_LOAD(dir ? nc - 1 : 0);
            const float gC = fexp2(lg2 * 64.f);
            float dec[2][4];
#pragma unroll
            for (int x = 0; x < 2; ++x)
#pragma unroll
                for (int r = 0; r < 4; ++r) { const int i = itl * 16 + c16, j = (eb + x) * 16 + 4 * g + r; const int df = dir ? j - i : i - j; const bool ok = dir ? df > 0 : df >= 0; dec[x][r] = ok ? fexp2(lg2 * (float)df) : 0.f; }
            const float wq_c = fexp2(lg2 * (float)(dir ? 64 - (itl * 16 + c16) : (itl * 16 + c16) + 1));
            const float wsj_c = fexp2(lg2 * (float)(dir ? (tid >> 3) : 63 - (tid >> 3)));
            for (int cc = 0; cc < nc; ++cc) {
                const int c = dir ? nc - 1 - cc : cc, t0 = 64 * c;
                LAS bf16_t* Vs = Vs0 + (cc & 1) * 13824;
#pragma unroll
                for (int p = 0; p < 4; ++p) { const int idx = tid + 512 * p, row = idx >> 5, ch = idx & 31; *(LAS u32x4*)(Qs + row * QST + ch * 8) = qreg[p]; *(LAS u32x4*)(Ks + row * QST + ch * 8) = kreg[p]; }
                { const int row = tid >> 3, ch = tid & 7; *(LAS u32x4*)(Vs + row * VST + ch * 8) = vreg;
                  const float wsj = wsj_c; u32x4 sv;
                  sv.x = cvt_pk_bf16(bflo(vreg.x) * wsj, bfhi(vreg.x) * wsj); sv.y = cvt_pk_bf16(bflo(vreg.y) * wsj, bfhi(vreg.y) * wsj);
                  sv.z = cvt_pk_bf16(bflo(vreg.z) * wsj, bfhi(vreg.z) * wsj); sv.w = cvt_pk_bf16(bflo(vreg.w) * wsj, bfhi(vreg.w) * wsj);
                  *(LAS u32x4*)(Vw + row * VST + ch * 8) = sv; }
                __syncthreads();
                if (cc + 1 < nc) RET_LOAD(dir ? nc - 2 - cc : cc + 1);
                const int orow = seqrow0 + t0 + itl * 16 + c16; bf16_t* op = ob + (size_t)orow * 2048 + head * 512 + sl * 64 + 4 * g;
                u32x2 pw0 = {0u, 0u}, pw1 = {0u, 0u};
                if (dir) { pw0 = *(const u32x2*)(op + eb * 16); pw1 = *(const u32x2*)(op + (eb + 1) * 16); }
                bf16x8 qf[8];
#pragma unroll
                for (int ks = 0; ks < 8; ++ks) qf[ks] = *(const LAS bf16x8*)(Qs + (itl * 16 + c16) * QST + 32 * ks + 8 * g);
#pragma unroll
                for (int x = 0; x < 2; ++x) {
                    const int jt = eb + x; f32x4 pt = {0.f, 0.f, 0.f, 0.f};
#pragma unroll
                    for (int ks = 0; ks < 8; ++ks) pt = mfma16(*(const LAS bf16x8*)(Ks + (jt * 16 + c16) * QST + 32 * ks + 8 * g), qf[ks], pt);
                    const int i = itl * 16 + c16; f32x4 pv;
#pragma unroll
                    for (int r = 0; r < 4; ++r) pv[r] = pt[r] * dec[x][r];
                    u32x2 wv; wv.x = cvt_pk_bf16(pv[0], pv[1]); wv.y = cvt_pk_bf16(pv[2], pv[3]);
                    *(LAS u32x2*)(Ps + i * VST + jt * 16 + 4 * g) = wv;
                }
                f32x4 oc[2];
                { const float wq = wq_c;
#pragma unroll
                  for (int x = 0; x < 2; ++x) { const int et = eb + x; f32x4 o = {0.f, 0.f, 0.f, 0.f};
#pragma unroll
                      for (int ks = 0; ks < 8; ++ks) o = mfma16(*(const LAS bf16x8*)(ST + (et * 16 + c16) * QST + 32 * ks + 8 * g), qf[ks], o);
                      oc[x] = o * wq; } }
#pragma unroll
                for (int dd = 0; dd < 2; ++dd)
#pragma unroll
                    for (int et = 0; et < 4; ++et) sacc[dd][et] = sacc[dd][et] * gC;
#pragma unroll
                for (int ks = 0; ks < 2; ++ks) {
                    bf16x8 bfr[4];
#pragma unroll
                    for (int et = 0; et < 4; ++et) { const LAS bf16_t* vp = Vw + (32 * ks + 8 * g + q4) * VST + 16 * et + 4 * p4; bfr[et] = tr8(vp, vp + 4 * VST); }
#pragma unroll
                    for (int dd = 0; dd < 2; ++dd) { const LAS bf16_t* kp = Ks + (32 * ks + 8 * g + q4) * QST + 32 * w + 16 * dd + 4 * p4; const bf16x8 af = tr8(kp, kp + 4 * QST);
#pragma unroll
                        for (int et = 0; et < 4; ++et) sacc[dd][et] = mfma16(af, bfr[et], sacc[dd][et]); }
                }
                __syncthreads();
#pragma unroll
                for (int x = 0; x < 2; ++x) { const int et = eb + x;
#pragma unroll
                    for (int ks = 0; ks < 2; ++ks) { const LAS bf16_t* vp = Vs + (32 * ks + 8 * g + q4) * VST + 16 * et + 4 * p4;
                        oc[x] = mfma16(tr8(vp, vp + 4 * VST), *(const LAS bf16x8*)(Ps + (itl * 16 + c16) * VST + 32 * ks + 8 * g), oc[x]); } }
                { const int row = orow;
                  if (dir == 0) { st4(op + eb * 16, oc[0]); st4(op + (eb + 1) * 16, oc[1]); }
                  else { float s1 = 0.f, s2 = 0.f;
#pragma unroll
                      for (int x = 0; x < 2; ++x) { bf16_t* o2 = op + (eb + x) * 16; const u32x2 pw = x ? pw1 : pw0; f32x4 f = oc[x];
                          f[0] += bflo(pw.x); f[1] += bfhi(pw.x); f[2] += bflo(pw.y); f[3] += bfhi(pw.y); st4(o2, f);
                          s1 += f[0] + f[1] + f[2] + f[3]; s2 += f[0] * f[0] + f[1] * f[1] + f[2] * f[2] + f[3] * f[3]; }
                      s1 += __shfl_xor(s1, 16); s1 += __shfl_xor(s1, 32); s2 += __shfl_xor(s2, 16); s2 += __shfl_xor(s2, 32);
                      if (g == 0) *(f32x2*)(statp + (((size_t)row * 4 + head) * 16 + sl * 2 + (w & 1)) * 2) = (f32x2){s1, s2}; } }
#pragma unroll
                for (int dd = 0; dd < 2; ++dd)
#pragma unroll
                    for (int et = 0; et < 4; ++et) { u32x2 wv; wv.x = cvt_pk_bf16(sacc[dd][et][0], sacc[dd][et][1]); wv.y = cvt_pk_bf16(sacc[dd][et][2], sacc[dd][et][3]);
                        *(LAS u32x2*)(ST + (16 * et + c16) * QST + 32 * w + 16 * dd + 4 * g) = wv; }
            }
#undef RET_LOAD
            if (!samp) {
#pragma unroll
                for (int dd = 0; dd < 2; ++dd)
#pragma unroll
                    for (int et = 0; et < 4; ++et)
#pragma unroll
                        for (int r = 0; r < 4; ++r)
                            state_out[((((size_t)b * 2 + dir) * 4 + head) * 256 + 32 * w + 16 * dd + 4 * g + r) * 512 + sl * 64 + 16 * et + c16] = sacc[dd][et][r];
            }
        }
    }
}
__device__ __forceinline__ void ret_fin_phase(const float* statp, float* fin, const int wv) {
    for (int i = bid_s() * 512 + (wv * 64 + lane_id_v()); i < MTOK * 4; i += gridDim.x * 512) {
        float s1 = 0.f, s2 = 0.f;
#pragma unroll
        for (int p = 0; p < 16; ++p) { const f32x2 v = *(const f32x2*)(statp + ((size_t)i * 16 + p) * 2); s1 += v.x; s2 += v.y; }
        const float mu = s1 * (1.f / 512.f), var = fmaxf(s2 * (1.f / 512.f) - mu * mu, 0.f);
        *(f32x2*)(fin + (size_t)i * 2) = (f32x2){mu, rsqrtf(var + 1e-6f)};
    }
}

__device__ __forceinline__ void lru_conv_phase(const bf16_t* xr, bf16_t* xc, const float* cw, const float* cbias, const int wv) {
    for (size_t i = (size_t)bid_s() * 512 + (wv * 64 + lane_id_v()); i < (size_t)MTOK * 128; i += (size_t)gridDim.x * 512) {
        const int r = (int)(i >> 7), c8 = (int)(i & 127) * 8;
        const int t = r < NPROMPT ? (r & 255) : ((r - NPROMPT) & 4095), T = r < NPROMPT ? 256 : 4096;
        float acc[8];
        { const f32x4 b0 = *(const f32x4*)(cbias + c8), b1 = *(const f32x4*)(cbias + c8 + 4); acc[0] = b0[0]; acc[1] = b0[1]; acc[2] = b0[2]; acc[3] = b0[3]; acc[4] = b1[0]; acc[5] = b1[1]; acc[6] = b1[2]; acc[7] = b1[3]; }
#pragma unroll
        for (int jj = 0; jj < 4; ++jj) { const int tt = t - 2 + jj;
            if (tt >= 0 && tt < T) { const u32x4 xw = *(const u32x4*)(xr + (size_t)(r - 2 + jj) * 1024 + c8); const f32x4 w0 = *(const f32x4*)(cw + jj * 1024 + c8), w1 = *(const f32x4*)(cw + jj * 1024 + c8 + 4);
                acc[0] += w0[0] * bflo(xw.x); acc[1] += w0[1] * bfhi(xw.x); acc[2] += w0[2] * bflo(xw.y); acc[3] += w0[3] * bfhi(xw.y);
                acc[4] += w1[0] * bflo(xw.z); acc[5] += w1[1] * bfhi(xw.z); acc[6] += w1[2] * bflo(xw.w); acc[7] += w1[3] * bfhi(xw.w); } }
        u32x4 o; o.x = cvt_pk_bf16(acc[0], acc[1]); o.y = cvt_pk_bf16(acc[2], acc[3]); o.z = cvt_pk_bf16(acc[4], acc[5]); o.w = cvt_pk_bf16(acc[6], acc[7]);
        *(u32x4*)(xc + (size_t)r * 1024 + c8) = o;
    }
}
__device__ __forceinline__ void lru_scanA_phase(const bf16_t* __restrict__ la, const bf16_t* __restrict__ uu, float* __restrict__ agg, const int wv) {
    constexpr int NS = 8 * 2 * 32 * 512, NP = 16 * 2 * 2 * 512;
    for (int idx = bid_s() * 512 + (wv * 64 + lane_id_v()); idx < NS + NP; idx += gridDim.x * 512) {
        int cp, dir, row0, segidx;
        if (idx < NS) { cp = idx & 511; const int seg = (idx >> 9) & 31; dir = (idx >> 14) & 1; const int b = idx >> 15; row0 = NPROMPT + b * 4096 + seg * 128; segidx = (b * 2 + dir) * 32 + seg; }
        else { const int i2 = idx - NS; cp = i2 & 511; const int seg = (i2 >> 9) & 1; dir = (i2 >> 10) & 1; const int b = i2 >> 11; row0 = b * 256 + seg * 128; segidx = 512 + (b * 2 + dir) * 2 + seg; }
        float L0 = 0.f, L1 = 0.f, H0 = 0.f, H1 = 0.f;
        for (int s0 = 0; s0 < 128; s0 += 16) {
            unsigned lw[16], uw[16];
#pragma unroll
            for (int j = 0; j < 16; ++j) { const int r = row0 + (dir ? 127 - (s0 + j) : s0 + j); const size_t o = ((size_t)r * 2 + dir) * 1024 + 2 * cp; lw[j] = *(const unsigned*)(la + o); uw[j] = *(const unsigned*)(uu + o); }
#pragma unroll
            for (int j = 0; j < 16; ++j) { const float l0 = bflo(lw[j]), l1 = bfhi(lw[j]); H0 = __expf(l0) * H0 + bflo(uw[j]); H1 = __expf(l1) * H1 + bfhi(uw[j]); L0 += l0; L1 += l1; }
        }
        *(f32x4*)(agg + ((size_t)segidx * 1024 + 2 * cp) * 2) = (f32x4){L0, H0, L1, H1};
    }
}
__device__ __forceinline__ void lru_scanC_phase(const bf16_t* __restrict__ la, const bf16_t* __restrict__ uu, const float* __restrict__ agg, bf16_t* __restrict__ rec, const float* __restrict__ st_in, float* __restrict__ st_out, const int wv) {
    constexpr int NS = 8 * 32 * 512, NP = 16 * 2 * 512;
    for (int idx = bid_s() * 512 + (wv * 64 + lane_id_v()); idx < NS + NP; idx += gridDim.x * 512) {
        int cp, seg, b, row0, nseg, segb; const bool samp = idx < NS;
        if (samp) { cp = idx & 511; seg = (idx >> 9) & 31; b = idx >> 14; row0 = NPROMPT + b * 4096 + seg * 128; nseg = 32; segb = b * 64; }
        else { const int i2 = idx - NS; cp = i2 & 511; seg = (i2 >> 9) & 1; b = i2 >> 10; row0 = b * 256 + seg * 128; nseg = 2; segb = 512 + b * 4; }
        float h0 = 0.f, h1 = 0.f;
        if (samp) { const f32x2 v = *(const f32x2*)(st_in + (b * 2 + 0) * 1024 + 2 * cp); h0 = v.x; h1 = v.y; }
        for (int s2 = 0; s2 < seg; ++s2) { const f32x4 v = *(const f32x4*)(agg + ((size_t)(segb + s2) * 1024 + 2 * cp) * 2); h0 = __expf(v[0]) * h0 + v[1]; h1 = __expf(v[2]) * h1 + v[3]; }
        for (int s0 = 0; s0 < 128; s0 += 16) {
            unsigned lw[16], uw[16];
#pragma unroll
            for (int j = 0; j < 16; ++j) { const size_t o = ((size_t)(row0 + s0 + j) * 2 + 0) * 1024 + 2 * cp; lw[j] = *(const unsigned*)(la + o); uw[j] = *(const unsigned*)(uu + o); }
#pragma unroll
            for (int j = 0; j < 16; ++j) { h0 = __expf(bflo(lw[j])) * h0 + bflo(uw[j]); h1 = __expf(bfhi(lw[j])) * h1 + bfhi(uw[j]); *(unsigned*)(rec + (size_t)(row0 + s0 + j) * 1024 + 2 * cp) = cvt_pk_bf16(h0, h1); }
        }
        if (!samp && seg == nseg - 1) *(f32x2*)(st_out + (b * 2 + 0) * 1024 + 2 * cp) = (f32x2){h0, h1};
        h0 = 0.f; h1 = 0.f;
        if (samp) { const f32x2 v = *(const f32x2*)(st_in + (b * 2 + 1) * 1024 + 2 * cp); h0 = v.x; h1 = v.y; }
        for (int s2 = nseg - 1; s2 > seg; --s2) { const f32x4 v = *(const f32x4*)(agg + ((size_t)(segb + nseg + s2) * 1024 + 2 * cp) * 2); h0 = __expf(v[0]) * h0 + v[1]; h1 = __expf(v[2]) * h1 + v[3]; }
        for (int s0 = 0; s0 < 128; s0 += 16) {
            unsigned lw[16], uw[16], rw[16];
#pragma unroll
            for (int j = 0; j < 16; ++j) { const int r = row0 + 127 - (s0 + j); const size_t o = ((size_t)r * 2 + 1) * 1024 + 2 * cp; lw[j] = *(const unsigned*)(la + o); uw[j] = *(const unsigned*)(uu + o); rw[j] = *(const unsigned*)(rec + (size_t)r * 1024 + 2 * cp); }
#pragma unroll
            for (int j = 0; j < 16; ++j) { const int r = row0 + 127 - (s0 + j); h0 = __expf(bflo(lw[j])) * h0 + bflo(uw[j]); h1 = __expf(bfhi(lw[j])) * h1 + bfhi(uw[j]);
                *(unsigned*)(rec + (size_t)r * 1024 + 2 * cp) = cvt_pk_bf16(bflo(rw[j]) + h0, bfhi(rw[j]) + h1); }
        }
        if (!samp && seg == 0) *(f32x2*)(st_out + (b * 2 + 1) * 1024 + 2 * cp) = (f32x2){h0, h1};
    }
}

#ifndef REP_BAR
#define REP_BAR 1
#endif
#ifndef REP_ATT
#define REP_ATT 1
#endif
#ifndef REP_RET
#define REP_RET 1
#endif
#ifndef REP_LRU
#define REP_LRU 1
#endif
#ifndef REP_UP
#define REP_UP 1
#endif
#ifndef REP_NORM
#define REP_NORM 1
#endif
__device__ __forceinline__ int opq(int n) { asm volatile("" : "+s"(n)); return n; }
constexpr int LDS_BYTES = 147456;
constexpr size_t WS_BAR = 4096;
#define XB_TMO      128
#define XB_XCNT(j)  (256  + 64 * (j))
#define XB_XSUB(j)  (1280 + 64 * (j))
#define XB_XGEN(j)  (2304 + 64 * (j))
#define XB_TOP      3328
#define XB_TOPGEN   3392
#define XCD_BAR_WORDS 3456
#define XB_SPIN_CAP (1u << 22)
__device__ __forceinline__ unsigned xb_ld(unsigned* p)              { return __hip_atomic_load(p, __ATOMIC_RELAXED, __HIP_MEMORY_SCOPE_AGENT); }
__device__ __forceinline__ unsigned xb_add(unsigned* p, unsigned v) { return __hip_atomic_fetch_add(p, v, __ATOMIC_RELAXED, __HIP_MEMORY_SCOPE_AGENT); }
__device__ __forceinline__ unsigned xb_xcc_id() { return (unsigned)__builtin_amdgcn_s_getreg((3 << 11) | 20) & 0xFu; }
#define XB_SPIN(cond, bar) do { unsigned _sp = 0; while (cond) { __builtin_amdgcn_s_sleep(1); \
    if ((++_sp & 255u) == 0u) { if (xb_ld(&(bar)[XB_TMO])) break; if (_sp > XB_SPIN_CAP) { atomicAdd(&(bar)[XB_TMO], 1u); break; } } } } while (0)
__device__ __forceinline__ void xcd_barrier_complete(unsigned* bar, unsigned x, unsigned& nloc, unsigned& nx) {
    const unsigned G = gridDim.x;
    unsigned sum, cnt, mine, sp = 0u;
    for (;;) {
        sum = 0u; cnt = 0u; mine = 0u;
#pragma unroll
        for (unsigned j = 0; j < 16; ++j) { const unsigned c = xb_ld(&bar[XB_XCNT(j)]); sum += c; cnt += (c > 0u) ? 1u : 0u; mine = (j == x) ? c : mine; }
        if (sum == G) break;
        __builtin_amdgcn_s_sleep(1);
        if ((++sp & 255u) == 0u) { if (xb_ld(&bar[XB_TMO])) break; if (sp > XB_SPIN_CAP) { atomicAdd(&bar[XB_TMO], 1u); break; } }
    }
    nloc = mine > 0u ? mine : 1u; nx = cnt > 0u ? cnt : 1u;
}
__device__ __forceinline__ void gbar(unsigned* bar, volatile LAS unsigned* st, const int wv) {
    asm volatile("s_waitcnt vmcnt(0) lgkmcnt(0)" ::: "memory");
    __syncthreads();
    if (wv == 0) {
      if (lane_id_v() == 0) {
        const unsigned x = xb_xcc_id();
        unsigned nloc = st[0], nx = st[1];
        if (nloc == 0u) { xcd_barrier_complete(bar, x, nloc, nx); st[0] = nloc; st[1] = nx; }
        const unsigned old = xb_add(&bar[XB_XSUB(x)], 1u);
        const unsigned gen = old / nloc;
        if (old + 1u == (gen + 1u) * nloc) {
            __builtin_amdgcn_fence(__ATOMIC_RELEASE, "agent");
            asm volatile("s_waitcnt vmcnt(0)" ::: "memory");
            const unsigned og = xb_add(&bar[XB_TOP], 1u);
            const unsigned tg = og / nx;
            if (og + 1u == (tg + 1u) * nx) xb_add(&bar[XB_TOPGEN], 1u);
            else XB_SPIN(xb_ld(&bar[XB_TOPGEN]) == tg, bar);
            __builtin_amdgcn_fence(__ATOMIC_ACQUIRE, "agent");
            xb_add(&bar[XB_XGEN(x)], 1u);
            asm volatile("s_waitcnt vmcnt(0)" ::: "memory");
        } else {
            XB_SPIN(xb_ld(&bar[XB_XGEN(x)]) == gen, bar);
            __builtin_amdgcn_fence(__ATOMIC_ACQUIRE, "agent");
            asm volatile("s_waitcnt vmcnt(0)" ::: "memory");
        }
      }
    }
    __syncthreads();
}
__global__ void __launch_bounds__(512, 2) fwd_mega(KArgs a) {
    extern __shared__ __attribute__((aligned(16))) unsigned char lds_raw[];
    LAS unsigned char* lds = (LAS unsigned char*)lds_raw;
    cg::this_grid().sync();
    volatile LAS unsigned* bst = (volatile LAS unsigned*)(lds + 143360);
    if (wave_id_s() == 0 && lane_id_v() == 0) { bst[0] = 0u; bst[1] = 0u; const unsigned xc_ = xb_xcc_id();
        const unsigned slot_ = xb_add(&((unsigned*)(karg_ptr(264) + WS_BAR))[XB_XCNT(xc_)], 1u); bst[2] = blockIdx.x; bst[3] = (xc_ << 8) | slot_; }
    __syncthreads();
    const int wave = wave_id_s(), lane = 0, G = gridDim.x, gw = bid_s() * 8 + wave, NGW = G * 8;
#define ws karg_ptr(264)
#define XR ((float*)karg_ptr(256))
#define modt ((float*)(ws + WS_MOD))
#define hbuf ((bf16_t*)(ws + WS_H))
#define WUP ((bf16_t*)(ws + WS_WUP))
#define WDN ((bf16_t*)(ws + WS_WDN))
#define WIN ((bf16_t*)(ws + WS_WIN))
#define WOUT ((bf16_t*)(ws + WS_WOUT))
#define WX ((bf16_t*)(ws + WS_WX))
#define WX2 ((bf16_t*)(ws + WS_WX2))
    mod_phase(a, lds, wave); __syncthreads();
    cache_phase(a, wave);
    convert_layer_weights(a, ws, 0, lds, wave, lane, gw, NGW);
    if (bid_s() == 0 && wave == 0) { const int l_ = lane_id_v(); if (l_ < 32) ((const float**)ws)[l_] = a.in[l_]; }
    for (int rb_ = opq(REP_BAR); rb_ > 0; --rb_) gbar((unsigned*)(ws + WS_BAR), bst, wave);
    if (wave == 0 && lane_id_v() == 0) {
        unsigned* bar_ = (unsigned*)(ws + WS_BAR); bool ok_ = gridDim.x == 256;
        for (unsigned j = 0; j < 16; ++j) { const unsigned c_ = xb_ld(&bar_[XB_XCNT(j)]); ok_ = ok_ && (c_ == (j < 8 ? 32u : 0u)); }
        const unsigned v_ = bst[3]; if (ok_) bst[2] = (v_ & 255u) * 8u + (v_ >> 8);
    }
    __syncthreads();
#define tb (KTab{(const float* const*)ws})
    constexpr int KS = 1;
    for (int layer = 0; layer < 4; ++layer) {
        const int kind = layer % 3, slot = layer / 3;
#define modl (modt + (size_t)layer * 9 * 6144)
        pg8::StaticOrder S;
        if (layer == 0) norm_phase<true>(inp(tb, 0), inp(tb, 1), XR, inp(tb, 8), modl, 0, hbuf, lane, gw, NGW);
        else { norm_phase<false>(nullptr, nullptr, XR, inp(tb, 8) + layer * DM, modl, 0, hbuf, lane, gw, NGW, KS ? (const float*)(ws + WS_PART_M) : nullptr, modl - 9 * 6144 + 5 * 1024); __syncthreads(); convert_layer_weights(tb, ws, layer, lds, wave, lane, gw, NGW); }
        for (int rb_ = opq(REP_BAR); rb_ > 0; --rb_) gbar((unsigned*)(ws + WS_BAR), bst, wave);
        if (kind == 0) {
            bf16_t *q = (bf16_t*)(ws + WS_AQ), *k = (bf16_t*)(ws + WS_AK), *v = (bf16_t*)(ws + WS_AV), *o = (bf16_t*)(ws + WS_AO);
            { pg8::Gemm g{hbuf, WIN, MTOK, 1536, 1024, 1024, 1024, 31, 0}; S.init(MTOK, 1536, G, bid_s());
              pg8::EpiAttnQKV E{q, k, v, XR + OUT_K, XR + OUT_V, inp(tb, 16) + slot * 64, inp(tb, 17) + slot * 64, slot};
              pg8::gemm_phase(lds, g, S, E, wave); }
            for (int rb_ = opq(REP_BAR); rb_ > 0; --rb_) gbar((unsigned*)(ws + WS_BAR), bst, wave);
            for (int rp_ = opq(REP_ATT); rp_ > 0; --rp_) attn_phase(lds, q, k, v, (const bf16_t*)(ws + WS_CK) + (size_t)slot * 512 * 256, (const bf16_t*)(ws + WS_CV) + (size_t)slot * 512 * 256, o, inp(tb, 18) + slot * 16, wave);
            for (int rb_ = opq(REP_BAR); rb_ > 0; --rb_) gbar((unsigned*)(ws + WS_BAR), bst, wave);
            { pg8::Gemm g{o, WOUT, MTOK, 1024, 1024, 1024, 1024, 31, 0}; S.init(MTOK, 1024, G, bid_s(), KS); pg8::EpiResid E{XR, modl + 2 * 1024, (float*)(ws + WS_PART_A)}; pg8::gemm_phase(lds, g, S, E, wave); }
            for (int rb_ = opq(REP_BAR); rb_ > 0; --rb_) gbar((unsigned*)(ws + WS_BAR), bst, wave);
        } else if (kind == 1) {
            bf16_t *q = (bf16_t*)(ws + WS_RQ), *k = (bf16_t*)(ws + WS_RK), *v = (bf16_t*)(ws + WS_RV), *o = (bf16_t*)(ws + WS_RO);
            float* statp = (float*)(ws + WS_RSTP); float* fin = (float*)(ws + WS_RFIN);
            { pg8::Gemm g{hbuf, WIN, MTOK, 4096, 1024, 1024, 1024, 31, 0}; S.init(MTOK, 4096, G, bid_s()); pg8::EpiRetQKV E{q, k, v}; pg8::gemm_phase(lds, g, S, E, wave); }
            for (int rb_ = opq(REP_BAR); rb_ > 0; --rb_) gbar((unsigned*)(ws + WS_BAR), bst, wave);
            for (int rp_ = opq(REP_RET); rp_ > 0; --rp_) ret_scan_phase(lds, q, k, v, o, statp, inp(tb, 22) + slot * 8, inp(tb, 4), XR + OUT_RET, wave);
            for (int rb_ = opq(REP_BAR); rb_ > 0; --rb_) gbar((unsigned*)(ws + WS_BAR), bst, wave);
            bf16_t* h2 = (bf16_t*)(ws + WS_RQ);
            norm_phase<false>(nullptr, nullptr, XR, inp(tb, 8) + layer * DM, modl, 0, h2, lane, gw, NGW);
            ret_fin_phase(statp, fin, wave);
            for (int rb_ = opq(REP_BAR); rb_ > 0; --rb_) gbar((unsigned*)(ws + WS_BAR), bst, wave);
            { pg8::Gemm g{h2, WX, MTOK, 2048, 1024, 1024, 1024, 31, 0}; S.init(MTOK, 2048, G, bid_s()); pg8::EpiLateGate<0> E{o, 2048, fin, inp(tb, 21) + slot * 2048}; pg8::gemm_phase(lds, g, S, E, wave); }
            for (int rb_ = opq(REP_BAR); rb_ > 0; --rb_) gbar((unsigned*)(ws + WS_BAR), bst, wave);
            { pg8::Gemm g{o, WOUT, MTOK, 1024, 2048, 2048, 2048, 31, 0}; S.init(MTOK, 1024, G, bid_s(), KS); pg8::EpiResid E{XR, modl + 2 * 1024, (float*)(ws + WS_PART_R)}; pg8::gemm_phase(lds, g, S, E, wave); }
            for (int rb_ = opq(REP_BAR); rb_ > 0; --rb_) gbar((unsigned*)(ws + WS_BAR), bst, wave);
        } else {
            bf16_t *xr = (bf16_t*)(ws + WS_LXR), *xc = (bf16_t*)(ws + WS_LXC), *la = (bf16_t*)(ws + WS_LLA), *uu = (bf16_t*)(ws + WS_LU), *rec = (bf16_t*)(ws + WS_LREC);
            float* agg = (float*)(ws + WS_LAGG);
            { pg8::Gemm g{hbuf, WIN, MTOK, 1024, 1024, 1024, 1024, 31, 0}; S.init(MTOK, 1024, G, bid_s()); pg8::EpiStore<0> E{xr, 1024}; pg8::gemm_phase(lds, g, S, E, wave); }
            for (int rb_ = opq(REP_BAR); rb_ > 0; --rb_) gbar((unsigned*)(ws + WS_BAR), bst, wave);
            for (int rp_ = opq(REP_LRU); rp_ > 0; --rp_) lru_conv_phase(xr, xc, inp(tb, 24) + slot * 4096, inp(tb, 25) + slot * 1024, wave);
            for (int rb_ = opq(REP_BAR); rb_ > 0; --rb_) gbar((unsigned*)(ws + WS_BAR), bst, wave);
            { pg8::Gemm g{xc, WX2, MTOK, 4096, 128, 1024, 128, 1, 256}; S.init(MTOK, 4096, G, bid_s());
              pg8::EpiLruGates E{xc, la, uu, inp(tb, 27) + slot * 2048, inp(tb, 29) + slot * 2048, inp(tb, 30) + slot * 2048}; pg8::gemm_phase(lds, g, S, E, wave); }
            for (int rb_ = opq(REP_BAR); rb_ > 0; --rb_) gbar((unsigned*)(ws + WS_BAR), bst, wave);
            for (int rp_ = opq(REP_LRU); rp_ > 0; --rp_) lru_scanA_phase(la, uu, agg, wave);
            for (int rb_ = opq(REP_BAR); rb_ > 0; --rb_) gbar((unsigned*)(ws + WS_BAR), bst, wave);
            for (int rp_ = opq(REP_LRU); rp_ > 0; --rp_) lru_scanC_phase(la, uu, agg, rec, inp(tb, 5) + slot * 2048, XR + OUT_LRU, wave);
            for (int rb_ = opq(REP_BAR); rb_ > 0; --rb_) gbar((unsigned*)(ws + WS_BAR), bst, wave);
            { pg8::Gemm g{hbuf, WX, MTOK, 1024, 1024, 1024, 1024, 31, 0}; S.init(MTOK, 1024, G, bid_s()); pg8::EpiLateGate<1> E{rec, 1024, nullptr, nullptr}; pg8::gemm_phase(lds, g, S, E, wave); }
            for (int rb_ = opq(REP_BAR); rb_ > 0; --rb_) gbar((unsigned*)(ws + WS_BAR), bst, wave);
            { pg8::Gemm g{rec, WOUT, MTOK, 1024, 1024, 1024, 1024, 31, 0}; S.init(MTOK, 1024, G, bid_s(), KS); pg8::EpiResid E{XR, modl + 2 * 1024, (float*)(ws + WS_PART_L)}; pg8::gemm_phase(lds, g, S, E, wave); }
            for (int rb_ = opq(REP_BAR); rb_ > 0; --rb_) gbar((unsigned*)(ws + WS_BAR), bst, wave);
        }
        norm_phase<false>(nullptr, nullptr, XR, inp(tb, 9) + layer * DM, modl, 3, hbuf, lane, gw, NGW, KS ? (const float*)(ws + (kind == 0 ? WS_PART_A : kind == 1 ? WS_PART_R : WS_PART_L)) : nullptr, modl + 2 * 1024);
        for (int rb_ = opq(REP_BAR); rb_ > 0; --rb_) gbar((unsigned*)(ws + WS_BAR), bst, wave);
        bf16_t* hid = (bf16_t*)(ws + WS_HID);
        for (int rp_ = opq(REP_UP); rp_ > 0; --rp_) { pg8::Gemm g{hbuf, WUP, MTOK, 4096, 1024, 1024, 1024, 31, 0}; S.init(MTOK, 4096, G, bid_s()); pg8::EpiStore<2> E{hid, 4096}; pg8::gemm_phase(lds, g, S, E, wave); }
        for (int rb_ = opq(REP_BAR); rb_ > 0; --rb_) gbar((unsigned*)(ws + WS_BAR), bst, wave);
        { pg8::Gemm g{hid, WDN, MTOK, 1024, 4096, 4096, 4096, 31, 0}; S.init(MTOK, 1024, G, bid_s(), KS); pg8::EpiResid E{XR, modl + 5 * 1024, (float*)(ws + WS_PART_M)}; pg8::gemm_phase(lds, g, S, E, wave); }
        for (int rb_ = opq(REP_BAR); rb_ > 0; --rb_) gbar((unsigned*)(ws + WS_BAR), bst, wave);
    }
    {
        const int layer = 3; const float* gate = modl + 5 * 1024; const float* part = (const float*)(ws + WS_PART_M); float* xo = XR;
        const int l_ = lane_id_v();
        for (int r = gw; r < MTOK; r += NGW) { const bf16_t* xb = (const bf16_t*)xo + (size_t)r * 2048; f32x4 v[4];
#pragma unroll
            for (int j = 0; j < 4; ++j) { const u32x2 w = *(const u32x2*)(xb + 4 * l_ + 256 * j); v[j] = (f32x4){bflo(w.x), bfhi(w.x), bflo(w.y), bfhi(w.y)}; }
            if (KS && r >= 32768) { const float* gp = gate + (size_t)modidx(r) * 6144;
#pragma unroll
                for (int j = 0; j < 4; ++j) { const int c = 4 * l_ + 256 * j; const bf16_t* pp = (const bf16_t*)part + (size_t)(r - 32768) * DM + c;
                    const f32x4 ps = ((ld4bf(pp) + ld4bf(pp + (size_t)4096 * DM)) + ld4bf(pp + (size_t)2 * 4096 * DM)) + ld4bf(pp + (size_t)3 * 4096 * DM);
                    v[j] = v[j] + *(const f32x4*)(gp + c) * ps; } }
            asm volatile("s_waitcnt vmcnt(0)" ::: "memory");
#pragma unroll
            for (int j = 0; j < 4; ++j) *(f32x4*)(xo + (size_t)r * DM + 4 * l_ + 256 * j) = v[j];
        }
    }
}

#undef ws
#undef XR
#undef modt
#undef hbuf
#undef WUP
#undef WDN
#undef WIN
#undef WOUT
#undef WX
#undef WX2
#undef modl
#undef tb
extern "C" void kernel_launch(void* const* d_in, const int* in_sizes, int n_in, void* d_out, int out_size, void* d_ws, size_t ws_size, hipStream_t stream) {
    static int grid = 0;
    if (grid == 0) {
        int dev = 0, cus = 0, per_cu = 0;
        hipGetDevice(&dev); hipDeviceGetAttribute(&cus, hipDeviceAttributeMultiprocessorCount, dev);
        if (hipFuncSetAttribute((const void*)fwd_mega, hipFuncAttributeMaxDynamicSharedMemorySize, LDS_BYTES) != hipSuccess) { fprintf(stderr, "hipFuncSetAttribute failed\n"); grid = -1; return; }
        if (hipOccupancyMaxActiveBlocksPerMultiprocessor(&per_cu, (const void*)fwd_mega, 512, LDS_BYTES) != hipSuccess || per_cu < 1) { fprintf(stderr, "occupancy query: %d\n", per_cu); per_cu = 1; }
        (void)hipGetLastError();
        grid = cus * per_cu;
        if (grid != 256) { fprintf(stderr, "kernel_launch: this build needs exactly 256 resident workgroups (got %d)\n", grid); grid = -1; return; }
        if (n_in != 32 || ws_size < 512 * MiB) { fprintf(stderr, "kernel_launch: unexpected n_in %d / ws %zu\n", n_in, ws_size); grid = -1; return; }
    }
    if (grid < 0) return;
    KArgs a{};
    for (int i = 0; i < 32; ++i) a.in[i] = (const float*)d_in[i];
    a.out = (float*)d_out; a.ws = (unsigned char*)d_ws;
    if (hipMemsetAsync((char*)d_ws + WS_BAR, 0, 16384, stream) != hipSuccess) { fprintf(stderr, "memset failed\n"); return; }
    void* args[] = {&a};
    hipError_t e = hipLaunchCooperativeKernel((const void*)fwd_mega, dim3(grid), dim3(512), args, LDS_BYTES, stream);
    if (e != hipSuccess) fprintf(stderr, "cooperative launch failed: %s (grid %d)\n", hipGetErrorString(e), grid);
}
```

```cpp
#include <hip/hip_runtime.h>
#include <hip/hip_cooperative_groups.h>
#include <cstdio>
#include <cstdint>
namespace cg = cooperative_groups;

#define LAS __attribute__((address_space(3)))
typedef unsigned short bf16_t;
typedef short bf16x8 __attribute__((ext_vector_type(8)));
typedef short s16x4 __attribute__((ext_vector_type(4)));
typedef float f32x4 __attribute__((ext_vector_type(4)));
typedef float f32x2 __attribute__((ext_vector_type(2)));
typedef float f32x16 __attribute__((ext_vector_type(16)));
typedef unsigned u32x4 __attribute__((ext_vector_type(4)));
typedef unsigned u32x2 __attribute__((ext_vector_type(2)));

#define LOG2E 1.4426950408889634f
constexpr int DM = 1024, NPROMPT = 4096, MTOK = 36864, DFF = 4096;
constexpr size_t MiB = 1u << 20;
constexpr size_t WS_MOD = 1 * MiB;
constexpr size_t WS_WUP = 2 * MiB, WS_WDN = 10 * MiB, WS_WIN = 18 * MiB, WS_WOUT = 26 * MiB, WS_WX = 30 * MiB, WS_WX2 = 32 * MiB;
constexpr size_t WS_CK = 34 * MiB, WS_CV = 38 * MiB;
constexpr size_t WS_A = 44 * MiB;
constexpr size_t WS_H = 440 * MiB;
constexpr size_t WS_AQ = 44 * MiB, WS_AK = 116 * MiB, WS_AV = 134 * MiB, WS_AO = 152 * MiB;
constexpr size_t WS_RQ = 44 * MiB, WS_RK = 116 * MiB, WS_RV = 188 * MiB, WS_RO = 332 * MiB, WS_RSTP = 476 * MiB, WS_RFIN = 494 * MiB;
constexpr size_t WS_LXR = 368 * MiB, WS_LXC = 44 * MiB, WS_LLA = 116 * MiB, WS_LU = 260 * MiB, WS_LAGG = 404 * MiB, WS_LREC = 44 * MiB;
constexpr size_t WS_HID = 44 * MiB;
constexpr size_t WS_PART_A = 224 * MiB, WS_PART_R = 44 * MiB, WS_PART_L = 116 * MiB, WS_PART_M = 332 * MiB;
constexpr size_t OUT_K = 37748736, OUT_V = 39845888, OUT_RET = 41943040, OUT_LRU = 58720256;

__device__ __forceinline__ unsigned cvt_pk_bf16(float lo, float hi) { unsigned r; asm volatile("v_cvt_pk_bf16_f32 %0, %1, %2" : "=v"(r) : "v"(lo), "v"(hi)); return r; }
__device__ __forceinline__ float bf2f(unsigned short b) { return __uint_as_float((unsigned)b << 16); }
__device__ __forceinline__ float bflo(unsigned w) { return __uint_as_float(w << 16); }
__device__ __forceinline__ float bfhi(unsigned w) { return __uint_as_float(w & 0xffff0000u); }
__device__ __forceinline__ f32x4 ld4bf(const bf16_t* p) { const u32x2 w = *(const u32x2*)p; return (f32x4){bflo(w.x), bfhi(w.x), bflo(w.y), bfhi(w.y)}; }
__device__ __forceinline__ float fsigmoid(float x) { return __builtin_amdgcn_rcpf(1.f + __expf(-x)); }
__device__ __forceinline__ float fsilu(float x) { return x * fsigmoid(x); }
__device__ __forceinline__ float fgelu_tanh(float x) { const float u = 0.7978845608028654f * (x + 0.044715f * x * x * x); return x * fsigmoid(2.f * u); }
__device__ __forceinline__ int launder(int v) { asm volatile("" : "+v"(v)); return v; }
__device__ __forceinline__ int lane_id_v() { int l; asm volatile("v_mbcnt_lo_u32_b32 %0, -1, 0\n\tv_mbcnt_hi_u32_b32 %0, -1, %0" : "=v"(l)); return l; }
__device__ __forceinline__ int bid_s() { const int b = *(volatile LAS int*)(uintptr_t)143368u; return __builtin_amdgcn_readfirstlane(b); }
__device__ __forceinline__ int wave_id_s() { return __builtin_amdgcn_readfirstlane(__builtin_amdgcn_workitem_id_x() >> 6); }
__device__ __forceinline__ unsigned char* karg_ptr(int off) {
#if defined(__HIP_DEVICE_COMPILE__)
    unsigned long long v; auto ka = __builtin_amdgcn_kernarg_segment_ptr();
    if (off == 256) asm volatile("s_load_dwordx2 %0, %1, 0x100\n\ts_waitcnt lgkmcnt(0)" : "=s"(v) : "s"(ka));
    else asm volatile("s_load_dwordx2 %0, %1, 0x108\n\ts_waitcnt lgkmcnt(0)" : "=s"(v) : "s"(ka));
    return (unsigned char*)v;
#else
    (void)off; return nullptr;
#endif
}
__device__ __forceinline__ int modidx(int r) { return r < NPROMPT ? 0 : 1 + ((r - NPROMPT) >> 12); }
__device__ __forceinline__ void rope_cs(float pos, float inv, float& c, float& s) {
    float rev = pos * inv * 0.15915494309189535f; rev -= rintf(rev);
    s = __builtin_amdgcn_sinf(rev); c = __builtin_amdgcn_cosf(rev);
}

namespace pg8 {
constexpr int BM = 256, BK = 64, HALF = 128, HTB = HALF * BK * 2, STAGE_BYTES = 8 * HTB, NXCD = 8, WGM = 8;
__host__ __device__ __forceinline__ int lds_byte(int r, int c) { const int st = (r >> 4) * 2 + (c >> 5), rr = r & 15, cc = c & 31, ob = rr * 64 + cc * 2; return st * 1024 + (ob ^ (((ob >> 9) & 1) << 5)); }
__host__ __device__ __forceinline__ void stage_rc(int b, int& R, int& C) { const int st = b / 1024, sb = b % 1024, swz = sb ^ (((sb >> 9) & 1) << 5); R = (st >> 1) * 16 + swz / 64; C = (st & 1) * 32 + (swz % 64) / 2; }
__host__ __device__ __forceinline__ int perm32(int rho) { const int n = rho >> 4, i = rho & 15; return 8 * (i >> 2) + 4 * n + (i & 3); }
struct Unit { int pm, pn, kq; };
struct Gemm { const bf16_t* A; const bf16_t* Bt; int M, N, K, lda, ldb, ash, astep; };
struct StaticOrder {
    int nM, nN, nwg, G, c, ks;
    __device__ void init(int M, int N, int G_, int c_, int ks_ = 0) { nM = M / BM; nN = N / BM; nwg = nM * nN; G = G_; c = c_; ks = ks_; }
    __device__ bool next(int i, Unit& u) const {
        if (ks) { if (i < 2) { const int j = i * 32 + (c >> 3), xx = c & 7; u.pm = 16 * xx + (j >> 2); u.pn = j & 3; u.kq = -1; return true; }
                  if (i == 2) { const int t = c >> 2; u.pm = 128 + (t >> 2); u.pn = t & 3; u.kq = c & 3; return true; } return false; }
        u.kq = -1;
        const int L = i * G + c; if (L >= nwg) return false;
        int wgid = L; { const int q = nwg / NXCD, r = nwg % NXCD, xcd = wgid % NXCD, off = wgid / NXCD; wgid = (xcd < r ? xcd * (q + 1) : r * (q + 1) + (xcd - r) * q) + off; }
        const int nig = WGM * nN, gid = wgid / nig, fm = gid * WGM, gsz = (nM - fm) < WGM ? (nM - fm) : WGM;
        u.pm = fm + ((wgid % nig) % gsz); u.pn = (wgid % nig) / gsz; return true;
    }
};

template <class Epi>
__device__ __forceinline__ void gemm_phase(LAS unsigned char* lds, const Gemm g, const StaticOrder& S, const Epi& E, const int wv) {
    const int wid = wv, lane = lane_id_v(), tid = wid * 64 + lane, wr = wid >> 2, wc = wid & 3, fr = lane & 15, fq = lane >> 4;
    int K_ = g.K; asm volatile("" : "+s"(K_));
    const int K = K_, nt = K / BK;
    unsigned voffA[2], voffB[2];
#pragma unroll
    for (int i = 0; i < 2; ++i) { int R, C; stage_rc(tid * 16 + i * 8192, R, C); const int Rb = Epi::PERM ? ((R & ~31) + perm32(R & 31)) : R;
        voffA[i] = (unsigned)(R * g.lda + C) * 2u; voffB[i] = (unsigned)(Rb * g.ldb + C) * 2u; }
    const unsigned kstep = (unsigned)(BK * 2);
    const unsigned hA = (unsigned)HALF * g.lda * 2u, hB = (unsigned)HALF * g.ldb * 2u, tA = 2u * hA, tB = 2u * hB;
    const unsigned ldsw = (unsigned)wid * 1024u;
    const int aoff = lds_byte(wr * 64 + fr, fq * 8), boff = lds_byte(wc * 32 + fr, fq * 8);
#define PG8_SA(b, h) (((b) * 2 + (h)) * HTB)
#define PG8_SB(b, h) ((4 + (b) * 2 + (h)) * HTB)
#define PG8_STAGE(bufoff, gbase, voff) do { _Pragma("unroll") for (int _i = 0; _i < 2; ++_i) \
        __builtin_amdgcn_global_load_lds((const unsigned*)((const char*)(gbase) + (voff)[_i]), (LAS unsigned*)(lds + (bufoff) + ldsw + _i * 8192), 16, 0, 0); } while (0)
#define PG8_LDA(dst, b, h) do { _Pragma("unroll") for (int m = 0; m < 4; ++m) _Pragma("unroll") for (int k = 0; k < 2; ++k) dst[m][k] = *(const LAS bf16x8*)(lds + PG8_SA(b, h) + aoff + m * 2048 + k * 1024); } while (0)
#define PG8_LDB(dst, b, h) do { _Pragma("unroll") for (int n = 0; n < 2; ++n) _Pragma("unroll") for (int k = 0; k < 2; ++k) dst[n][k] = *(const LAS bf16x8*)(lds + PG8_SB(b, h) + boff + n * 2048 + k * 1024); } while (0)
#define PG8_MMA(ai, bj, At, Bt) do { __builtin_amdgcn_s_setprio(1); _Pragma("unroll") for (int m = 0; m < 4; ++m) _Pragma("unroll") for (int n = 0; n < 2; ++n) _Pragma("unroll") for (int k = 0; k < 2; ++k) \
        acc[ai][bj][m][n] = __builtin_amdgcn_mfma_f32_16x16x32_bf16(Bt[n][k], At[m][k], acc[ai][bj][m][n], 0, 0, 0); __builtin_amdgcn_s_setprio(0); } while (0)
#define PG8_WAIT_V(n) asm volatile("s_waitcnt vmcnt(" #n ")" ::: "memory")
#define PG8_WAIT_L(n) asm volatile("s_waitcnt lgkmcnt(" #n ")" ::: "memory")
#define PG8_BAR __builtin_amdgcn_s_barrier()
#define PG8_SCHED __builtin_amdgcn_sched_barrier(0)
    Unit cur, nxt; int ui = 0;
    if (!S.next(0, cur)) return;
    f32x4 acc[2][2][4][2];
#pragma unroll
    for (int a = 0; a < 2; ++a)
#pragma unroll
        for (int b = 0; b < 2; ++b)
#pragma unroll
            for (int m = 0; m < 4; ++m)
#pragma unroll
                for (int n = 0; n < 2; ++n) acc[a][b][m][n] = (f32x4){0.f, 0.f, 0.f, 0.f};
    bf16x8 At[4][2], B0[2][2], B1[2][2];
    const int ntq = nt >> 2;
    int cnt = cur.kq >= 0 ? ntq : nt;
    const unsigned cko = cur.kq >= 0 ? (unsigned)(cur.kq * ntq) * kstep : 0u;
    const char* cA = (const char*)g.A + ((unsigned)cur.pm * tA + (unsigned)(cur.pn >> g.ash) * (unsigned)g.astep + cko);
    const char* cB = (const char*)g.Bt + ((unsigned)cur.pn * tB + cko);
    PG8_STAGE(PG8_SB(0, 0), cB, voffB); PG8_STAGE(PG8_SB(0, 1), cB + hB, voffB); PG8_STAGE(PG8_SA(0, 0), cA, voffA); PG8_STAGE(PG8_SA(0, 1), cA + hA, voffA);
    if (wr == 1) PG8_BAR;
    PG8_WAIT_V(2); PG8_BAR;
    PG8_STAGE(PG8_SB(1, 0), cB + kstep, voffB); PG8_STAGE(PG8_SA(1, 0), cA + kstep, voffA); PG8_STAGE(PG8_SB(1, 1), cB + hB + kstep, voffB);
    PG8_WAIT_V(6); PG8_BAR;
    for (;;) {
        const bool has_next = S.next(ui + 1, nxt);
        const unsigned nko = (has_next && nxt.kq >= 0) ? (unsigned)(nxt.kq * ntq) * kstep : 0u;
        const char* nA = has_next ? (const char*)g.A + ((unsigned)nxt.pm * tA + (unsigned)(nxt.pn >> g.ash) * (unsigned)g.astep + nko) : cA; const char* nB = has_next ? (const char*)g.Bt + ((unsigned)nxt.pn * tB + nko) : cB;
        for (int t = 0; t < cnt; t += 2) {
            const bool last = (t == cnt - 2);
            const char* a1 = cA + (unsigned)(t + 1) * kstep;
            const char* a2 = last ? nA : cA + (unsigned)(t + 2) * kstep; const char* b2 = last ? nB : cB + (unsigned)(t + 2) * kstep;
            const char* a3 = a2 + kstep; const char* b3 = b2 + kstep;
            PG8_LDB(B0, 0, 0); PG8_LDB(B1, 0, 1); PG8_SCHED; PG8_LDA(At, 0, 0); PG8_STAGE(PG8_SA(1, 1), a1 + hA, voffA);
            PG8_WAIT_V(8); PG8_WAIT_L(0); PG8_BAR; PG8_MMA(0, 0, At, B0); PG8_MMA(0, 1, At, B1); PG8_BAR; PG8_SCHED;
            PG8_LDA(At, 0, 1); PG8_STAGE(PG8_SB(0, 0), b2, voffB); PG8_STAGE(PG8_SB(0, 1), b2 + hB, voffB); PG8_STAGE(PG8_SA(0, 0), a2, voffA);
            PG8_WAIT_V(8); PG8_WAIT_L(0); PG8_BAR; PG8_MMA(1, 0, At, B0); PG8_MMA(1, 1, At, B1); PG8_BAR; PG8_SCHED;
            PG8_LDB(B0, 1, 0); PG8_LDB(B1, 1, 1); PG8_SCHED; PG8_LDA(At, 1, 0); PG8_STAGE(PG8_SA(0, 1), a2 + hA, voffA);
            PG8_WAIT_V(8); PG8_WAIT_L(0); PG8_BAR; PG8_MMA(0, 0, At, B0); PG8_MMA(0, 1, At, B1); PG8_BAR; PG8_SCHED;
            PG8_LDA(At, 1, 1); PG8_STAGE(PG8_SB(1, 0), b3, voffB); PG8_STAGE(PG8_SB(1, 1), b3 + hB, voffB); PG8_STAGE(PG8_SA(1, 0), a3, voffA);
            PG8_WAIT_V(8); PG8_WAIT_L(0); PG8_BAR; PG8_MMA(1, 0, At, B0); PG8_MMA(1, 1, At, B1); PG8_BAR; PG8_SCHED;
        }
        if (wr == 0) PG8_BAR;
        E(acc, cur, wr, wc, fr, fq);
        if (!has_next) break;
#pragma unroll
        for (int a = 0; a < 2; ++a)
#pragma unroll
            for (int b = 0; b < 2; ++b)
#pragma unroll
                for (int m = 0; m < 4; ++m)
#pragma unroll
                    for (int n = 0; n < 2; ++n) acc[a][b][m][n] = (f32x4){0.f, 0.f, 0.f, 0.f};
        cur = nxt; cA = nA; cB = nB; ++ui; cnt = cur.kq >= 0 ? ntq : nt;
        if (wr == 1) PG8_BAR;
    }
    PG8_WAIT_V(0);
    PG8_BAR;
#undef PG8_SA
#undef PG8_SB
#undef PG8_STAGE
#undef PG8_LDA
#undef PG8_LDB
#undef PG8_MMA
#undef PG8_WAIT_V
#undef PG8_WAIT_L
#undef PG8_BAR
#undef PG8_SCHED
}

template <int ACT> struct EpiStore {
    static constexpr bool PERM = true;
    bf16_t* O; int ldc;
    __device__ __forceinline__ void operator()(const f32x4 (&acc)[2][2][4][2], const Unit& u, int wr, int wc, int fr, int fq) const {
        fr = launder(fr); fq = launder(fq);
        const int row0 = u.pm * BM + wr * 64 + fr, col0 = u.pn * BM + wc * 32 + 8 * fq;
#pragma unroll
        for (int ai = 0; ai < 2; ++ai)
#pragma unroll
            for (int m = 0; m < 4; ++m) { bf16_t* rowp = O + (size_t)(row0 + ai * HALF + m * 16) * ldc + col0;
#pragma unroll
                for (int bj = 0; bj < 2; ++bj) { f32x4 v0 = acc[ai][bj][m][0], v1 = acc[ai][bj][m][1];
                    if (ACT == 2) {
#pragma unroll
                        for (int e = 0; e < 4; ++e) { const float a = fmaxf(v0[e], 0.f), b = fmaxf(v1[e], 0.f); v0[e] = a * a; v1[e] = b * b; } }
                    u32x4 w; w.x = cvt_pk_bf16(v0[0], v0[1]); w.y = cvt_pk_bf16(v0[2], v0[3]); w.z = cvt_pk_bf16(v1[0], v1[1]); w.w = cvt_pk_bf16(v1[2], v1[3]);
                    *(u32x4*)(rowp + bj * HALF) = w; } asm volatile("" ::: "memory"); }
    }
};
struct EpiResid {
    static constexpr bool PERM = true;
    float* x; const float* gate; float* part;
    __device__ __forceinline__ void operator()(const f32x4 (&acc)[2][2][4][2], const Unit& u, int wr, int wc, int fr, int fq) const {
        fr = launder(fr); fq = launder(fq);
        const int row0 = u.pm * BM + wr * 64 + fr, col0 = u.pn * BM + wc * 32 + 8 * fq;
        if (u.kq >= 0) {
#pragma unroll
            for (int ai = 0; ai < 2; ++ai)
#pragma unroll
                for (int m = 0; m < 4; ++m) { bf16_t* rowp = (bf16_t*)part + ((size_t)u.kq * 4096 + (row0 + ai * HALF + m * 16 - 32768)) * DM + col0;
#pragma unroll
                    for (int bj = 0; bj < 2; ++bj) { const f32x4 a0 = acc[ai][bj][m][0], a1 = acc[ai][bj][m][1];
                        u32x4 o; o.x = cvt_pk_bf16(a0[0], a0[1]); o.y = cvt_pk_bf16(a0[2], a0[3]); o.z = cvt_pk_bf16(a1[0], a1[1]); o.w = cvt_pk_bf16(a1[2], a1[3]); *(u32x4*)(rowp + bj * HALF) = o; } }
            return;
        }
        const float* gp = gate + (size_t)modidx(u.pm * BM) * 6144 + col0;
        f32x4 gv[2][2];
#pragma unroll
        for (int bj = 0; bj < 2; ++bj)
#pragma unroll
            for (int n = 0; n < 2; ++n) gv[bj][n] = *(const f32x4*)(gp + bj * HALF + 4 * n);
#pragma unroll
        for (int ai = 0; ai < 2; ++ai) {
            u32x4 xw[4][2];
#pragma unroll
            for (int m = 0; m < 4; ++m)
#pragma unroll
                for (int bj = 0; bj < 2; ++bj) xw[m][bj] = *(const u32x4*)((const bf16_t*)x + (size_t)(row0 + ai * HALF + m * 16) * 2048 + col0 + bj * HALF);
#pragma unroll
            for (int m = 0; m < 4; ++m)
#pragma unroll
                for (int bj = 0; bj < 2; ++bj) { const u32x4 w = xw[m][bj];
                    const f32x4 xa = (f32x4){bflo(w.x), bfhi(w.x), bflo(w.y), bfhi(w.y)} + gv[bj][0] * acc[ai][bj][m][0], xb = (f32x4){bflo(w.z), bfhi(w.z), bflo(w.w), bfhi(w.w)} + gv[bj][1] * acc[ai][bj][m][1];
                    u32x4 o; o.x = cvt_pk_bf16(xa[0], xa[1]); o.y = cvt_pk_bf16(xa[2], xa[3]); o.z = cvt_pk_bf16(xb[0], xb[1]); o.w = cvt_pk_bf16(xb[2], xb[3]);
                    *(u32x4*)((bf16_t*)x + (size_t)(row0 + ai * HALF + m * 16) * 2048 + col0 + bj * HALF) = o; }
            asm volatile("" ::: "memory"); }
    }
};
__device__ __forceinline__ void st4(bf16_t* p, const f32x4 v) { u32x2 w; w.x = cvt_pk_bf16(v[0], v[1]); w.y = cvt_pk_bf16(v[2], v[3]); *(u32x2*)p = w; }
struct EpiAttnQKV {
    static constexpr bool PERM = false;
    bf16_t *q, *k, *v; float *nk, *nv; const float *qg, *kg; int slot;
    __device__ __forceinline__ void operator()(const f32x4 (&acc)[2][2][4][2], const Unit& u, int wr, int wc, int fr, int fq) const {
        fr = launder(fr); fq = launder(fq);
        const int pn = u.pn;
#pragma unroll
        for (int ai = 0; ai < 2; ++ai)
#pragma unroll
            for (int m = 0; m < 4; ++m) {
                const int r = u.pm * BM + ai * HALF + wr * 64 + m * 16 + fr;
                f32x4 v00 = acc[ai][0][m][0], v01 = acc[ai][0][m][1], v10 = acc[ai][1][m][0], v11 = acc[ai][1][m][1];
                if (pn < 5) {
                    float ss = 0.f;
#pragma unroll
                    for (int e = 0; e < 4; ++e) ss += v00[e] * v00[e] + v01[e] * v01[e] + v10[e] * v10[e] + v11[e] * v11[e];
                    ss += __shfl_xor(ss, 16); ss += __shfl_xor(ss, 32);
                    const float rs = rsqrtf(ss * (1.f / 64.f) + 1e-6f);
                    const float* gn = (pn < 4 ? qg : kg) + 4 * fq;
                    v00 = v00 * rs * *(const f32x4*)(gn); v01 = v01 * rs * *(const f32x4*)(gn + 16); v10 = v10 * rs * *(const f32x4*)(gn + 32); v11 = v11 * rs * *(const f32x4*)(gn + 48);
                    if (r >= NPROMPT) {
                        const int t = (r - NPROMPT) & 4095; const float rp = (float)(t >> 6), cp = (float)(t & 63);
#pragma unroll
                        for (int e = 0; e < 4; ++e) {
                            const float inv = __builtin_amdgcn_exp2f(-(float)(4 * fq + e) * (13.287712379549449f / 16.f)); float c, s;
                            rope_cs(rp, inv, c, s); { const float x1 = v00[e], x2 = v01[e]; v00[e] = x1 * c - x2 * s; v01[e] = x2 * c + x1 * s; }
                            rope_cs(cp, inv, c, s); { const float x1 = v10[e], x2 = v11[e]; v10[e] = x1 * c - x2 * s; v11[e] = x2 * c + x1 * s; }
                        }
                    }
                }
                if (pn < 4) {
                    bf16_t* d = q + (size_t)r * 1024 + (4 * pn + wc) * 64 + 4 * fq;
                    constexpr float QS = 0.125f * LOG2E; st4(d, v00 * QS); st4(d + 16, v01 * QS); st4(d + 32, v10 * QS); st4(d + 48, v11 * QS);
                } else {
                    bf16_t* d = (pn == 4 ? k : v) + (size_t)r * 256 + wc * 64 + 4 * fq;
                    st4(d, v00); st4(d + 16, v01); st4(d + 32, v10); st4(d + 48, v11);
                    if (r < NPROMPT) { const int b = r >> 8, t = r & 255; float* o = (pn == 4 ? nk : nv) + ((size_t)(b * 2 + slot) * 256 + t) * 256 + wc * 64 + 4 * fq;
                        *(f32x4*)o = v00; *(f32x4*)(o + 16) = v01; *(f32x4*)(o + 32) = v10; *(f32x4*)(o + 48) = v11; }
                }
            }
    }
};
struct EpiRetQKV {
    static constexpr bool PERM = false;
    bf16_t *q, *k, *v;
    __device__ __forceinline__ void operator()(const f32x4 (&acc)[2][2][4][2], const Unit& u, int wr, int wc, int fr, int fq) const {
        fr = launder(fr); fq = launder(fq);
        const int pn = u.pn;
#pragma unroll
        for (int ai = 0; ai < 2; ++ai)
#pragma unroll
            for (int m = 0; m < 4; ++m) {
                const int r = u.pm * BM + ai * HALF + wr * 64 + m * 16 + fr;
                f32x4 v00 = acc[ai][0][m][0], v01 = acc[ai][0][m][1], v10 = acc[ai][1][m][0], v11 = acc[ai][1][m][1];
                if (pn < 8) {
                    if (r >= NPROMPT) {
                        const int t = (r - NPROMPT) & 4095; const float rp = (float)(t >> 6), cp = (float)(t & 63);
#pragma unroll
                        for (int e = 0; e < 4; ++e) {
                            const float inv = __builtin_amdgcn_exp2f(-(float)(16 * wc + 4 * fq + e) * (13.287712379549449f / 64.f)); float c, s;
                            rope_cs(rp, inv, c, s); { const float x1 = v00[e], x2 = v01[e]; v00[e] = x1 * c - x2 * s; v01[e] = x2 * c + x1 * s; }
                            rope_cs(cp, inv, c, s); { const float x1 = v10[e], x2 = v11[e]; v10[e] = x1 * c - x2 * s; v11[e] = x2 * c + x1 * s; }
                        }
                    }
                    if (pn >= 4) { v00 = v00 * 0.0625f; v01 = v01 * 0.0625f; v10 = v10 * 0.0625f; v11 = v11 * 0.0625f; }
                }
                bf16_t* d = (pn < 4 ? q + (size_t)r * 1024 + pn * 256 : pn < 8 ? k + (size_t)r * 1024 + (pn - 4) * 256 : v + (size_t)r * 2048 + (pn - 8) * 256) + 16 * wc + 4 * fq;
                st4(d, v00); st4(d + 64, v01); st4(d + 128, v10); st4(d + 192, v11);
            }
    }
};
template <int MODE> struct EpiLateGate {
    static constexpr bool PERM = true;
    bf16_t* Z; int ldz; const float* fin; const float* gn;
    __device__ __forceinline__ void operator()(const f32x4 (&acc)[2][2][4][2], const Unit& u, int wr, int wc, int fr, int fq) const {
        fr = launder(fr); fq = launder(fq);
        const int row0 = u.pm * BM + wr * 64 + fr, col0 = u.pn * BM + wc * 32 + 8 * fq;
#pragma unroll
        for (int ai = 0; ai < 2; ++ai) {
            u32x4 zq[4][2];
#pragma unroll
            for (int m = 0; m < 4; ++m)
#pragma unroll
                for (int bj = 0; bj < 2; ++bj) zq[m][bj] = *(const u32x4*)(Z + (size_t)(row0 + ai * HALF + m * 16) * ldz + col0 + bj * HALF);
#pragma unroll
            for (int m = 0; m < 4; ++m) { const int r = row0 + ai * HALF + m * 16;
#pragma unroll
                for (int bj = 0; bj < 2; ++bj) { const int c0 = col0 + bj * HALF; bf16_t* zp = Z + (size_t)r * ldz + c0;
                    const u32x4 zw = zq[m][bj]; float z[8] = {bflo(zw.x), bfhi(zw.x), bflo(zw.y), bfhi(zw.y), bflo(zw.z), bfhi(zw.z), bflo(zw.w), bfhi(zw.w)};
                    float a[8]; { const f32x4 a0 = acc[ai][bj][m][0], a1 = acc[ai][bj][m][1]; a[0] = a0[0]; a[1] = a0[1]; a[2] = a0[2]; a[3] = a0[3]; a[4] = a1[0]; a[5] = a1[1]; a[6] = a1[2]; a[7] = a1[3]; }
                    float y[8];
                    if (MODE == 0) { const f32x2 st = *(const f32x2*)(fin + ((size_t)r * 4 + (c0 >> 9)) * 2); const f32x4 g0 = *(const f32x4*)(gn + c0), g1 = *(const f32x4*)(gn + c0 + 4);
                        const float gg[8] = {g0[0], g0[1], g0[2], g0[3], g1[0], g1[1], g1[2], g1[3]};
#pragma unroll
                        for (int e = 0; e < 8; ++e) y[e] = fsilu(a[e]) * ((z[e] - st.x) * st.y * gg[e]);
                    } else {
#pragma unroll
                        for (int e = 0; e < 8; ++e) y[e] = fgelu_tanh(a[e]) * z[e];
                    }
                    u32x4 w; w.x = cvt_pk_bf16(y[0], y[1]); w.y = cvt_pk_bf16(y[2], y[3]); w.z = cvt_pk_bf16(y[4], y[5]); w.w = cvt_pk_bf16(y[6], y[7]);
                    *(u32x4*)zp = w; } }
            asm volatile("" ::: "memory"); }
    }
};
struct EpiLruGates {
    static constexpr bool PERM = false;
    const bf16_t* xc; bf16_t *la, *uu; const float *br, *bi, *lam;
    __device__ __forceinline__ void operator()(const f32x4 (&acc)[2][2][4][2], const Unit& u, int wr, int wc, int fr, int fq) const {
        fr = launder(fr); fq = launder(fq);
        const int nb = u.pn >> 1, dir = u.pn & 1;
#pragma unroll
        for (int bj = 0; bj < 2; ++bj) {
            const int ch = nb * 128 + 64 * bj + 16 * wc + 4 * fq;
            const f32x4 brv = *(const f32x4*)(br + dir * 1024 + ch), biv = *(const f32x4*)(bi + dir * 1024 + ch), lv = *(const f32x4*)(lam + dir * 1024 + ch);
            f32x4 sp;
#pragma unroll
            for (int e = 0; e < 4; ++e) sp[e] = -8.f * __logf(1.f + __expf(-lv[e]));
            u32x2 xq[2][4];
#pragma unroll
            for (int ai = 0; ai < 2; ++ai)
#pragma unroll
                for (int m = 0; m < 4; ++m) xq[ai][m] = *(const u32x2*)(xc + (size_t)(u.pm * BM + ai * HALF + wr * 64 + m * 16 + fr) * 1024 + ch);
#pragma unroll
            for (int ai = 0; ai < 2; ++ai)
#pragma unroll
                for (int m = 0; m < 4; ++m) {
                    const int r = u.pm * BM + ai * HALF + wr * 64 + m * 16 + fr;
                    const u32x2 xw = xq[ai][m]; const float xv[4] = {bflo(xw.x), bfhi(xw.x), bflo(xw.y), bfhi(xw.y)};
                    const f32x4 rp = acc[ai][bj][m][0], ip = acc[ai][bj][m][1]; f32x4 lo, uo;
#pragma unroll
                    for (int e = 0; e < 4; ++e) { const float pa = 1.f + __expf(-(rp[e] + brv[e])), pb = 1.f + __expf(-(ip[e] + biv[e])); const float inv = __builtin_amdgcn_rcpf(pa * pb);
                        const float rg = pb * inv, ig = pa * inv; const float l = rg * sp[e]; lo[e] = l; uo[e] = __builtin_amdgcn_sqrtf(fmaxf(1.f - __expf(2.f * l), 0.f)) * ig * xv[e]; }
                    st4(la + ((size_t)r * 2 + dir) * 1024 + ch, lo); st4(uu + ((size_t)r * 2 + dir) * 1024 + ch, uo);
                    asm volatile("" ::: "memory");
                }
        }
    }
};
}
using pg8::st4;

struct KArgs { const float* in[32]; float* out; unsigned char* ws; };
struct KTab { const float* const* t; };
__device__ __forceinline__ const float* inp(const KTab& a, int k) { return a.t[k]; }
__device__ __forceinline__ const float* inp(const KArgs& a, int k) { return a.in[k]; }

__device__ __forceinline__ float wave_sum(float v) {
#pragma unroll
    for (int o = 1; o < 64; o <<= 1) v += __shfl_xor(v, o);
    return v;
}
__device__ __forceinline__ float wave_max(float v) {
#pragma unroll
    for (int o = 1; o < 64; o <<= 1) v = fmaxf(v, __shfl_xor(v, o));
    return v;
}

template <int MODE>
__device__ __forceinline__ const float* wcol(const float* s0, const float* s1, int n) {
    if (MODE == 0) return s0 + n;
    if (MODE == 1) { const int gp = (n >> 5) & 7, bj = gp >> 2, wc = gp & 3; return s0 + (n & ~255) + (2 * wc + bj) * 32 + (n & 31); }
    if (MODE == 2) { const int p = n & 255, bj = p >> 7, wc = (p >> 5) & 3, nn = (p >> 4) & 1, r = p & 15; return s0 + (n & ~255) + 128 * bj + 64 * nn + 16 * wc + r; }
    { const int pn = n >> 8, nb = pn >> 1, dir = pn & 1, p = n & 255, bj = p >> 7, wc = (p >> 5) & 3, nn = (p >> 4) & 1, r = p & 15; const int cb = 64 * bj + 16 * wc + r;
      return (nn ? s1 : s0) + (size_t)(dir * 8 + nb) * 16384 + cb; }
}
template <int MODE>
__device__ __forceinline__ void wconv(const float* s0, const float* s1, int ld, int K, int N, bf16_t* WT, LAS float* scr, int lane_, int gw, int NGW) {
    const int lane = lane_id_v(); (void)lane_; asm volatile("" : "+s"(gw));
    const int nblk = N / 32, nitems = (K / 64) * nblk;
    for (int item = gw; item < nitems; item += NGW) {
        const int kb = item / nblk, nb = item % nblk, k0 = 64 * kb, n0 = 32 * nb;
        const float* cp = wcol<MODE>(s0, s1, n0 + (lane & 31));
#pragma unroll 8
        for (int i = 0; i < 32; ++i) { const int kk = 2 * i + (lane >> 5); scr[kk * 33 + (lane & 31)] = cp[(size_t)(k0 + kk) * ld]; }
        asm volatile("s_waitcnt lgkmcnt(0)" ::: "memory");
        const int c = lane & 7;
#pragma unroll
        for (int j = 0; j < 4; ++j) { const int n = (lane >> 3) + 8 * j; const LAS float* s = scr + (8 * c) * 33 + n;
            u32x4 o; o.x = cvt_pk_bf16(s[0 * 33], s[1 * 33]); o.y = cvt_pk_bf16(s[2 * 33], s[3 * 33]); o.z = cvt_pk_bf16(s[4 * 33], s[5 * 33]); o.w = cvt_pk_bf16(s[6 * 33], s[7 * 33]);
            *(u32x4*)(WT + (size_t)(n0 + n) * K + k0 + 8 * c) = o; }
        asm volatile("s_waitcnt lgkmcnt(0)" ::: "memory");
    }
}
template <class AT>
__device__ __forceinline__ void convert_layer_weights(const AT& a, unsigned char* ws, int layer, LAS unsigned char* lds, int wave, int lane, int gw, int NGW) {
    LAS float* scr = (LAS float*)(lds + wave * 8448);
    wconv<0>(inp(a, 12) + (size_t)layer * DM * DFF, nullptr, DFF, DM, DFF, (bf16_t*)(ws + WS_WUP), scr, lane, gw, NGW);
    wconv<0>(inp(a, 13) + (size_t)layer * DFF * DM, nullptr, DM, DFF, DM, (bf16_t*)(ws + WS_WDN), scr, lane, gw, NGW);
    const int kind = layer % 3, slot = layer / 3;
    if (kind == 0) {
        wconv<1>(inp(a, 14) + (size_t)slot * DM * 1536, nullptr, 1536, DM, 1536, (bf16_t*)(ws + WS_WIN), scr, lane, gw, NGW);
        wconv<0>(inp(a, 15) + (size_t)slot * DM * DM, nullptr, DM, DM, DM, (bf16_t*)(ws + WS_WOUT), scr, lane, gw, NGW);
    } else if (kind == 1) {
        wconv<2>(inp(a, 19) + (size_t)slot * DM * 6144, nullptr, 6144, DM, 4096, (bf16_t*)(ws + WS_WIN), scr, lane, gw, NGW);
        wconv<0>(inp(a, 19) + (size_t)slot * DM * 6144 + 4096, nullptr, 6144, DM, 2048, (bf16_t*)(ws + WS_WX), scr, lane, gw, NGW);
        wconv<0>(inp(a, 20) + (size_t)slot * 2048 * DM, nullptr, DM, 2048, DM, (bf16_t*)(ws + WS_WOUT), scr, lane, gw, NGW);
    } else {
        wconv<0>(inp(a, 23) + (size_t)slot * DM * 2048 + 1024, nullptr, 2048, DM, 1024, (bf16_t*)(ws + WS_WIN), scr, lane, gw, NGW);
        wconv<0>(inp(a, 23) + (size_t)slot * DM * 2048, nullptr, 2048, DM, 1024, (bf16_t*)(ws + WS_WX), scr, lane, gw, NGW);
        wconv<3>(inp(a, 26) + (size_t)slot * 2 * 8 * 16384, inp(a, 28) + (size_t)slot * 2 * 8 * 16384, 128, 128, 4096, (bf16_t*)(ws + WS_WX2), scr, lane, gw, NGW);
        wconv<0>(inp(a, 31) + (size_t)slot * DM * DM, nullptr, DM, DM, DM, (bf16_t*)(ws + WS_WOUT), scr, lane, gw, NGW);
    }
}

__device__ __forceinline__ void mod_phase(const KArgs& a, LAS unsigned char* lds, const int wv) {
    LAS float* sc = (LAS float*)lds;
    LAS float* red = (LAS float*)(lds + 36864);
    const int tid = (wv * 64 + lane_id_v());
    if (bid_s() >= 384) return;
    for (int i = tid; i < 9 * 1024; i += 512) { const int j = i >> 10, k = i & 1023; const float v = j == 0 ? inp(a, 7)[k] : inp(a, 6)[(j - 1) * 1024 + k]; sc[i] = fsilu(v); }
    __syncthreads();
    float* modt = (float*)(a.ws + WS_MOD);
    const int cl = tid & 63, ks = tid >> 6;
    for (int item = bid_s(); item < 384; item += gridDim.x) {
        const int l = item / 96, cg_ = item % 96, col = cg_ * 64 + cl;
        const float* w = inp(a, 10) + (size_t)l * DM * 6144 + col;
        float acc[9];
#pragma unroll
        for (int j = 0; j < 9; ++j) acc[j] = 0.f;
        for (int k0 = ks * 128; k0 < ks * 128 + 128; k0 += 16) {
            float wv[16];
#pragma unroll
            for (int u = 0; u < 16; ++u) wv[u] = w[(size_t)(k0 + u) * 6144];
#pragma unroll
            for (int u = 0; u < 16; ++u)
#pragma unroll
                for (int j = 0; j < 9; ++j) acc[j] += sc[j * 1024 + k0 + u] * wv[u];
        }
#pragma unroll
        for (int j = 0; j < 9; ++j) red[(ks * 9 + j) * 64 + cl] = acc[j];
        __syncthreads();
        for (int idx = tid; idx < 576; idx += 512) { const int j = idx >> 6, c2 = idx & 63; float s = inp(a, 11)[(size_t)l * 6144 + cg_ * 64 + c2];
#pragma unroll
            for (int q = 0; q < 8; ++q) s += red[(q * 9 + j) * 64 + c2];
            modt[((size_t)l * 9 + j) * 6144 + cg_ * 64 + c2] = s; }
        __syncthreads();
    }
}
__device__ __forceinline__ void cache_phase(const KArgs& a, const int wv) {
    const size_t n4 = (size_t)8 * 2 * 512 * 256 / 4;
    for (size_t i = (size_t)bid_s() * 512 + (wv * 64 + lane_id_v()); i < 2 * n4; i += (size_t)gridDim.x * 512) {
        const bool isv = i >= n4; const size_t j = isv ? i - n4 : i;
        const f32x4 v = *(const f32x4*)((isv ? inp(a, 3) : inp(a, 2)) + j * 4);
        st4((bf16_t*)(a.ws + (isv ? WS_CV : WS_CK)) + j * 4, v);
    }
}
template <bool FIRST>
__device__ __forceinline__ void norm_phase(const float* xp_, const float* xs_, float* xres, const float* gain, const float* modl, int sh_chunk, bf16_t* hout, int lane_, int gw, int NGW, const float* part = nullptr, const float* fixgate = nullptr) {
    const int lane = lane_id_v(); (void)lane_; asm volatile("" : "+s"(gw));
    for (int r = gw; r < MTOK; r += NGW) {
        const float* xr = FIRST ? (r < NPROMPT ? xp_ + (size_t)r * DM : xs_ + (size_t)(r - NPROMPT) * DM) : nullptr;
        bf16_t* xb = (bf16_t*)xres + (size_t)r * 2048;
        f32x4 v[4]; float s = 0.f;
#pragma unroll
        for (int j = 0; j < 4; ++j) {
            if (FIRST) v[j] = *(const f32x4*)(xr + 4 * lane + 256 * j);
            else { const u32x2 w = *(const u32x2*)(xb + 4 * lane + 256 * j); v[j] = (f32x4){bflo(w.x), bfhi(w.x), bflo(w.y), bfhi(w.y)}; }
            s += v[j][0] * v[j][0] + v[j][1] * v[j][1] + v[j][2] * v[j][2] + v[j][3] * v[j][3]; }
        if (FIRST) {
#pragma unroll
            for (int j = 0; j < 4; ++j) st4(xb + 4 * lane + 256 * j, v[j]);
        }
        if (!FIRST && part != nullptr && r >= 32768) {
            const float* gp = fixgate + (size_t)modidx(r) * 6144; s = 0.f;
#pragma unroll
            for (int j = 0; j < 4; ++j) { const int c = 4 * lane + 256 * j; const bf16_t* pp = (const bf16_t*)part + (size_t)(r - 32768) * DM + c;
                const f32x4 ps = ((ld4bf(pp) + ld4bf(pp + (size_t)4096 * DM)) + ld4bf(pp + (size_t)2 * 4096 * DM)) + ld4bf(pp + (size_t)3 * 4096 * DM);
                v[j] = v[j] + *(const f32x4*)(gp + c) * ps; st4(xb + c, v[j]);
                s += v[j][0] * v[j][0] + v[j][1] * v[j][1] + v[j][2] * v[j][2] + v[j][3] * v[j][3]; }
        }
        const float rs = rsqrtf(wave_sum(s) * (1.f / DM) + 1e-6f);
        const float* mp = modl + (size_t)modidx(r) * 6144 + sh_chunk * 1024;
#pragma unroll
        for (int j = 0; j < 4; ++j) { const int c = 4 * lane + 256 * j; const f32x4 g = *(const f32x4*)(gain + c), sh = *(const f32x4*)(mp + c), sc = *(const f32x4*)(mp + 1024 + c);
            const f32x4 y = v[j] * rs * g * (1.f + sc) + sh; st4(hout + (size_t)r * DM + c, y); }
    }
}

__device__ __forceinline__ bf16x8 tr8(const LAS bf16_t* p0, const LAS bf16_t* p1) {
    const s16x4 a = __builtin_amdgcn_ds_read_tr16_b64_v4i16((LAS s16x4*)p0);
    const s16x4 b = __builtin_amdgcn_ds_read_tr16_b64_v4i16((LAS s16x4*)p1);
    return (bf16x8){a[0], a[1], a[2], a[3], b[0], b[1], b[2], b[3]};
}
__device__ __forceinline__ f32x16 mfma32(bf16x8 a, bf16x8 b, f32x16 c) { return __builtin_amdgcn_mfma_f32_32x32x16_bf16(a, b, c, 0, 0, 0); }
__device__ __forceinline__ f32x4 mfma16(bf16x8 a, bf16x8 b, f32x4 c) { return __builtin_amdgcn_mfma_f32_16x16x32_bf16(a, b, c, 0, 0, 0); }
__device__ __forceinline__ float fexp2(float x) { return __builtin_amdgcn_exp2f(x); }

__device__ __forceinline__ void att_tile(const LAS bf16_t* Ks, const LAS bf16_t* Vs, const bf16x8 (&Qf)[2][4], f32x16 (&ot)[2][2], float (&mrun)[2], float (&lrun)[2],
                                         bool skipw, bool needmask, int kpos0, int qpos0, int l31, int lh, int q4, int p4, int blk) {
            if (!skipw) {
                f32x16 sc[2][2];
#pragma unroll
                for (int cb = 0; cb < 2; ++cb)
#pragma unroll
                    for (int kk = 0; kk < 2; ++kk)
#pragma unroll
                        for (int r = 0; r < 16; ++r) sc[cb][kk][r] = 0.f;
#pragma unroll
                for (int s = 0; s < 4; ++s) {
                    const bf16x8 k0 = *(const LAS bf16x8*)(Ks + l31 * 72 + 16 * s + 8 * lh), k1 = *(const LAS bf16x8*)(Ks + (32 + l31) * 72 + 16 * s + 8 * lh);
                    sc[0][0] = mfma32(k0, Qf[0][s], sc[0][0]); sc[0][1] = mfma32(k1, Qf[0][s], sc[0][1]);
                    sc[1][0] = mfma32(k0, Qf[1][s], sc[1][0]); sc[1][1] = mfma32(k1, Qf[1][s], sc[1][1]);
                }
                bf16x8 pf[2][2][2];
#pragma unroll
                for (int cb = 0; cb < 2; ++cb) {
                    const int qpos = qpos0 + cb * 32 + l31;
                    float mx = -3.0e38f;
                    if (needmask) {
#pragma unroll
                        for (int r = 0; r < 16; ++r) { const int d0 = kpos0 + (r & 3) + 8 * (r >> 2) + 4 * lh - qpos, d1 = d0 + 32;
                            if (d0 > 128 || d0 < -128) sc[cb][0][r] = -1e30f; if (d1 > 128 || d1 < -128) sc[cb][1][r] = -1e30f; }
                    }
#pragma unroll
                    for (int r = 0; r < 16; ++r) mx = fmaxf(mx, fmaxf(sc[cb][0][r], sc[cb][1][r]));
                    mx = fmaxf(mx, __shfl_xor(mx, 32));
                    const float mnew = fmaxf(mrun[cb], mx), alpha = fexp2(mrun[cb] - mnew); mrun[cb] = mnew;
                    float ls = 0.f;
#pragma unroll
                    for (int r = 0; r < 16; ++r) { sc[cb][0][r] = fexp2(sc[cb][0][r] - mnew); sc[cb][1][r] = fexp2(sc[cb][1][r] - mnew); ls += sc[cb][0][r] + sc[cb][1][r]; }
                    lrun[cb] = lrun[cb] * alpha + ls;
                    if (__builtin_amdgcn_ballot_w64(alpha != 1.f) != 0ull) { ot[0][cb] = ot[0][cb] * alpha; ot[1][cb] = ot[1][cb] * alpha; }
#pragma unroll
                    for (int kk = 0; kk < 2; ++kk)
#pragma unroll
                        for (int s2 = 0; s2 < 2; ++s2) {
                            u32x4 w0;
                            w0.x = cvt_pk_bf16(sc[cb][kk][8 * s2 + 0], sc[cb][kk][8 * s2 + 1]); w0.y = cvt_pk_bf16(sc[cb][kk][8 * s2 + 2], sc[cb][kk][8 * s2 + 3]);
                            w0.z = cvt_pk_bf16(sc[cb][kk][8 * s2 + 4], sc[cb][kk][8 * s2 + 5]); w0.w = cvt_pk_bf16(sc[cb][kk][8 * s2 + 6], sc[cb][kk][8 * s2 + 7]);
                            pf[cb][kk][s2] = __builtin_bit_cast(bf16x8, w0);
                        }
                }
#pragma unroll
                for (int db = 0; db < 2; ++db)
#pragma unroll
                    for (int kbk = 0; kbk < 2; ++kbk)
#pragma unroll
                        for (int s2 = 0; s2 < 2; ++s2) {
                            const LAS bf16_t* vp = Vs + (kbk * 32 + 16 * s2 + 4 * lh + q4) * 72 + 32 * db + 16 * blk + 4 * p4;
                            const bf16x8 vf = tr8(vp, vp + 8 * 72);
                            ot[db][0] = mfma32(vf, pf[0][kbk][s2], ot[db][0]);
                            ot[db][1] = mfma32(vf, pf[1][kbk][s2], ot[db][1]);
                        }
            }
}
__device__ __forceinline__ void attn_phase(LAS unsigned char* lds, const bf16_t* qb, const bf16_t* kb, const bf16_t* vb, const bf16_t* ck, const bf16_t* cv, bf16_t* ob, const float* sink, const int wv) {
    LAS bf16_t* Ks = (LAS bf16_t*)lds; LAS bf16_t* Vs = (LAS bf16_t*)(lds + 9216);
    const int wid = wv, lane = lane_id_v(), tid = wid * 64 + lane, g = wid >> 1, qh = wid & 1;
    const int l31 = lane & 31, lh = lane >> 5, q4 = (lane & 15) >> 2, p4 = lane & 3, blk = (lane >> 4) & 1;
    const int skey = tid >> 3, sdc = tid & 7;
    for (int it = bid_s(); it < 1152; it += gridDim.x) {
        int b, hk, seqrow0, T, qbase, nlat, latk0, nctx; bool masked;
        if (it < 1024) { b = it >> 7; const int n = (it >> 2) & 31; hk = it & 3; seqrow0 = NPROMPT + b * 4096; T = 4096; qbase = n * 128; nlat = 6; latk0 = qbase - 128; nctx = 8; masked = true; }
        else { const int i2 = it - 1024; b = i2 >> 3; hk = (i2 >> 1) & 3; seqrow0 = b * 256; T = 256; qbase = (i2 & 1) * 128; nlat = 4; latk0 = 0; nctx = 0; masked = false; }
        const int h = hk * 4 + g, qpos0 = qbase + 64 * qh, ntiles = nlat + nctx;
        bf16x8 Qf[2][4];
#pragma unroll
        for (int cb = 0; cb < 2; ++cb)
#pragma unroll
            for (int s = 0; s < 4; ++s) Qf[cb][s] = *(const bf16x8*)(qb + (size_t)(seqrow0 + qpos0 + cb * 32 + l31) * 1024 + h * 64 + 16 * s + 8 * lh);
        float mrun[2], lrun[2]; f32x16 ot[2][2];
        const float sk = sink[h] * LOG2E;
        mrun[0] = sk; mrun[1] = sk; lrun[0] = lh == 0 ? 1.f : 0.f; lrun[1] = lrun[0];
#pragma unroll
        for (int i = 0; i < 2; ++i)
#pragma unroll
            for (int j = 0; j < 2; ++j)
#pragma unroll
                for (int r = 0; r < 16; ++r) ot[i][j][r] = 0.f;
        int ti = 0; while (ti < nlat && latk0 + 64 * ti < 0) ++ti;
        u32x4 kr0, vr0, kr1, vr1;
#define ATT_NEXT(tt) (((tt) + 1 < nlat && latk0 + 64 * ((tt) + 1) >= T) ? nlat : (tt) + 1)
#define ATT_LD(tt, KR, VR) do { const bf16_t *kp_, *vp_; if ((tt) < nlat) { const size_t o_ = (size_t)(seqrow0 + latk0 + 64 * (tt) + skey) * 256 + hk * 64 + sdc * 8; kp_ = kb + o_; vp_ = vb + o_; } \
            else { const size_t o_ = ((size_t)b * 1024 + 64 * ((tt) - nlat) + skey) * 256 + hk * 64 + sdc * 8; kp_ = ck + o_; vp_ = cv + o_; } KR = *(const u32x4*)kp_; VR = *(const u32x4*)vp_; } while (0)
#define ATT_FLAGS(cur_, SK, NM, KP) const bool SK##l_ = (cur_) < nlat; const int KP = latk0 + 64 * (cur_); bool SK = false, NM = false; \
            if (masked && SK##l_) { SK = (KP > qpos0 + 63 + 128) || (KP + 63 < qpos0 - 128); NM = (KP < qpos0 - 64) || (KP > qpos0 + 64); }
        int tp = ti, tq = ATT_NEXT(tp);
        ATT_LD(tp, kr0, vr0); ATT_LD(tq, kr1, vr1);
        while (tp < ntiles) {
            __syncthreads();
            *(LAS u32x4*)(Ks + skey * 72 + sdc * 8) = kr0; *(LAS u32x4*)(Vs + skey * 72 + sdc * 8) = vr0;
            *(LAS u32x4*)(Ks + 9216 + skey * 72 + sdc * 8) = kr1; *(LAS u32x4*)(Vs + 9216 + skey * 72 + sdc * 8) = vr1;
            __syncthreads();
            const int c0 = tp, c1 = tq;
            tp = ATT_NEXT(tq); tq = ATT_NEXT(tp);
            if (tp < ntiles) { ATT_LD(tp, kr0, vr0); ATT_LD(tq, kr1, vr1); }
            { ATT_FLAGS(c0, sk0, nm0, kp0) att_tile(Ks, Vs, Qf, ot, mrun, lrun, sk0, nm0, kp0, qpos0, l31, lh, q4, p4, blk); }
            { ATT_FLAGS(c1, sk1, nm1, kp1) att_tile(Ks + 9216, Vs + 9216, Qf, ot, mrun, lrun, sk1, nm1, kp1, qpos0, l31, lh, q4, p4, blk); }
        }
#undef ATT_NEXT
#undef ATT_LD
#undef ATT_FLAGS
#pragma unroll
        for (int cb = 0; cb < 2; ++cb) {
            const float lt = lrun[cb] + __shfl_xor(lrun[cb], 32), inv = 1.f / lt;
            bf16_t* orow = ob + (size_t)(seqrow0 + qpos0 + cb * 32 + l31) * 1024 + h * 64;
#pragma unroll
            for (int db = 0; db < 2; ++db)
#pragma unroll
                for (int rg = 0; rg < 4; ++rg) { const f32x4 v = {ot[db][cb][4 * rg] * inv, ot[db][cb][4 * rg + 1] * inv, ot[db][cb][4 * rg + 2] * inv, ot[db][cb][4 * rg + 3] * inv};
                    st4(orow + db * 32 + 8 * rg + 4 * lh, v); }
        }
    }
}

__device__ __forceinline__ void ret_scan_phase(LAS unsigned char* lds, const bf16_t* qb, const bf16_t* kb, const bf16_t* vb, bf16_t* ob, float* statp, const float* logdec, const float* state_in, float* state_out, const int wv) {
    constexpr int QST = 264, VST = 72;
    LAS bf16_t* Qs = (LAS bf16_t*)lds; LAS bf16_t* Ks = (LAS bf16_t*)(lds + 33792); LAS bf16_t* ST = (LAS bf16_t*)(lds + 67584);
    LAS bf16_t* Vs0 = (LAS bf16_t*)(lds + 101376); LAS bf16_t* Vw = (LAS bf16_t*)(lds + 110592); LAS bf16_t* Ps = (LAS bf16_t*)(lds + 119808);
    const int w = wv, lane = lane_id_v(), tid = w * 64 + lane, c16 = lane & 15, g = lane >> 4, q4 = (lane & 15) >> 2, p4 = lane & 3;
    const int itl = w >> 1, eb = 2 * (w & 1);
    for (int rnd = 0; rnd < 3; ++rnd) {
        const int bid = bid_s(), xx = bid & 7, ss = bid >> 3;
        const bool samp = rnd == 0; const int gidx = (samp ? 0 : (rnd - 1) * 32) + xx * 4 + (ss >> 3); const int b = gidx >> 2, head = gidx & 3, sl = ss & 7;
        const int seqrow0 = samp ? NPROMPT + b * 4096 : b * 256, T = samp ? 4096 : 256, nc = T / 64;
        for (int dir = 0; dir < 2; ++dir) {
            const float lg2 = logdec[dir * 4 + head] * LOG2E;
            f32x4 sacc[2][4];
#pragma unroll
            for (int dd = 0; dd < 2; ++dd)
#pragma unroll
                for (int et = 0; et < 4; ++et)
#pragma unroll
                    for (int r = 0; r < 4; ++r)
                        sacc[dd][et][r] = samp ? state_in[((((size_t)b * 2 + dir) * 4 + head) * 256 + 32 * w + 16 * dd + 4 * g + r) * 512 + sl * 64 + 16 * et + c16] : 0.f;
            __syncthreads();
#pragma unroll
            for (int dd = 0; dd < 2; ++dd)
#pragma unroll
                for (int et = 0; et < 4; ++et) { u32x2 wv; wv.x = cvt_pk_bf16(sacc[dd][et][0], sacc[dd][et][1]); wv.y = cvt_pk_bf16(sacc[dd][et][2], sacc[dd][et][3]);
                    *(LAS u32x2*)(ST + (16 * et + c16) * QST + 32 * w + 16 * dd + 4 * g) = wv; }
            u32x4 qreg[4], kreg[4], vreg;
#define RET_LOAD(cc_) do { const int t0_ = 64 * (cc_); _Pragma("unroll") for (int p = 0; p < 4; ++p) { const int idx = tid + 512 * p, row = idx >> 5, ch = idx & 31; \
                const size_t o_ = (size_t)(seqrow0 + t0_ + row) * 1024 + head * 256 + ch * 8; qreg[p] = *(const u32x4*)(qb + o_); kreg[p] = *(const u32x4*)(kb + o_); } \
                vreg = *(const u32x4*)(vb + (size_t)(seqrow0 + t0_ + (tid >> 3)) * 2048 + head * 512 + sl * 64 + (tid & 7) * 8); } while (0)
            RET_LOAD(dir ? nc - 1 : 0);
            const float gC = fexp2(lg2 * 64.f);
            float dec[2][4];
#pragma unroll
            for (int x = 0; x < 2; ++x)
#pragma unroll
                for (int r = 0; r < 4; ++r) { const int i = itl * 16 + c16, j = (eb + x) * 16 + 4 * g + r; const int df = dir ? j - i : i - j; const bool ok = dir ? df > 0 : df >= 0; dec[x][r] = ok ? fexp2(lg2 * (float)df) : 0.f; }
            const float wq_c = fexp2(lg2 * (float)(dir ? 64 - (itl * 16 + c16) : (itl * 16 + c16) + 1));
            const float wsj_c = fexp2(lg2 * (float)(dir ? (tid >> 3) : 63 - (tid >> 3)));
            for (int cc = 0; cc < nc; ++cc) {
                const int c = dir ? nc - 1 - cc : cc, t0 = 64 * c;
                LAS bf16_t* Vs = Vs0 + (cc & 1) * 13824;
#pragma unroll
                for (int p = 0; p < 4; ++p) { const int idx = tid + 512 * p, row = idx >> 5, ch = idx & 31; *(LAS u32x4*)(Qs + row * QST + ch * 8) = qreg[p]; *(LAS u32x4*)(Ks + row * QST + ch * 8) = kreg[p]; }
                { const int row = tid >> 3, ch = tid & 7; *(LAS u32x4*)(Vs + row * VST + ch * 8) = vreg;
                  const float wsj = wsj_c; u32x4 sv;
                  sv.x = cvt_pk_bf16(bflo(vreg.x) * wsj, bfhi(vreg.x) * wsj); sv.y = cvt_pk_bf16(bflo(vreg.y) * wsj, bfhi(vreg.y) * wsj);
                  sv.z = cvt_pk_bf16(bflo(vreg.z) * wsj, bfhi(vreg.z) * wsj); sv.w = cvt_pk_bf16(bflo(vreg.w) * wsj, bfhi(vreg.w) * wsj);
                  *(LAS u32x4*)(Vw + row * VST + ch * 8) = sv; }
                __syncthreads();
                if (cc + 1 < nc) RET_LOAD(dir ? nc - 2 - cc : cc + 1);
                const int orow = seqrow0 + t0 + itl * 16 + c16; bf16_t* op = ob + (size_t)orow * 2048 + head * 512 + sl * 64 + 4 * g;
                u32x2 pw0 = {0u, 0u}, pw1 = {0u, 0u};
                if (dir) { pw0 = *(const u32x2*)(op + eb * 16); pw1 = *(const u32x2*)(op + (eb + 1) * 16); }
                bf16x8 qf[8];
#pragma unroll
                for (int ks = 0; ks < 8; ++ks) qf[ks] = *(const LAS bf16x8*)(Qs + (itl * 16 + c16) * QST + 32 * ks + 8 * g);
#pragma unroll
                for (int x = 0; x < 2; ++x) {
                    const int jt = eb + x; f32x4 pt = {0.f, 0.f, 0.f, 0.f};
#pragma unroll
                    for (int ks = 0; ks < 8; ++ks) pt = mfma16(*(const LAS bf16x8*)(Ks + (jt * 16 + c16) * QST + 32 * ks + 8 * g), qf[ks], pt);
                    const int i = itl * 16 + c16; f32x4 pv;
#pragma unroll
                    for (int r = 0; r < 4; ++r) pv[r] = pt[r] * dec[x][r];
                    u32x2 wv; wv.x = cvt_pk_bf16(pv[0], pv[1]); wv.y = cvt_pk_bf16(pv[2], pv[3]);
                    *(LAS u32x2*)(Ps + i * VST + jt * 16 + 4 * g) = wv;
                }
                f32x4 oc[2];
                { const float wq = wq_c;
#pragma unroll
                  for (int x = 0; x < 2; ++x) { const int et = eb + x; f32x4 o = {0.f, 0.f, 0.f, 0.f};
#pragma unroll
                      for (int ks = 0; ks < 8; ++ks) o = mfma16(*(const LAS bf16x8*)(ST + (et * 16 + c16) * QST + 32 * ks + 8 * g), qf[ks], o);
                      oc[x] = o * wq; } }
#pragma unroll
                for (int dd = 0; dd < 2; ++dd)
#pragma unroll
                    for (int et = 0; et < 4; ++et) sacc[dd][et] = sacc[dd][et] * gC;
#pragma unroll
                for (int ks = 0; ks < 2; ++ks) {
                    bf16x8 bfr[4];
#pragma unroll
                    for (int et = 0; et < 4; ++et) { const LAS bf16_t* vp = Vw + (32 * ks + 8 * g + q4) * VST + 16 * et + 4 * p4; bfr[et] = tr8(vp, vp + 4 * VST); }
#pragma unroll
                    for (int dd = 0; dd < 2; ++dd) { const LAS bf16_t* kp = Ks + (32 * ks + 8 * g + q4) * QST + 32 * w + 16 * dd + 4 * p4; const bf16x8 af = tr8(kp, kp + 4 * QST);
#pragma unroll
                        for (int et = 0; et < 4; ++et) sacc[dd][et] = mfma16(af, bfr[et], sacc[dd][et]); }
                }
                __syncthreads();
#pragma unroll
                for (int x = 0; x < 2; ++x) { const int et = eb + x;
#pragma unroll
                    for (int ks = 0; ks < 2; ++ks) { const LAS bf16_t* vp = Vs + (32 * ks + 8 * g + q4) * VST + 16 * et + 4 * p4;
                        oc[x] = mfma16(tr8(vp, vp + 4 * VST), *(const LAS bf16x8*)(Ps + (itl * 16 + c16) * VST + 32 * ks + 8 * g), oc[x]); } }
                { const int row = orow;
                  if (dir == 0) { st4(op + eb * 16, oc[0]); st4(op + (eb + 1) * 16, oc[1]); }
                  else { float s1 = 0.f, s2 = 0.f;
#pragma unroll
                      for (int x = 0; x < 2; ++x) { bf16_t* o2 = op + (eb + x) * 16; const u32x2 pw = x ? pw1 : pw0; f32x4 f = oc[x];
                          f[0] += bflo(pw.x); f[1] += bfhi(pw.x); f[2] += bflo(pw.y); f[3] += bfhi(pw.y); st4(o2, f);
                          s1 += f[0] + f[1] + f[2] + f[3]; s2 += f[0] * f[0] + f[1] * f[1] + f[2] * f[2] + f[3] * f[3]; }
                      s1 += __shfl_xor(s1, 16); s1 += __shfl_xor(s1, 32); s2 += __shfl_xor(s2, 16); s2 += __shfl_xor(s2, 32);
                      if (g == 0) *(f32x2*)(statp + (((size_t)row * 4 + head) * 16 + sl * 2 + (w & 1)) * 2) = (f32x2){s1, s2}; } }
#pragma unroll
                for (int dd = 0; dd < 2; ++dd)
#pragma unroll
                    for (int et = 0; et < 4; ++et) { u32x2 wv; wv.x = cvt_pk_bf16(sacc[dd][et][0], sacc[dd][et][1]); wv.y = cvt_pk_bf16(sacc[dd][et][2], sacc[dd][et][3]);
                        *(LAS u32x2*)(ST + (16 * et + c16) * QST + 32 * w + 16 * dd + 4 * g) = wv; }
            }
#undef RET_LOAD
            if (!samp) {
#pragma unroll
                for (int dd = 0; dd < 2; ++dd)
#pragma unroll
                    for (int et = 0; et < 4; ++et)
#pragma unroll
                        for (int r = 0; r < 4; ++r)
                            state_out[((((size_t)b * 2 + dir) * 4 + head) * 256 + 32 * w + 16 * dd + 4 * g + r) * 512 + sl * 64 + 16 * et + c16] = sacc[dd][et][r];
            }
        }
    }
}
__device__ __forceinline__ void ret_fin_phase(const float* statp, float* fin, const int wv) {
    for (int i = bid_s() * 512 + (wv * 64 + lane_id_v()); i < MTOK * 4; i += gridDim.x * 512) {
        float s1 = 0.f, s2 = 0.f;
#pragma unroll
        for (int p = 0; p < 16; ++p) { const f32x2 v = *(const f32x2*)(statp + ((size_t)i * 16 + p) * 2); s1 += v.x; s2 += v.y; }
        const float mu = s1 * (1.f / 512.f), var = fmaxf(s2 * (1.f / 512.f) - mu * mu, 0.f);
        *(f32x2*)(fin + (size_t)i * 2) = (f32x2){mu, rsqrtf(var + 1e-6f)};
    }
}

__device__ __forceinline__ void lru_conv_phase(const bf16_t* xr, bf16_t* xc, const float* cw, const float* cbias, const int wv) {
    for (size_t i = (size_t)bid_s() * 512 + (wv * 64 + lane_id_v()); i < (size_t)MTOK * 128; i += (size_t)gridDim.x * 512) {
        const int r = (int)(i >> 7), c8 = (int)(i & 127) * 8;
        const int t = r < NPROMPT ? (r & 255) : ((r - NPROMPT) & 4095), T = r < NPROMPT ? 256 : 4096;
        float acc[8];
        { const f32x4 b0 = *(const f32x4*)(cbias + c8), b1 = *(const f32x4*)(cbias + c8 + 4); acc[0] = b0[0]; acc[1] = b0[1]; acc[2] = b0[2]; acc[3] = b0[3]; acc[4] = b1[0]; acc[5] = b1[1]; acc[6] = b1[2]; acc[7] = b1[3]; }
#pragma unroll
        for (int jj = 0; jj < 4; ++jj) { const int tt = t - 2 + jj;
            if (tt >= 0 && tt < T) { const u32x4 xw = *(const u32x4*)(xr + (size_t)(r - 2 + jj) * 1024 + c8); const f32x4 w0 = *(const f32x4*)(cw + jj * 1024 + c8), w1 = *(const f32x4*)(cw + jj * 1024 + c8 + 4);
                acc[0] += w0[0] * bflo(xw.x); acc[1] += w0[1] * bfhi(xw.x); acc[2] += w0[2] * bflo(xw.y); acc[3] += w0[3] * bfhi(xw.y);
                acc[4] += w1[0] * bflo(xw.z); acc[5] += w1[1] * bfhi(xw.z); acc[6] += w1[2] * bflo(xw.w); acc[7] += w1[3] * bfhi(xw.w); } }
        u32x4 o; o.x = cvt_pk_bf16(acc[0], acc[1]); o.y = cvt_pk_bf16(acc[2], acc[3]); o.z = cvt_pk_bf16(acc[4], acc[5]); o.w = cvt_pk_bf16(acc[6], acc[7]);
        *(u32x4*)(xc + (size_t)r * 1024 + c8) = o;
    }
}
__device__ __forceinline__ void lru_scanA_phase(const bf16_t* __restrict__ la, const bf16_t* __restrict__ uu, float* __restrict__ agg, const int wv) {
    constexpr int NS = 8 * 2 * 32 * 512, NP = 16 * 2 * 2 * 512;
    for (int idx = bid_s() * 512 + (wv * 64 + lane_id_v()); idx < NS + NP; idx += gridDim.x * 512) {
        int cp, dir, row0, segidx;
        if (idx < NS) { cp = idx & 511; const int seg = (idx >> 9) & 31; dir = (idx >> 14) & 1; const int b = idx >> 15; row0 = NPROMPT + b * 4096 + seg * 128; segidx = (b * 2 + dir) * 32 + seg; }
        else { const int i2 = idx - NS; cp = i2 & 511; const int seg = (i2 >> 9) & 1; dir = (i2 >> 10) & 1; const int b = i2 >> 11; row0 = b * 256 + seg * 128; segidx = 512 + (b * 2 + dir) * 2 + seg; }
        float L0 = 0.f, L1 = 0.f, H0 = 0.f, H1 = 0.f;
        for (int s0 = 0; s0 < 128; s0 += 16) {
            unsigned lw[16], uw[16];
#pragma unroll
            for (int j = 0; j < 16; ++j) { const int r = row0 + (dir ? 127 - (s0 + j) : s0 + j); const size_t o = ((size_t)r * 2 + dir) * 1024 + 2 * cp; lw[j] = *(const unsigned*)(la + o); uw[j] = *(const unsigned*)(uu + o); }
#pragma unroll
            for (int j = 0; j < 16; ++j) { const float l0 = bflo(lw[j]), l1 = bfhi(lw[j]); H0 = __expf(l0) * H0 + bflo(uw[j]); H1 = __expf(l1) * H1 + bfhi(uw[j]); L0 += l0; L1 += l1; }
        }
        *(f32x4*)(agg + ((size_t)segidx * 1024 + 2 * cp) * 2) = (f32x4){L0, H0, L1, H1};
    }
}
__device__ __forceinline__ void lru_scanC_phase(const bf16_t* __restrict__ la, const bf16_t* __restrict__ uu, const float* __restrict__ agg, bf16_t* __restrict__ rec, const float* __restrict__ st_in, float* __restrict__ st_out, const int wv) {
    constexpr int NS = 8 * 32 * 512, NP = 16 * 2 * 512;
    for (int idx = bid_s() * 512 + (wv * 64 + lane_id_v()); idx < NS + NP; idx += gridDim.x * 512) {
        int cp, seg, b, row0, nseg, segb; const bool samp = idx < NS;
        if (samp) { cp = idx & 511; seg = (idx >> 9) & 31; b = idx >> 14; row0 = NPROMPT + b * 4096 + seg * 128; nseg = 32; segb = b * 64; }
        else { const int i2 = idx - NS; cp = i2 & 511; seg = (i2 >> 9) & 1; b = i2 >> 10; row0 = b * 256 + seg * 128; nseg = 2; segb = 512 + b * 4; }
        float h0 = 0.f, h1 = 0.f;
        if (samp) { const f32x2 v = *(const f32x2*)(st_in + (b * 2 + 0) * 1024 + 2 * cp); h0 = v.x; h1 = v.y; }
        for (int s2 = 0; s2 < seg; ++s2) { const f32x4 v = *(const f32x4*)(agg + ((size_t)(segb + s2) * 1024 + 2 * cp) * 2); h0 = __expf(v[0]) * h0 + v[1]; h1 = __expf(v[2]) * h1 + v[3]; }
        for (int s0 = 0; s0 < 128; s0 += 16) {
            unsigned lw[16], uw[16];
#pragma unroll
            for (int j = 0; j < 16; ++j) { const size_t o = ((size_t)(row0 + s0 + j) * 2 + 0) * 1024 + 2 * cp; lw[j] = *(const unsigned*)(la + o); uw[j] = *(const unsigned*)(uu + o); }
#pragma unroll
            for (int j = 0; j < 16; ++j) { h0 = __expf(bflo(lw[j])) * h0 + bflo(uw[j]); h1 = __expf(bfhi(lw[j])) * h1 + bfhi(uw[j]); *(unsigned*)(rec + (size_t)(row0 + s0 + j) * 1024 + 2 * cp) = cvt_pk_bf16(h0, h1); }
        }
        if (!samp && seg == nseg - 1) *(f32x2*)(st_out + (b * 2 + 0) * 1024 + 2 * cp) = (f32x2){h0, h1};
        h0 = 0.f; h1 = 0.f;
        if (samp) { const f32x2 v = *(const f32x2*)(st_in + (b * 2 + 1) * 1024 + 2 * cp); h0 = v.x; h1 = v.y; }
        for (int s2 = nseg - 1; s2 > seg; --s2) { const f32x4 v = *(const f32x4*)(agg + ((size_t)(segb + nseg + s2) * 1024 + 2 * cp) * 2); h0 = __expf(v[0]) * h0 + v[1]; h1 = __expf(v[2]) * h1 + v[3]; }
        for (int s0 = 0; s0 < 128; s0 += 16) {
            unsigned lw[16], uw[16], rw[16];
#pragma unroll
            for (int j = 0; j < 16; ++j) { const int r = row0 + 127 - (s0 + j); const size_t o = ((size_t)r * 2 + 1) * 1024 + 2 * cp; lw[j] = *(const unsigned*)(la + o); uw[j] = *(const unsigned*)(uu + o); rw[j] = *(const unsigned*)(rec + (size_t)r * 1024 + 2 * cp); }
#pragma unroll
            for (int j = 0; j < 16; ++j) { const int r = row0 + 127 - (s0 + j); h0 = __expf(bflo(lw[j])) * h0 + bflo(uw[j]); h1 = __expf(bfhi(lw[j])) * h1 + bfhi(uw[j]);
                *(unsigned*)(rec + (size_t)r * 1024 + 2 * cp) = cvt_pk_bf16(bflo(rw[j]) + h0, bfhi(rw[j]) + h1); }
        }
        if (!samp && seg == 0) *(f32x2*)(st_out + (b * 2 + 1) * 1024 + 2 * cp) = (f32x2){h0, h1};
    }
}

#ifndef REP_BAR
#define REP_BAR 1
#endif
#ifndef REP_ATT
#define REP_ATT 1
#endif
#ifndef REP_RET
#define REP_RET 1
#endif
#ifndef REP_LRU
#define REP_LRU 1
#endif
#ifndef REP_UP
#define REP_UP 1
#endif
#ifndef REP_NORM
#define REP_NORM 1
#endif
__device__ __forceinline__ int opq(int n) { asm volatile("" : "+s"(n)); return n; }
constexpr int LDS_BYTES = 147456;
constexpr size_t WS_BAR = 4096;
#define XB_TMO      128
#define XB_XCNT(j)  (256  + 64 * (j))
#define XB_XSUB(j)  (1280 + 64 * (j))
#define XB_XGEN(j)  (2304 + 64 * (j))
#define XB_TOP      3328
#define XB_TOPGEN   3392
#define XCD_BAR_WORDS 3456
#define XB_SPIN_CAP (1u << 22)
__device__ __forceinline__ unsigned xb_ld(unsigned* p)              { return __hip_atomic_load(p, __ATOMIC_RELAXED, __HIP_MEMORY_SCOPE_AGENT); }
__device__ __forceinline__ unsigned xb_add(unsigned* p, unsigned v) { return __hip_atomic_fetch_add(p, v, __ATOMIC_RELAXED, __HIP_MEMORY_SCOPE_AGENT); }
__device__ __forceinline__ unsigned xb_xcc_id() { return (unsigned)__builtin_amdgcn_s_getreg((3 << 11) | 20) & 0xFu; }
#define XB_SPIN(cond, bar) do { unsigned _sp = 0; while (cond) { __builtin_amdgcn_s_sleep(1); \
    if ((++_sp & 255u) == 0u) { if (xb_ld(&(bar)[XB_TMO])) break; if (_sp > XB_SPIN_CAP) { atomicAdd(&(bar)[XB_TMO], 1u); break; } } } } while (0)
__device__ __forceinline__ void xcd_barrier_complete(unsigned* bar, unsigned x, unsigned& nloc, unsigned& nx) {
    const unsigned G = gridDim.x;
    unsigned sum, cnt, mine, sp = 0u;
    for (;;) {
        sum = 0u; cnt = 0u; mine = 0u;
#pragma unroll
        for (unsigned j = 0; j < 16; ++j) { const unsigned c = xb_ld(&bar[XB_XCNT(j)]); sum += c; cnt += (c > 0u) ? 1u : 0u; mine = (j == x) ? c : mine; }
        if (sum == G) break;
        __builtin_amdgcn_s_sleep(1);
        if ((++sp & 255u) == 0u) { if (xb_ld(&bar[XB_TMO])) break; if (sp > XB_SPIN_CAP) { atomicAdd(&bar[XB_TMO], 1u); break; } }
    }
    nloc = mine > 0u ? mine : 1u; nx = cnt > 0u ? cnt : 1u;
}
__device__ __forceinline__ void gbar(unsigned* bar, volatile LAS unsigned* st, const int wv) {
    asm volatile("s_waitcnt vmcnt(0) lgkmcnt(0)" ::: "memory");
    __syncthreads();
    if (wv == 0) {
      if (lane_id_v() == 0) {
        const unsigned x = xb_xcc_id();
        unsigned nloc = st[0], nx = st[1];
        if (nloc == 0u) { xcd_barrier_complete(bar, x, nloc, nx); st[0] = nloc; st[1] = nx; }
        const unsigned old = xb_add(&bar[XB_XSUB(x)], 1u);
        const unsigned gen = old / nloc;
        if (old + 1u == (gen + 1u) * nloc) {
            __builtin_amdgcn_fence(__ATOMIC_RELEASE, "agent");
            asm volatile("s_waitcnt vmcnt(0)" ::: "memory");
            const unsigned og = xb_add(&bar[XB_TOP], 1u);
            const unsigned tg = og / nx;
            if (og + 1u == (tg + 1u) * nx) xb_add(&bar[XB_TOPGEN], 1u);
            else XB_SPIN(xb_ld(&bar[XB_TOPGEN]) == tg, bar);
            __builtin_amdgcn_fence(__ATOMIC_ACQUIRE, "agent");
            xb_add(&bar[XB_XGEN(x)], 1u);
            asm volatile("s_waitcnt vmcnt(0)" ::: "memory");
        } else {
            XB_SPIN(xb_ld(&bar[XB_XGEN(x)]) == gen, bar);
            __builtin_amdgcn_fence(__ATOMIC_ACQUIRE, "agent");
            asm volatile("s_waitcnt vmcnt(0)" ::: "memory");
        }
      }
    }
    __syncthreads();
}
__global__ void __launch_bounds__(512, 2) fwd_mega(KArgs a) {
    extern __shared__ __attribute__((aligned(16))) unsigned char lds_raw[];
    LAS unsigned char* lds = (LAS unsigned char*)lds_raw;
    cg::this_grid().sync();
    volatile LAS unsigned* bst = (volatile LAS unsigned*)(lds + 143360);
    if (wave_id_s() == 0 && lane_id_v() == 0) { bst[0] = 0u; bst[1] = 0u; const unsigned xc_ = xb_xcc_id();
        const unsigned slot_ = xb_add(&((unsigned*)(karg_ptr(264) + WS_BAR))[XB_XCNT(xc_)], 1u); bst[2] = blockIdx.x; bst[3] = (xc_ << 8) | slot_; }
    __syncthreads();
    const int wave = wave_id_s(), lane = 0, G = gridDim.x, gw = bid_s() * 8 + wave, NGW = G * 8;
#define ws karg_ptr(264)
#define XR ((float*)karg_ptr(256))
#define modt ((float*)(ws + WS_MOD))
#define hbuf ((bf16_t*)(ws + WS_H))
#define WUP ((bf16_t*)(ws + WS_WUP))
#define WDN ((bf16_t*)(ws + WS_WDN))
#define WIN ((bf16_t*)(ws + WS_WIN))
#define WOUT ((bf16_t*)(ws + WS_WOUT))
#define WX ((bf16_t*)(ws + WS_WX))
#define WX2 ((bf16_t*)(ws + WS_WX2))
    mod_phase(a, lds, wave); __syncthreads();
    cache_phase(a, wave);
    convert_layer_weights(a, ws, 0, lds, wave, lane, gw, NGW);
    if (bid_s() == 0 && wave == 0) { const int l_ = lane_id_v(); if (l_ < 32) ((const float**)ws)[l_] = a.in[l_]; }
    for (int rb_ = opq(REP_BAR); rb_ > 0; --rb_) gbar((unsigned*)(ws + WS_BAR), bst, wave);
    if (wave == 0 && lane_id_v() == 0) {
        unsigned* bar_ = (unsigned*)(ws + WS_BAR); bool ok_ = gridDim.x == 256;
        for (unsigned j = 0; j < 16; ++j) { const unsigned c_ = xb_ld(&bar_[XB_XCNT(j)]); ok_ = ok_ && (c_ == (j < 8 ? 32u : 0u)); }
        const unsigned v_ = bst[3]; if (ok_) bst[2] = (v_ & 255u) * 8u + (v_ >> 8);
    }
    __syncthreads();
#define tb (KTab{(const float* const*)ws})
    constexpr int KS = 1;
    for (int layer = 0; layer < 4; ++layer) {
        const int kind = layer % 3, slot = layer / 3;
#define modl (modt + (size_t)layer * 9 * 6144)
        pg8::StaticOrder S;
        if (layer == 0) norm_phase<true>(inp(tb, 0), inp(tb, 1), XR, inp(tb, 8), modl, 0, hbuf, lane, gw, NGW);
        else { norm_phase<false>(nullptr, nullptr, XR, inp(tb, 8) + layer * DM, modl, 0, hbuf, lane, gw, NGW, KS ? (const float*)(ws + WS_PART_M) : nullptr, modl - 9 * 6144 + 5 * 1024); __syncthreads(); convert_layer_weights(tb, ws, layer, lds, wave, lane, gw, NGW); }
        for (int rb_ = opq(REP_BAR); rb_ > 0; --rb_) gbar((unsigned*)(ws + WS_BAR), bst, wave);
        if (kind == 0) {
            bf16_t *q = (bf16_t*)(ws + WS_AQ), *k = (bf16_t*)(ws + WS_AK), *v = (bf16_t*)(ws + WS_AV), *o = (bf16_t*)(ws + WS_AO);
            { pg8::Gemm g{hbuf, WIN, MTOK, 1536, 1024, 1024, 1024, 31, 0}; S.init(MTOK, 1536, G, bid_s());
              pg8::EpiAttnQKV E{q, k, v, XR + OUT_K, XR + OUT_V, inp(tb, 16) + slot * 64, inp(tb, 17) + slot * 64, slot};
              pg8::gemm_phase(lds, g, S, E, wave); }
            for (int rb_ = opq(REP_BAR); rb_ > 0; --rb_) gbar((unsigned*)(ws + WS_BAR), bst, wave);
            for (int rp_ = opq(REP_ATT); rp_ > 0; --rp_) attn_phase(lds, q, k, v, (const bf16_t*)(ws + WS_CK) + (size_t)slot * 512 * 256, (const bf16_t*)(ws + WS_CV) + (size_t)slot * 512 * 256, o, inp(tb, 18) + slot * 16, wave);
            for (int rb_ = opq(REP_BAR); rb_ > 0; --rb_) gbar((unsigned*)(ws + WS_BAR), bst, wave);
            { pg8::Gemm g{o, WOUT, MTOK, 1024, 1024, 1024, 1024, 31, 0}; S.init(MTOK, 1024, G, bid_s(), KS); pg8::EpiResid E{XR, modl + 2 * 1024, (float*)(ws + WS_PART_A)}; pg8::gemm_phase(lds, g, S, E, wave); }
            for (int rb_ = opq(REP_BAR); rb_ > 0; --rb_) gbar((unsigned*)(ws + WS_BAR), bst, wave);
        } else if (kind == 1) {
            bf16_t *q = (bf16_t*)(ws + WS_RQ), *k = (bf16_t*)(ws + WS_RK), *v = (bf16_t*)(ws + WS_RV), *o = (bf16_t*)(ws + WS_RO);
            float* statp = (float*)(ws + WS_RSTP); float* fin = (float*)(ws + WS_RFIN);
            { pg8::Gemm g{hbuf, WIN, MTOK, 4096, 1024, 1024, 1024, 31, 0}; S.init(MTOK, 4096, G, bid_s()); pg8::EpiRetQKV E{q, k, v}; pg8::gemm_phase(lds, g, S, E, wave); }
            for (int rb_ = opq(REP_BAR); rb_ > 0; --rb_) gbar((unsigned*)(ws + WS_BAR), bst, wave);
            for (int rp_ = opq(REP_RET); rp_ > 0; --rp_) ret_scan_phase(lds, q, k, v, o, statp, inp(tb, 22) + slot * 8, inp(tb, 4), XR + OUT_RET, wave);
            for (int rb_ = opq(REP_BAR); rb_ > 0; --rb_) gbar((unsigned*)(ws + WS_BAR), bst, wave);
            bf16_t* h2 = (bf16_t*)(ws + WS_RQ);
            norm_phase<false>(nullptr, nullptr, XR, inp(tb, 8) + layer * DM, modl, 0, h2, lane, gw, NGW);
            ret_fin_phase(statp, fin, wave);
            for (int rb_ = opq(REP_BAR); rb_ > 0; --rb_) gbar((unsigned*)(ws + WS_BAR), bst, wave);
            { pg8::Gemm g{h2, WX, MTOK, 2048, 1024, 1024, 1024, 31, 0}; S.init(MTOK, 2048, G, bid_s()); pg8::EpiLateGate<0> E{o, 2048, fin, inp(tb, 21) + slot * 2048}; pg8::gemm_phase(lds, g, S, E, wave); }
            for (int rb_ = opq(REP_BAR); rb_ > 0; --rb_) gbar((unsigned*)(ws + WS_BAR), bst, wave);
            { pg8::Gemm g{o, WOUT, MTOK, 1024, 2048, 2048, 2048, 31, 0}; S.init(MTOK, 1024, G, bid_s(), KS); pg8::EpiResid E{XR, modl + 2 * 1024, (float*)(ws + WS_PART_R)}; pg8::gemm_phase(lds, g, S, E, wave); }
            for (int rb_ = opq(REP_BAR); rb_ > 0; --rb_) gbar((unsigned*)(ws + WS_BAR), bst, wave);
        } else {
            bf16_t *xr = (bf16_t*)(ws + WS_LXR), *xc = (bf16_t*)(ws + WS_LXC), *la = (bf16_t*)(ws + WS_LLA), *uu = (bf16_t*)(ws + WS_LU), *rec = (bf16_t*)(ws + WS_LREC);
            float* agg = (float*)(ws + WS_LAGG);
            { pg8::Gemm g{hbuf, WIN, MTOK, 1024, 1024, 1024, 1024, 31, 0}; S.init(MTOK, 1024, G, bid_s()); pg8::EpiStore<0> E{xr, 1024}; pg8::gemm_phase(lds, g, S, E, wave); }
            for (int rb_ = opq(REP_BAR); rb_ > 0; --rb_) gbar((unsigned*)(ws + WS_BAR), bst, wave);
            for (int rp_ = opq(REP_LRU); rp_ > 0; --rp_) lru_conv_phase(xr, xc, inp(tb, 24) + slot * 4096, inp(tb, 25) + slot * 1024, wave);
            for (int rb_ = opq(REP_BAR); rb_ > 0; --rb_) gbar((unsigned*)(ws + WS_BAR), bst, wave);
            { pg8::Gemm g{xc, WX2, MTOK, 4096, 128, 1024, 128, 1, 256}; S.init(MTOK, 4096, G, bid_s());
              pg8::EpiLruGates E{xc, la, uu, inp(tb, 27) + slot * 2048, inp(tb, 29) + slot * 2048, inp(tb, 30) + slot * 2048}; pg8::gemm_phase(lds, g, S, E, wave); }
            for (int rb_ = opq(REP_BAR); rb_ > 0; --rb_) gbar((unsigned*)(ws + WS_BAR), bst, wave);
            for (int rp_ = opq(REP_LRU); rp_ > 0; --rp_) lru_scanA_phase(la, uu, agg, wave);
            for (int rb_ = opq(REP_BAR); rb_ > 0; --rb_) gbar((unsigned*)(ws + WS_BAR), bst, wave);
            for (int rp_ = opq(REP_LRU); rp_ > 0; --rp_) lru_scanC_phase(la, uu, agg, rec, inp(tb, 5) + slot * 2048, XR + OUT_LRU, wave);
            for (int rb_ = opq(REP_BAR); rb_ > 0; --rb_) gbar((unsigned*)(ws + WS_BAR), bst, wave);
            { pg8::Gemm g{hbuf, WX, MTOK, 1024, 1024, 1024, 1024, 31, 0}; S.init(MTOK, 1024, G, bid_s()); pg8::EpiLateGate<1> E{rec, 1024, nullptr, nullptr}; pg8::gemm_phase(lds, g, S, E, wave); }
            for (int rb_ = opq(REP_BAR); rb_ > 0; --rb_) gbar((unsigned*)(ws + WS_BAR), bst, wave);
            { pg8::Gemm g{rec, WOUT, MTOK, 1024, 1024, 1024, 1024, 31, 0}; S.init(MTOK, 1024, G, bid_s(), KS); pg8::EpiResid E{XR, modl + 2 * 1024, (float*)(ws + WS_PART_L)}; pg8::gemm_phase(lds, g, S, E, wave); }
            for (int rb_ = opq(REP_BAR); rb_ > 0; --rb_) gbar((unsigned*)(ws + WS_BAR), bst, wave);
        }
        norm_phase<false>(nullptr, nullptr, XR, inp(tb, 9) + layer * DM, modl, 3, hbuf, lane, gw, NGW, KS ? (const float*)(ws + (kind == 0 ? WS_PART_A : kind == 1 ? WS_PART_R : WS_PART_L)) : nullptr, modl + 2 * 1024);
        for (int rb_ = opq(REP_BAR); rb_ > 0; --rb_) gbar((unsigned*)(ws + WS_BAR), bst, wave);
        bf16_t* hid = (bf16_t*)(ws + WS_HID);
        for (int rp_ = opq(REP_UP); rp_ > 0; --rp_) { pg8::Gemm g{hbuf, WUP, MTOK, 4096, 1024, 1024, 1024, 31, 0}; S.init(MTOK, 4096, G, bid_s()); pg8::EpiStore<2> E{hid, 4096}; pg8::gemm_phase(lds, g, S, E, wave); }
        for (int rb_ = opq(REP_BAR); rb_ > 0; --rb_) gbar((unsigned*)(ws + WS_BAR), bst, wave);
        { pg8::Gemm g{hid, WDN, MTOK, 1024, 4096, 4096, 4096, 31, 0}; S.init(MTOK, 1024, G, bid_s(), KS); pg8::EpiResid E{XR, modl + 5 * 1024, (float*)(ws + WS_PART_M)}; pg8::gemm_phase(lds, g, S, E, wave); }
        for (int rb_ = opq(REP_BAR); rb_ > 0; --rb_) gbar((unsigned*)(ws + WS_BAR), bst, wave);
    }
    {
        const int layer = 3; const float* gate = modl + 5 * 1024; const float* part = (const float*)(ws + WS_PART_M); float* xo = XR;
        const int l_ = lane_id_v();
        for (int r = gw; r < MTOK; r += NGW) { const bf16_t* xb = (const bf16_t*)xo + (size_t)r * 2048; f32x4 v[4];
#pragma unroll
            for (int j = 0; j < 4; ++j) { const u32x2 w = *(const u32x2*)(xb + 4 * l_ + 256 * j); v[j] = (f32x4){bflo(w.x), bfhi(w.x), bflo(w.y), bfhi(w.y)}; }
            if (KS && r >= 32768) { const float* gp = gate + (size_t)modidx(r) * 6144;
#pragma unroll
                for (int j = 0; j < 4; ++j) { const int c = 4 * l_ + 256 * j; const bf16_t* pp = (const bf16_t*)part + (size_t)(r - 32768) * DM + c;
                    const f32x4 ps = ((ld4bf(pp) + ld4bf(pp + (size_t)4096 * DM)) + ld4bf(pp + (size_t)2 * 4096 * DM)) + ld4bf(pp + (size_t)3 * 4096 * DM);
                    v[j] = v[j] + *(const f32x4*)(gp + c) * ps; } }
            asm volatile("s_waitcnt vmcnt(0)" ::: "memory");
#pragma unroll
            for (int j = 0; j < 4; ++j) *(f32x4*)(xo + (size_t)r * DM + 4 * l_ + 256 * j) = v[j];
        }
    }
}

#undef ws
#undef XR
#undef modt
#undef hbuf
#undef WUP
#undef WDN
#undef WIN
#undef WOUT
#undef WX
#undef WX2
#undef modl
#undef tb
extern "C" void kernel_launch(void* const* d_in, const int* in_sizes, int n_in, void* d_out, int out_size, void* d_ws, size_t ws_size, hipStream_t stream) {
    static int grid = 0;
    if (grid == 0) {
        int dev = 0, cus = 0, per_cu = 0;
        hipGetDevice(&dev); hipDeviceGetAttribute(&cus, hipDeviceAttributeMultiprocessorCount, dev);
        if (hipFuncSetAttribute((const void*)fwd_mega, hipFuncAttributeMaxDynamicSharedMemorySize, LDS_BYTES) != hipSuccess) { fprintf(stderr, "hipFuncSetAttribute failed\n"); grid = -1; return; }
        if (hipOccupancyMaxActiveBlocksPerMultiprocessor(&per_cu, (const void*)fwd_mega, 512, LDS_BYTES) != hipSuccess || per_cu < 1) { fprintf(stderr, "occupancy query: %d\n", per_cu); per_cu = 1; }
        (void)hipGetLastError();
        grid = cus * per_cu;
        if (grid != 256) { fprintf(stderr, "kernel_launch: this build needs exactly 256 resident workgroups (got %d)\n", grid); grid = -1; return; }
        if (n_in != 32 || ws_size < 512 * MiB) { fprintf(stderr, "kernel_launch: unexpected n_in %d / ws %zu\n", n_in, ws_size); grid = -1; return; }
    }
    if (grid < 0) return;
    KArgs a{};
    for (int i = 0; i < 32; ++i) a.in[i] = (const float*)d_in[i];
    a.out = (float*)d_out; a.ws = (unsigned char*)d_ws;
    if (hipMemsetAsync((char*)d_ws + WS_BAR, 0, 16384, stream) != hipSuccess) { fprintf(stderr, "memset failed\n"); return; }
    void* args[] = {&a};
    hipError_t e = hipLaunchCooperativeKernel((const void*)fwd_mega, dim3(grid), dim3(512), args, LDS_BYTES, stream);
    if (e != hipSuccess) fprintf(stderr, "cooperative launch failed: %s (grid %d)\n", hipGetErrorString(e), grid);
}
```

```cpp
#include <hip/hip_runtime.h>
#include <hip/hip_cooperative_groups.h>
#include <cstdio>
#include <cstdint>
namespace cg = cooperative_groups;

#define LAS __attribute__((address_space(3)))
typedef unsigned short bf16_t;
typedef short bf16x8 __attribute__((ext_vector_type(8)));
typedef short s16x4 __attribute__((ext_vector_type(4)));
typedef float f32x4 __attribute__((ext_vector_type(4)));
typedef float f32x2 __attribute__((ext_vector_type(2)));
typedef float f32x16 __attribute__((ext_vector_type(16)));
typedef unsigned u32x4 __attribute__((ext_vector_type(4)));
typedef unsigned u32x2 __attribute__((ext_vector_type(2)));

#define LOG2E 1.4426950408889634f
constexpr int DM = 1024, NPROMPT = 4096, MTOK = 36864, DFF = 4096;
constexpr size_t MiB = 1u << 20;
constexpr size_t WS_MOD = 1 * MiB;
constexpr size_t WS_WUP = 2 * MiB, WS_WDN = 10 * MiB, WS_WIN = 18 * MiB, WS_WOUT = 26 * MiB, WS_WX = 30 * MiB, WS_WX2 = 32 * MiB;
constexpr size_t WS_CK = 34 * MiB, WS_CV = 38 * MiB;
constexpr size_t WS_A = 44 * MiB;
constexpr size_t WS_H = 440 * MiB;
constexpr size_t WS_AQ = 44 * MiB, WS_AK = 116 * MiB, WS_AV = 134 * MiB, WS_AO = 152 * MiB;
constexpr size_t WS_RQ = 44 * MiB, WS_RK = 116 * MiB, WS_RV = 188 * MiB, WS_RO = 332 * MiB, WS_RSTP = 476 * MiB, WS_RFIN = 494 * MiB;
constexpr size_t WS_LXR = 368 * MiB, WS_LXC = 44 * MiB, WS_LLA = 116 * MiB, WS_LU = 260 * MiB, WS_LAGG = 404 * MiB, WS_LREC = 44 * MiB;
constexpr size_t WS_HID = 44 * MiB;
constexpr size_t WS_PART_A = 224 * MiB, WS_PART_R = 44 * MiB, WS_PART_L = 116 * MiB, WS_PART_M = 332 * MiB;
constexpr size_t OUT_K = 37748736, OUT_V = 39845888, OUT_RET = 41943040, OUT_LRU = 58720256;

__device__ __forceinline__ unsigned cvt_pk_bf16(float lo, float hi) { unsigned r; asm volatile("v_cvt_pk_bf16_f32 %0, %1, %2" : "=v"(r) : "v"(lo), "v"(hi)); return r; }
__device__ __forceinline__ float bf2f(unsigned short b) { return __uint_as_float((unsigned)b << 16); }
__device__ __forceinline__ float bflo(unsigned w) { return __uint_as_float(w << 16); }
__device__ __forceinline__ float bfhi(unsigned w) { return __uint_as_float(w & 0xffff0000u); }
__device__ __forceinline__ f32x4 ld4bf(const bf16_t* p) { const u32x2 w = *(const u32x2*)p; return (f32x4){bflo(w.x), bfhi(w.x), bflo(w.y), bfhi(w.y)}; }
__device__ __forceinline__ float fsigmoid(float x) { return __builtin_amdgcn_rcpf(1.f + __expf(-x)); }
__device__ __forceinline__ float fsilu(float x) { return x * fsigmoid(x); }
__device__ __forceinline__ float fgelu_tanh(float x) { const float u = 0.7978845608028654f * (x + 0.044715f * x * x * x); return x * fsigmoid(2.f * u); }
__device__ __forceinline__ int launder(int v) { asm volatile("" : "+v"(v)); return v; }
__device__ __forceinline__ int lane_id_v() { int l; asm volatile("v_mbcnt_lo_u32_b32 %0, -1, 0\n\tv_mbcnt_hi_u32_b32 %0, -1, %0" : "=v"(l)); return l; }
__device__ __forceinline__ int bid_s() { const int b = *(volatile LAS int*)(uintptr_t)143368u; return __builtin_amdgcn_readfirstlane(b); }
__device__ __forceinline__ int wave_id_s() { return __builtin_amdgcn_readfirstlane(__builtin_amdgcn_workitem_id_x() >> 6); }
__device__ __forceinline__ unsigned char* karg_ptr(int off) {
#if defined(__HIP_DEVICE_COMPILE__)
    unsigned long long v; auto ka = __builtin_amdgcn_kernarg_segment_ptr();
    if (off == 256) asm volatile("s_load_dwordx2 %0, %1, 0x100\n\ts_waitcnt lgkmcnt(0)" : "=s"(v) : "s"(ka));
    else asm volatile("s_load_dwordx2 %0, %1, 0x108\n\ts_waitcnt lgkmcnt(0)" : "=s"(v) : "s"(ka));
    return (unsigned char*)v;
#else
    (void)off; return nullptr;
#endif
}
__device__ __forceinline__ int modidx(int r) { return r < NPROMPT ? 0 : 1 + ((r - NPROMPT) >> 12); }
__device__ __forceinline__ void rope_cs(float pos, float inv, float& c, float& s) {
    float rev = pos * inv * 0.15915494309189535f; rev -= rintf(rev);
    s = __builtin_amdgcn_sinf(rev); c = __builtin_amdgcn_cosf(rev);
}

namespace pg8 {
constexpr int BM = 256, BK = 64, HALF = 128, HTB = HALF * BK * 2, STAGE_BYTES = 8 * HTB, NXCD = 8, WGM = 8;
__host__ __device__ __forceinline__ int lds_byte(int r, int c) { const int st = (r >> 4) * 2 + (c >> 5), rr = r & 15, cc = c & 31, ob = rr * 64 + cc * 2; return st * 1024 + (ob ^ (((ob >> 9) & 1) << 5)); }
__host__ __device__ __forceinline__ void stage_rc(int b, int& R, int& C) { const int st = b / 1024, sb = b % 1024, swz = sb ^ (((sb >> 9) & 1) << 5); R = (st >> 1) * 16 + swz / 64; C = (st & 1) * 32 + (swz % 64) / 2; }
__host__ __device__ __forceinline__ int perm32(int rho) { const int n = rho >> 4, i = rho & 15; return 8 * (i >> 2) + 4 * n + (i & 3); }
struct Unit { int pm, pn, kq; };
struct Gemm { const bf16_t* A; const bf16_t* Bt; int M, N, K, lda, ldb, ash, astep; };
struct StaticOrder {
    int nM, nN, nwg, G, c, ks;
    __device__ void init(int M, int N, int G_, int c_, int ks_ = 0) { nM = M / BM; nN = N / BM; nwg = nM * nN; G = G_; c = c_; ks = ks_; }
    __device__ bool next(int i, Unit& u) const {
        if (ks) { if (i < 2) { const int j = i * 32 + (c >> 3), xx = c & 7; u.pm = 16 * xx + (j >> 2); u.pn = j & 3; u.kq = -1; return true; }
                  if (i == 2) { const int t = c >> 2; u.pm = 128 + (t >> 2); u.pn = t & 3; u.kq = c & 3; return true; } return false; }
        u.kq = -1;
        const int L = i * G + c; if (L >= nwg) return false;
        int wgid = L; { const int q = nwg / NXCD, r = nwg % NXCD, xcd = wgid % NXCD, off = wgid / NXCD; wgid = (xcd < r ? xcd * (q + 1) : r * (q + 1) + (xcd - r) * q) + off; }
        const int nig = WGM * nN, gid = wgid / nig, fm = gid * WGM, gsz = (nM - fm) < WGM ? (nM - fm) : WGM;
        u.pm = fm + ((wgid % nig) % gsz); u.pn = (wgid % nig) / gsz; return true;
    }
};

template <class Epi>
__device__ __forceinline__ void gemm_phase(LAS unsigned char* lds, const Gemm g, const StaticOrder& S, const Epi& E, const int wv) {
    const int wid = wv, lane = lane_id_v(), tid = wid * 64 + lane, wr = wid >> 2, wc = wid & 3, fr = lane & 15, fq = lane >> 4;
    int K_ = g.K; asm volatile("" : "+s"(K_));
    const int K = K_, nt = K / BK;
    unsigned voffA[2], voffB[2];
#pragma unroll
    for (int i = 0; i < 2; ++i) { int R, C; stage_rc(tid * 16 + i * 8192, R, C); const int Rb = Epi::PERM ? ((R & ~31) + perm32(R & 31)) : R;
        voffA[i] = (unsigned)(R * g.lda + C) * 2u; voffB[i] = (unsigned)(Rb * g.ldb + C) * 2u; }
    const unsigned kstep = (unsigned)(BK * 2);
    const unsigned hA = (unsigned)HALF * g.lda * 2u, hB = (unsigned)HALF * g.ldb * 2u, tA = 2u * hA, tB = 2u * hB;
    const unsigned ldsw = (unsigned)wid * 1024u;
    const int aoff = lds_byte(wr * 64 + fr, fq * 8), boff = lds_byte(wc * 32 + fr, fq * 8);
#define PG8_SA(b, h) (((b) * 2 + (h)) * HTB)
#define PG8_SB(b, h) ((4 + (b) * 2 + (h)) * HTB)
#define PG8_STAGE(bufoff, gbase, voff) do { _Pragma("unroll") for (int _i = 0; _i < 2; ++_i) \
        __builtin_amdgcn_global_load_lds((const unsigned*)((const char*)(gbase) + (voff)[_i]), (LAS unsigned*)(lds + (bufoff) + ldsw + _i * 8192), 16, 0, 0); } while (0)
#define PG8_LDA(dst, b, h) do { _Pragma("unroll") for (int m = 0; m < 4; ++m) _Pragma("unroll") for (int k = 0; k < 2; ++k) dst[m][k] = *(const LAS bf16x8*)(lds + PG8_SA(b, h) + aoff + m * 2048 + k * 1024); } while (0)
#define PG8_LDB(dst, b, h) do { _Pragma("unroll") for (int n = 0; n < 2; ++n) _Pragma("unroll") for (int k = 0; k < 2; ++k) dst[n][k] = *(const LAS bf16x8*)(lds + PG8_SB(b, h) + boff + n * 2048 + k * 1024); } while (0)
#define PG8_MMA(ai, bj, At, Bt) do { __builtin_amdgcn_s_setprio(1); _Pragma("unroll") for (int m = 0; m < 4; ++m) _Pragma("unroll") for (int n = 0; n < 2; ++n) _Pragma("unroll") for (int k = 0; k < 2; ++k) \
        acc[ai][bj][m][n] = __builtin_amdgcn_mfma_f32_16x16x32_bf16(Bt[n][k], At[m][k], acc[ai][bj][m][n], 0, 0, 0); __builtin_amdgcn_s_setprio(0); } while (0)
#define PG8_WAIT_V(n) asm volatile("s_waitcnt vmcnt(" #n ")" ::: "memory")
#define PG8_WAIT_L(n) asm volatile("s_waitcnt lgkmcnt(" #n ")" ::: "memory")
#define PG8_BAR __builtin_amdgcn_s_barrier()
#define PG8_SCHED __builtin_amdgcn_sched_barrier(0)
    Unit cur, nxt; int ui = 0;
    if (!S.next(0, cur)) return;
    f32x4 acc[2][2][4][2];
#pragma unroll
    for (int a = 0; a < 2; ++a)
#pragma unroll
        for (int b = 0; b < 2; ++b)
#pragma unroll
            for (int m = 0; m < 4; ++m)
#pragma unroll
                for (int n = 0; n < 2; ++n) acc[a][b][m][n] = (f32x4){0.f, 0.f, 0.f, 0.f};
    bf16x8 At[4][2], B0[2][2], B1[2][2];
    const int ntq = nt >> 2;
    int cnt = cur.kq >= 0 ? ntq : nt;
    const unsigned cko = cur.kq >= 0 ? (unsigned)(cur.kq * ntq) * kstep : 0u;
    const char* cA = (const char*)g.A + ((unsigned)cur.pm * tA + (unsigned)(cur.pn >> g.ash) * (unsigned)g.astep + cko);
    const char* cB = (const char*)g.Bt + ((unsigned)cur.pn * tB + cko);
    PG8_STAGE(PG8_SB(0, 0), cB, voffB); PG8_STAGE(PG8_SB(0, 1), cB + hB, voffB); PG8_STAGE(PG8_SA(0, 0), cA, voffA); PG8_STAGE(PG8_SA(0, 1), cA + hA, voffA);
    if (wr == 1) PG8_BAR;
    PG8_WAIT_V(2); PG8_BAR;
    PG8_STAGE(PG8_SB(1, 0), cB + kstep, voffB); PG8_STAGE(PG8_SA(1, 0), cA + kstep, voffA); PG8_STAGE(PG8_SB(1, 1), cB + hB + kstep, voffB);
    PG8_WAIT_V(6); PG8_BAR;
    for (;;) {
        const bool has_next = S.next(ui + 1, nxt);
        const unsigned nko = (has_next && nxt.kq >= 0) ? (unsigned)(nxt.kq * ntq) * kstep : 0u;
        const char* nA = has_next ? (const char*)g.A + ((unsigned)nxt.pm * tA + (unsigned)(nxt.pn >> g.ash) * (unsigned)g.astep + nko) : cA; const char* nB = has_next ? (const char*)g.Bt + ((unsigned)nxt.pn * tB + nko) : cB;
        for (int t = 0; t < cnt; t += 2) {
            const bool last = (t == cnt - 2);
            const char* a1 = cA + (unsigned)(t + 1) * kstep;
            const char* a2 = last ? nA : cA + (unsigned)(t + 2) * kstep; const char* b2 = last ? nB : cB + (unsigned)(t + 2) * kstep;
            const char* a3 = a2 + kstep; const char* b3 = b2 + kstep;
            PG8_LDB(B0, 0, 0); PG8_LDB(B1, 0, 1); PG8_SCHED; PG8_LDA(At, 0, 0); PG8_STAGE(PG8_SA(1, 1), a1 + hA, voffA);
            PG8_WAIT_V(8); PG8_WAIT_L(0); PG8_BAR; PG8_MMA(0, 0, At, B0); PG8_MMA(0, 1, At, B1); PG8_BAR; PG8_SCHED;
            PG8_LDA(At, 0, 1); PG8_STAGE(PG8_SB(0, 0), b2, voffB); PG8_STAGE(PG8_SB(0, 1), b2 + hB, voffB); PG8_STAGE(PG8_SA(0, 0), a2, voffA);
            PG8_WAIT_V(8); PG8_WAIT_L(0); PG8_BAR; PG8_MMA(1, 0, At, B0); PG8_MMA(1, 1, At, B1); PG8_BAR; PG8_SCHED;
            PG8_LDB(B0, 1, 0); PG8_LDB(B1, 1, 1); PG8_SCHED; PG8_LDA(At, 1, 0); PG8_STAGE(PG8_SA(0, 1), a2 + hA, voffA);
            PG8_WAIT_V(8); PG8_WAIT_L(0); PG8_BAR; PG8_MMA(0, 0, At, B0); PG8_MMA(0, 1, At, B1); PG8_BAR; PG8_SCHED;
            PG8_LDA(At, 1, 1); PG8_STAGE(PG8_SB(1, 0), b3, voffB); PG8_STAGE(PG8_SB(1, 1), b3 + hB, voffB); PG8_STAGE(PG8_SA(1, 0), a3, voffA);
            PG8_WAIT_V(8); PG8_WAIT_L(0); PG8_BAR; PG8_MMA(1, 0, At, B0); PG8_MMA(1, 1, At, B1); PG8_BAR; PG8_SCHED;
        }
        if (wr == 0) PG8_BAR;
        E(acc, cur, wr, wc, fr, fq);
        if (!has_next) break;
#pragma unroll
        for (int a = 0; a < 2; ++a)
#pragma unroll
            for (int b = 0; b < 2; ++b)
#pragma unroll
                for (int m = 0; m < 4; ++m)
#pragma unroll
                    for (int n = 0; n < 2; ++n) acc[a][b][m][n] = (f32x4){0.f, 0.f, 0.f, 0.f};
        cur = nxt; cA = nA; cB = nB; ++ui; cnt = cur.kq >= 0 ? ntq : nt;
        if (wr == 1) PG8_BAR;
    }
    PG8_WAIT_V(0);
    PG8_BAR;
#undef PG8_SA
#undef PG8_SB
#undef PG8_STAGE
#undef PG8_LDA
#undef PG8_LDB
#undef PG8_MMA
#undef PG8_WAIT_V
#undef PG8_WAIT_L
#undef PG8_BAR
#undef PG8_SCHED
}

template <int ACT> struct EpiStore {
    static constexpr bool PERM = true;
    bf16_t* O; int ldc;
    __device__ __forceinline__ void operator()(const f32x4 (&acc)[2][2][4][2], const Unit& u, int wr, int wc, int fr, int fq) const {
        fr = launder(fr); fq = launder(fq);
        const int row0 = u.pm * BM + wr * 64 + fr, col0 = u.pn * BM + wc * 32 + 8 * fq;
#pragma unroll
        for (int ai = 0; ai < 2; ++ai)
#pragma unroll
            for (int m = 0; m < 4; ++m) { bf16_t* rowp = O + (size_t)(row0 + ai * HALF + m * 16) * ldc + col0;
#pragma unroll
                for (int bj = 0; bj < 2; ++bj) { f32x4 v0 = acc[ai][bj][m][0], v1 = acc[ai][bj][m][1];
                    if (ACT == 2) {
#pragma unroll
                        for (int e = 0; e < 4; ++e) { const float a = fmaxf(v0[e], 0.f), b = fmaxf(v1[e], 0.f); v0[e] = a * a; v1[e] = b * b; } }
                    u32x4 w; w.x = cvt_pk_bf16(v0[0], v0[1]); w.y = cvt_pk_bf16(v0[2], v0[3]); w.z = cvt_pk_bf16(v1[0], v1[1]); w.w = cvt_pk_bf16(v1[2], v1[3]);
                    *(u32x4*)(rowp + bj * HALF) = w; } asm volatile("" ::: "memory"); }
    }
};
struct EpiResid {
    static constexpr bool PERM = true;
    float* x; const float* gate; float* part;
    __device__ __forceinline__ void operator()(const f32x4 (&acc)[2][2][4][2], const Unit& u, int wr, int wc, int fr, int fq) const {
        fr = launder(fr); fq = launder(fq);
        const int row0 = u.pm * BM + wr * 64 + fr, col0 = u.pn * BM + wc * 32 + 8 * fq;
        if (u.kq >= 0) {
#pragma unroll
            for (int ai = 0; ai < 2; ++ai)
#pragma unroll
                for (int m = 0; m < 4; ++m) { bf16_t* rowp = (bf16_t*)part + ((size_t)u.kq * 4096 + (row0 + ai * HALF + m * 16 - 32768)) * DM + col0;
#pragma unroll
                    for (int bj = 0; bj < 2; ++bj) { const f32x4 a0 = acc[ai][bj][m][0], a1 = acc[ai][bj][m][1];
                        u32x4 o; o.x = cvt_pk_bf16(a0[0], a0[1]); o.y = cvt_pk_bf16(a0[2], a0[3]); o.z = cvt_pk_bf16(a1[0], a1[1]); o.w = cvt_pk_bf16(a1[2], a1[3]); *(u32x4*)(rowp + bj * HALF) = o; } }
            return;
        }
        const float* gp = gate + (size_t)modidx(u.pm * BM) * 6144 + col0;
        f32x4 gv[2][2];
#pragma unroll
        for (int bj = 0; bj < 2; ++bj)
#pragma unroll
            for (int n = 0; n < 2; ++n) gv[bj][n] = *(const f32x4*)(gp + bj * HALF + 4 * n);
#pragma unroll
        for (int ai = 0; ai < 2; ++ai) {
            u32x4 xw[4][2];
#pragma unroll
            for (int m = 0; m < 4; ++m)
#pragma unroll
                for (int bj = 0; bj < 2; ++bj) xw[m][bj] = *(const u32x4*)((const bf16_t*)x + (size_t)(row0 + ai * HALF + m * 16) * 2048 + col0 + bj * HALF);
#pragma unroll
            for (int m = 0; m < 4; ++m)
#pragma unroll
                for (int bj = 0; bj < 2; ++bj) { const u32x4 w = xw[m][bj];
                    const f32x4 xa = (f32x4){bflo(w.x), bfhi(w.x), bflo(w.y), bfhi(w.y)} + gv[bj][0] * acc[ai][bj][m][0], xb = (f32x4){bflo(w.z), bfhi(w.z), bflo(w.w), bfhi(w.w)} + gv[bj][1] * acc[ai][bj][m][1];
                    u32x4 o; o.x = cvt_pk_bf16(xa[0], xa[1]); o.y = cvt_pk_bf16(xa[2], xa[3]); o.z = cvt_pk_bf16(xb[0], xb[1]); o.w = cvt_pk_bf16(xb[2], xb[3]);
                    *(u32x4*)((bf16_t*)x + (size_t)(row0 + ai * HALF + m * 16) * 2048 + col0 + bj * HALF) = o; }
            asm volatile("" ::: "memory"); }
    }
};
__device__ __forceinline__ void st4(bf16_t* p, const f32x4 v) { u32x2 w; w.x = cvt_pk_bf16(v[0], v[1]); w.y = cvt_pk_bf16(v[2], v[3]); *(u32x2*)p = w; }
struct EpiAttnQKV {
    static constexpr bool PERM = false;
    bf16_t *q, *k, *v; float *nk, *nv; const float *qg, *kg; int slot;
    __device__ __forceinline__ void operator()(const f32x4 (&acc)[2][2][4][2], const Unit& u, int wr, int wc, int fr, int fq) const {
        fr = launder(fr); fq = launder(fq);
        const int pn = u.pn;
#pragma unroll
        for (int ai = 0; ai < 2; ++ai)
#pragma unroll
            for (int m = 0; m < 4; ++m) {
                const int r = u.pm * BM + ai * HALF + wr * 64 + m * 16 + fr;
                f32x4 v00 = acc[ai][0][m][0], v01 = acc[ai][0][m][1], v10 = acc[ai][1][m][0], v11 = acc[ai][1][m][1];
                if (pn < 5) {
                    float ss = 0.f;
#pragma unroll
                    for (int e = 0; e < 4; ++e) ss += v00[e] * v00[e] + v01[e] * v01[e] + v10[e] * v10[e] + v11[e] * v11[e];
                    ss += __shfl_xor(ss, 16); ss += __shfl_xor(ss, 32);
                    const float rs = rsqrtf(ss * (1.f / 64.f) + 1e-6f);
                    const float* gn = (pn < 4 ? qg : kg) + 4 * fq;
                    v00 = v00 * rs * *(const f32x4*)(gn); v01 = v01 * rs * *(const f32x4*)(gn + 16); v10 = v10 * rs * *(const f32x4*)(gn + 32); v11 = v11 * rs * *(const f32x4*)(gn + 48);
                    if (r >= NPROMPT) {
                        const int t = (r - NPROMPT) & 4095; const float rp = (float)(t >> 6), cp = (float)(t & 63);
#pragma unroll
                        for (int e = 0; e < 4; ++e) {
                            const float inv = __builtin_amdgcn_exp2f(-(float)(4 * fq + e) * (13.287712379549449f / 16.f)); float c, s;
                            rope_cs(rp, inv, c, s); { const float x1 = v00[e], x2 = v01[e]; v00[e] = x1 * c - x2 * s; v01[e] = x2 * c + x1 * s; }
                            rope_cs(cp, inv, c, s); { const float x1 = v10[e], x2 = v11[e]; v10[e] = x1 * c - x2 * s; v11[e] = x2 * c + x1 * s; }
                        }
                    }
                }
                if (pn < 4) {
                    bf16_t* d = q + (size_t)r * 1024 + (4 * pn + wc) * 64 + 4 * fq;
                    constexpr float QS = 0.125f * LOG2E; st4(d, v00 * QS); st4(d + 16, v01 * QS); st4(d + 32, v10 * QS); st4(d + 48, v11 * QS);
                } else {
                    bf16_t* d = (pn == 4 ? k : v) + (size_t)r * 256 + wc * 64 + 4 * fq;
                    st4(d, v00); st4(d + 16, v01); st4(d + 32, v10); st4(d + 48, v11);
                    if (r < NPROMPT) { const int b = r >> 8, t = r & 255; float* o = (pn == 4 ? nk : nv) + ((size_t)(b * 2 + slot) * 256 + t) * 256 + wc * 64 + 4 * fq;
                        *(f32x4*)o = v00; *(f32x4*)(o + 16) = v01; *(f32x4*)(o + 32) = v10; *(f32x4*)(o + 48) = v11; }
                }
            }
    }
};
struct EpiRetQKV {
    static constexpr bool PERM = false;
    bf16_t *q, *k, *v;
    __device__ __forceinline__ void operator()(const f32x4 (&acc)[2][2][4][2], const Unit& u, int wr, int wc, int fr, int fq) const {
        fr = launder(fr); fq = launder(fq);
        const int pn = u.pn;
#pragma unroll
        for (int ai = 0; ai < 2; ++ai)
#pragma unroll
            for (int m = 0; m < 4; ++m) {
                const int r = u.pm * BM + ai * HALF + wr * 64 + m * 16 + fr;
                f32x4 v00 = acc[ai][0][m][0], v01 = acc[ai][0][m][1], v10 = acc[ai][1][m][0], v11 = acc[ai][1][m][1];
                if (pn < 8) {
                    if (r >= NPROMPT) {
                        const int t = (r - NPROMPT) & 4095; const float rp = (float)(t >> 6), cp = (float)(t & 63);
#pragma unroll
                        for (int e = 0; e < 4; ++e) {
                            const float inv = __builtin_amdgcn_exp2f(-(float)(16 * wc + 4 * fq + e) * (13.287712379549449f / 64.f)); float c, s;
                            rope_cs(rp, inv, c, s); { const float x1 = v00[e], x2 = v01[e]; v00[e] = x1 * c - x2 * s; v01[e] = x2 * c + x1 * s; }
                            rope_cs(cp, inv, c, s); { const float x1 = v10[e], x2 = v11[e]; v10[e] = x1 * c - x2 * s; v11[e] = x2 * c + x1 * s; }
                        }
                    }
                    if (pn >= 4) { v00 = v00 * 0.0625f; v01 = v01 * 0.0625f; v10 = v10 * 0.0625f; v11 = v11 * 0.0625f; }
                }
                bf16_t* d = (pn < 4 ? q + (size_t)r * 1024 + pn * 256 : pn < 8 ? k + (size_t)r * 1024 + (pn - 4) * 256 : v + (size_t)r * 2048 + (pn - 8) * 256) + 16 * wc + 4 * fq;
                st4(d, v00); st4(d + 64, v01); st4(d + 128, v10); st4(d + 192, v11);
            }
    }
};
template <int MODE> struct EpiLateGate {
    static constexpr bool PERM = true;
    bf16_t* Z; int ldz; const float* fin; const float* gn;
    __device__ __forceinline__ void operator()(const f32x4 (&acc)[2][2][4][2], const Unit& u, int wr, int wc, int fr, int fq) const {
        fr = launder(fr); fq = launder(fq);
        const int row0 = u.pm * BM + wr * 64 + fr, col0 = u.pn * BM + wc * 32 + 8 * fq;
#pragma unroll
        for (int ai = 0; ai < 2; ++ai) {
            u32x4 zq[4][2];
#pragma unroll
            for (int m = 0; m < 4; ++m)
#pragma unroll
                for (int bj = 0; bj < 2; ++bj) zq[m][bj] = *(const u32x4*)(Z + (size_t)(row0 + ai * HALF + m * 16) * ldz + col0 + bj * HALF);
#pragma unroll
            for (int m = 0; m < 4; ++m) { const int r = row0 + ai * HALF + m * 16;
#pragma unroll
                for (int bj = 0; bj < 2; ++bj) { const int c0 = col0 + bj * HALF; bf16_t* zp = Z + (size_t)r * ldz + c0;
                    const u32x4 zw = zq[m][bj]; float z[8] = {bflo(zw.x), bfhi(zw.x), bflo(zw.y), bfhi(zw.y), bflo(zw.z), bfhi(zw.z), bflo(zw.w), bfhi(zw.w)};
                    float a[8]; { const f32x4 a0 = acc[ai][bj][m][0], a1 = acc[ai][bj][m][1]; a[0] = a0[0]; a[1] = a0[1]; a[2] = a0[2]; a[3] = a0[3]; a[4] = a1[0]; a[5] = a1[1]; a[6] = a1[2]; a[7] = a1[3]; }
                    float y[8];
                    if (MODE == 0) { const f32x2 st = *(const f32x2*)(fin + ((size_t)r * 4 + (c0 >> 9)) * 2); const f32x4 g0 = *(const f32x4*)(gn + c0), g1 = *(const f32x4*)(gn + c0 + 4);
                        const float gg[8] = {g0[0], g0[1], g0[2], g0[3], g1[0], g1[1], g1[2], g1[3]};
#pragma unroll
                        for (int e = 0; e < 8; ++e) y[e] = fsilu(a[e]) * ((z[e] - st.x) * st.y * gg[e]);
                    } else {
#pragma unroll
                        for (int e = 0; e < 8; ++e) y[e] = fgelu_tanh(a[e]) * z[e];
                    }
                    u32x4 w; w.x = cvt_pk_bf16(y[0], y[1]); w.y = cvt_pk_bf16(y[2], y[3]); w.z = cvt_pk_bf16(y[4], y[5]); w.w = cvt_pk_bf16(y[6], y[7]);
                    *(u32x4*)zp = w; } }
            asm volatile("" ::: "memory"); }
    }
};
struct EpiLruGates {
    static constexpr bool PERM = false;
    const bf16_t* xc; bf16_t *la, *uu; const float *br, *bi, *lam;
    __device__ __forceinline__ void operator()(const f32x4 (&acc)[2][2][4][2], const Unit& u, int wr, int wc, int fr, int fq) const {
        fr = launder(fr); fq = launder(fq);
        const int nb = u.pn >> 1, dir = u.pn & 1;
#pragma unroll
        for (int bj = 0; bj < 2; ++bj) {
            const int ch = nb * 128 + 64 * bj + 16 * wc + 4 * fq;
            const f32x4 brv = *(const f32x4*)(br + dir * 1024 + ch), biv = *(const f32x4*)(bi + dir * 1024 + ch), lv = *(const f32x4*)(lam + dir * 1024 + ch);
            f32x4 sp;
#pragma unroll
            for (int e = 0; e < 4; ++e) sp[e] = -8.f * __logf(1.f + __expf(-lv[e]));
            u32x2 xq[2][4];
#pragma unroll
            for (int ai = 0; ai < 2; ++ai)
#pragma unroll
                for (int m = 0; m < 4; ++m) xq[ai][m] = *(const u32x2*)(xc + (size_t)(u.pm * BM + ai * HALF + wr * 64 + m * 16 + fr) * 1024 + ch);
#pragma unroll
            for (int ai = 0; ai < 2; ++ai)
#pragma unroll
                for (int m = 0; m < 4; ++m) {
                    const int r = u.pm * BM + ai * HALF + wr * 64 + m * 16 + fr;
                    const u32x2 xw = xq[ai][m]; const float xv[4] = {bflo(xw.x), bfhi(xw.x), bflo(xw.y), bfhi(xw.y)};
                    const f32x4 rp = acc[ai][bj][m][0], ip = acc[ai][bj][m][1]; f32x4 lo, uo;
#pragma unroll
                    for (int e = 0; e < 4; ++e) { const float pa = 1.f + __expf(-(rp[e] + brv[e])), pb = 1.f + __expf(-(ip[e] + biv[e])); const float inv = __builtin_amdgcn_rcpf(pa * pb);
                        const float rg = pb * inv, ig = pa * inv; const float l = rg * sp[e]; lo[e] = l; uo[e] = __builtin_amdgcn_sqrtf(fmaxf(1.f - __expf(2.f * l), 0.f)) * ig * xv[e]; }
                    st4(la + ((size_t)r * 2 + dir) * 1024 + ch, lo); st4(uu + ((size_t)r * 2 + dir) * 1024 + ch, uo);
                    asm volatile("" ::: "memory");
                }
        }
    }
};
}
using pg8::st4;

struct KArgs { const float* in[32]; float* out; unsigned char* ws; };
struct KTab { const float* const* t; };
__device__ __forceinline__ const float* inp(const KTab& a, int k) { return a.t[k]; }
__device__ __forceinline__ const float* inp(const KArgs& a, int k) { return a.in[k]; }

__device__ __forceinline__ float wave_sum(float v) {
#pragma unroll
    for (int o = 1; o < 64; o <<= 1) v += __shfl_xor(v, o);
    return v;
}
__device__ __forceinline__ float wave_max(float v) {
#pragma unroll
    for (int o = 1; o < 64; o <<= 1) v = fmaxf(v, __shfl_xor(v, o));
    return v;
}

template <int MODE>
__device__ __forceinline__ const float* wcol(const float* s0, const float* s1, int n) {
    if (MODE == 0) return s0 + n;
    if (MODE == 1) { const int gp = (n >> 5) & 7, bj = gp >> 2, wc = gp & 3; return s0 + (n & ~255) + (2 * wc + bj) * 32 + (n & 31); }
    if (MODE == 2) { const int p = n & 255, bj = p >> 7, wc = (p >> 5) & 3, nn = (p >> 4) & 1, r = p & 15; return s0 + (n & ~255) + 128 * bj + 64 * nn + 16 * wc + r; }
    { const int pn = n >> 8, nb = pn >> 1, dir = pn & 1, p = n & 255, bj = p >> 7, wc = (p >> 5) & 3, nn = (p >> 4) & 1, r = p & 15; const int cb = 64 * bj + 16 * wc + r;
      return (nn ? s1 : s0) + (size_t)(dir * 8 + nb) * 16384 + cb; }
}
template <int MODE>
__device__ __forceinline__ void wconv(const float* s0, const float* s1, int ld, int K, int N, bf16_t* WT, LAS float* scr, int lane_, int gw, int NGW) {
    const int lane = lane_id_v(); (void)lane_; asm volatile("" : "+s"(gw));
    const int nblk = N / 32, nitems = (K / 64) * nblk;
    for (int item = gw; item < nitems; item += NGW) {
        const int kb = item / nblk, nb = item % nblk, k0 = 64 * kb, n0 = 32 * nb;
        const float* cp = wcol<MODE>(s0, s1, n0 + (lane & 31));
#pragma unroll 8
        for (int i = 0; i < 32; ++i) { const int kk = 2 * i + (lane >> 5); scr[kk * 33 + (lane & 31)] = cp[(size_t)(k0 + kk) * ld]; }
        asm volatile("s_waitcnt lgkmcnt(0)" ::: "memory");
        const int c = lane & 7;
#pragma unroll
        for (int j = 0; j < 4; ++j) { const int n = (lane >> 3) + 8 * j; const LAS float* s = scr + (8 * c) * 33 + n;
            u32x4 o; o.x = cvt_pk_bf16(s[0 * 33], s[1 * 33]); o.y = cvt_pk_bf16(s[2 * 33], s[3 * 33]); o.z = cvt_pk_bf16(s[4 * 33], s[5 * 33]); o.w = cvt_pk_bf16(s[6 * 33], s[7 * 33]);
            *(u32x4*)(WT + (size_t)(n0 + n) * K + k0 + 8 * c) = o; }
        asm volatile("s_waitcnt lgkmcnt(0)" ::: "memory");
    }
}
template <class AT>
__device__ __forceinline__ void convert_layer_weights(const AT& a, unsigned char* ws, int layer, LAS unsigned char* lds, int wave, int lane, int gw, int NGW) {
    LAS float* scr = (LAS float*)(lds + wave * 8448);
    wconv<0>(inp(a, 12) + (size_t)layer * DM * DFF, nullptr, DFF, DM, DFF, (bf16_t*)(ws + WS_WUP), scr, lane, gw, NGW);
    wconv<0>(inp(a, 13) + (size_t)layer * DFF * DM, nullptr, DM, DFF, DM, (bf16_t*)(ws + WS_WDN), scr, lane, gw, NGW);
    const int kind = layer % 3, slot = layer / 3;
    if (kind == 0) {
        wconv<1>(inp(a, 14) + (size_t)slot * DM * 1536, nullptr, 1536, DM, 1536, (bf16_t*)(ws + WS_WIN), scr, lane, gw, NGW);
        wconv<0>(inp(a, 15) + (size_t)slot * DM * DM, nullptr, DM, DM, DM, (bf16_t*)(ws + WS_WOUT), scr, lane, gw, NGW);
    } else if (kind == 1) {
        wconv<2>(inp(a, 19) + (size_t)slot * DM * 6144, nullptr, 6144, DM, 4096, (bf16_t*)(ws + WS_WIN), scr, lane, gw, NGW);
        wconv<0>(inp(a, 19) + (size_t)slot * DM * 6144 + 4096, nullptr, 6144, DM, 2048, (bf16_t*)(ws + WS_WX), scr, lane, gw, NGW);
        wconv<0>(inp(a, 20) + (size_t)slot * 2048 * DM, nullptr, DM, 2048, DM, (bf16_t*)(ws + WS_WOUT), scr, lane, gw, NGW);
    } else {
        wconv<0>(inp(a, 23) + (size_t)slot * DM * 2048 + 1024, nullptr, 2048, DM, 1024, (bf16_t*)(ws + WS_WIN), scr, lane, gw, NGW);
        wconv<0>(inp(a, 23) + (size_t)slot * DM * 2048, nullptr, 2048, DM, 1024, (bf16_t*)(ws + WS_WX), scr, lane, gw, NGW);
        wconv<3>(inp(a, 26) + (size_t)slot * 2 * 8 * 16384, inp(a, 28) + (size_t)slot * 2 * 8 * 16384, 128, 128, 4096, (bf16_t*)(ws + WS_WX2), scr, lane, gw, NGW);
        wconv<0>(inp(a, 31) + (size_t)slot * DM * DM, nullptr, DM, DM, DM, (bf16_t*)(ws + WS_WOUT), scr, lane, gw, NGW);
    }
}

__device__ __forceinline__ void mod_phase(const KArgs& a, LAS unsigned char* lds, const int wv) {
    LAS float* sc = (LAS float*)lds;
    LAS float* red = (LAS float*)(lds + 36864);
    const int tid = (wv * 64 + lane_id_v());
    if (bid_s() >= 384) return;
    for (int i = tid; i < 9 * 1024; i += 512) { const int j = i >> 10, k = i & 1023; const float v = j == 0 ? inp(a, 7)[k] : inp(a, 6)[(j - 1) * 1024 + k]; sc[i] = fsilu(v); }
    __syncthreads();
    float* modt = (float*)(a.ws + WS_MOD);
    const int cl = tid & 63, ks = tid >> 6;
    for (int item = bid_s(); item < 384; item += gridDim.x) {
        const int l = item / 96, cg_ = item % 96, col = cg_ * 64 + cl;
        const float* w = inp(a, 10) + (size_t)l * DM * 6144 + col;
        float acc[9];
#pragma unroll
        for (int j = 0; j < 9; ++j) acc[j] = 0.f;
        for (int k0 = ks * 128; k0 < ks * 128 + 128; k0 += 16) {
            float wv[16];
#pragma unroll
            for (int u = 0; u < 16; ++u) wv[u] = w[(size_t)(k0 + u) * 6144];
#pragma unroll
            for (int u = 0; u < 16; ++u)
#pragma unroll
                for (int j = 0; j < 9; ++j) acc[j] += sc[j * 1024 + k0 + u] * wv[u];
        }
#pragma unroll
        for (int j = 0; j < 9; ++j) red[(ks * 9 + j) * 64 + cl] = acc[j];
        __syncthreads();
        for (int idx = tid; idx < 576; idx += 512) { const int j = idx >> 6, c2 = idx & 63; float s = inp(a, 11)[(size_t)l * 6144 + cg_ * 64 + c2];
#pragma unroll
            for (int q = 0; q < 8; ++q) s += red[(q * 9 + j) * 64 + c2];
            modt[((size_t)l * 9 + j) * 6144 + cg_ * 64 + c2] = s; }
        __syncthreads();
    }
}
__device__ __forceinline__ void cache_phase(const KArgs& a, const int wv) {
    const size_t n4 = (size_t)8 * 2 * 512 * 256 / 4;
    for (size_t i = (size_t)bid_s() * 512 + (wv * 64 + lane_id_v()); i < 2 * n4; i += (size_t)gridDim.x * 512) {
        const bool isv = i >= n4; const size_t j = isv ? i - n4 : i;
        const f32x4 v = *(const f32x4*)((isv ? inp(a, 3) : inp(a, 2)) + j * 4);
        st4((bf16_t*)(a.ws + (isv ? WS_CV : WS_CK)) + j * 4, v);
    }
}
template <bool FIRST>
__device__ __forceinline__ void norm_phase(const float* xp_, const float* xs_, float* xres, const float* gain, const float* modl, int sh_chunk, bf16_t* hout, int lane_, int gw, int NGW, const float* part = nullptr, const float* fixgate = nullptr) {
    const int lane = lane_id_v(); (void)lane_; asm volatile("" : "+s"(gw));
    for (int r = gw; r < MTOK; r += NGW) {
        const float* xr = FIRST ? (r < NPROMPT ? xp_ + (size_t)r * DM : xs_ + (size_t)(r - NPROMPT) * DM) : nullptr;
        bf16_t* xb = (bf16_t*)xres + (size_t)r * 2048;
        f32x4 v[4]; float s = 0.f;
#pragma unroll
        for (int j = 0; j < 4; ++j) {
            if (FIRST) v[j] = *(const f32x4*)(xr + 4 * lane + 256 * j);
            else { const u32x2 w = *(const u32x2*)(xb + 4 * lane + 256 * j); v[j] = (f32x4){bflo(w.x), bfhi(w.x), bflo(w.y), bfhi(w.y)}; }
            s += v[j][0] * v[j][0] + v[j][1] * v[j][1] + v[j][2] * v[j][2] + v[j][3] * v[j][3]; }
        if (FIRST) {
#pragma unroll
            for (int j = 0; j < 4; ++j) st4(xb + 4 * lane + 256 * j, v[j]);
        }
        if (!FIRST && part != nullptr && r >= 32768) {
            const float* gp = fixgate + (size_t)modidx(r) * 6144; s = 0.f;
#pragma unroll
            for (int j = 0; j < 4; ++j) { const int c = 4 * lane + 256 * j; const bf16_t* pp = (const bf16_t*)part + (size_t)(r - 32768) * DM + c;
                const f32x4 ps = ((ld4bf(pp) + ld4bf(pp + (size_t)4096 * DM)) + ld4bf(pp + (size_t)2 * 4096 * DM)) + ld4bf(pp + (size_t)3 * 4096 * DM);
                v[j] = v[j] + *(const f32x4*)(gp + c) * ps; st4(xb + c, v[j]);
                s += v[j][0] * v[j][0] + v[j][1] * v[j][1] + v[j][2] * v[j][2] + v[j][3] * v[j][3]; }
        }
        const float rs = rsqrtf(wave_sum(s) * (1.f / DM) + 1e-6f);
        const float* mp = modl + (size_t)modidx(r) * 6144 + sh_chunk * 1024;
#pragma unroll
        for (int j = 0; j < 4; ++j) { const int c = 4 * lane + 256 * j; const f32x4 g = *(const f32x4*)(gain + c), sh = *(const f32x4*)(mp + c), sc = *(const f32x4*)(mp + 1024 + c);
            const f32x4 y = v[j] * rs * g * (1.f + sc) + sh; st4(hout + (size_t)r * DM + c, y); }
    }
}

__device__ __forceinline__ bf16x8 tr8(const LAS bf16_t* p0, const LAS bf16_t* p1) {
    const s16x4 a = __builtin_amdgcn_ds_read_tr16_b64_v4i16((LAS s16x4*)p0);
    const s16x4 b = __builtin_amdgcn_ds_read_tr16_b64_v4i16((LAS s16x4*)p1);
    return (bf16x8){a[0], a[1], a[2], a[3], b[0], b[1], b[2], b[3]};
}
__device__ __forceinline__ f32x16 mfma32(bf16x8 a, bf16x8 b, f32x16 c) { return __builtin_amdgcn_mfma_f32_32x32x16_bf16(a, b, c, 0, 0, 0); }
__device__ __forceinline__ f32x4 mfma16(bf16x8 a, bf16x8 b, f32x4 c) { return __builtin_amdgcn_mfma_f32_16x16x32_bf16(a, b, c, 0, 0, 0); }
__device__ __forceinline__ float fexp2(float x) { return __builtin_amdgcn_exp2f(x); }

__device__ __forceinline__ void att_tile(const LAS bf16_t* Ks, const LAS bf16_t* Vs, const bf16x8 (&Qf)[2][4], f32x16 (&ot)[2][2], float (&mrun)[2], float (&lrun)[2],
                                         bool skipw, bool needmask, int kpos0, int qpos0, int l31, int lh, int q4, int p4, int blk) {
            if (!skipw) {
                f32x16 sc[2][2];
#pragma unroll
                for (int cb = 0; cb < 2; ++cb)
#pragma unroll
                    for (int kk = 0; kk < 2; ++kk)
#pragma unroll
                        for (int r = 0; r < 16; ++r) sc[cb][kk][r] = 0.f;
#pragma unroll
                for (int s = 0; s < 4; ++s) {
                    const bf16x8 k0 = *(const LAS bf16x8*)(Ks + l31 * 72 + 16 * s + 8 * lh), k1 = *(const LAS bf16x8*)(Ks + (32 + l31) * 72 + 16 * s + 8 * lh);
                    sc[0][0] = mfma32(k0, Qf[0][s], sc[0][0]); sc[0][1] = mfma32(k1, Qf[0][s], sc[0][1]);
                    sc[1][0] = mfma32(k0, Qf[1][s], sc[1][0]); sc[1][1] = mfma32(k1, Qf[1][s], sc[1][1]);
                }
                bf16x8 pf[2][2][2];
#pragma unroll
                for (int cb = 0; cb < 2; ++cb) {
                    const int qpos = qpos0 + cb * 32 + l31;
                    float mx = -3.0e38f;
                    if (needmask) {
#pragma unroll
                        for (int r = 0; r < 16; ++r) { const int d0 = kpos0 + (r & 3) + 8 * (r >> 2) + 4 * lh - qpos, d1 = d0 + 32;
                            if (d0 > 128 || d0 < -128) sc[cb][0][r] = -1e30f; if (d1 > 128 || d1 < -128) sc[cb][1][r] = -1e30f; }
                    }
#pragma unroll
                    for (int r = 0; r < 16; ++r) mx = fmaxf(mx, fmaxf(sc[cb][0][r], sc[cb][1][r]));
                    mx = fmaxf(mx, __shfl_xor(mx, 32));
                    const float mnew = fmaxf(mrun[cb], mx), alpha = fexp2(mrun[cb] - mnew); mrun[cb] = mnew;
                    float ls = 0.f;
#pragma unroll
                    for (int r = 0; r < 16; ++r) { sc[cb][0][r] = fexp2(sc[cb][0][r] - mnew); sc[cb][1][r] = fexp2(sc[cb][1][r] - mnew); ls += sc[cb][0][r] + sc[cb][1][r]; }
                    lrun[cb] = lrun[cb] * alpha + ls;
                    if (__builtin_amdgcn_ballot_w64(alpha != 1.f) != 0ull) { ot[0][cb] = ot[0][cb] * alpha; ot[1][cb] = ot[1][cb] * alpha; }
#pragma unroll
                    for (int kk = 0; kk < 2; ++kk)
#pragma unroll
                        for (int s2 = 0; s2 < 2; ++s2) {
                            u32x4 w0;
                            w0.x = cvt_pk_bf16(sc[cb][kk][8 * s2 + 0], sc[cb][kk][8 * s2 + 1]); w0.y = cvt_pk_bf16(sc[cb][kk][8 * s2 + 2], sc[cb][kk][8 * s2 + 3]);
                            w0.z = cvt_pk_bf16(sc[cb][kk][8 * s2 + 4], sc[cb][kk][8 * s2 + 5]); w0.w = cvt_pk_bf16(sc[cb][kk][8 * s2 + 6], sc[cb][kk][8 * s2 + 7]);
                            pf[cb][kk][s2] = __builtin_bit_cast(bf16x8, w0);
                        }
                }
#pragma unroll
                for (int db = 0; db < 2; ++db)
#pragma unroll
                    for (int kbk = 0; kbk < 2; ++kbk)
#pragma unroll
                        for (int s2 = 0; s2 < 2; ++s2) {
                            const LAS bf16_t* vp = Vs + (kbk * 32 + 16 * s2 + 4 * lh + q4) * 72 + 32 * db + 16 * blk + 4 * p4;
                            const bf16x8 vf = tr8(vp, vp + 8 * 72);
                            ot[db][0] = mfma32(vf, pf[0][kbk][s2], ot[db][0]);
                            ot[db][1] = mfma32(vf, pf[1][kbk][s2], ot[db][1]);
                        }
            }
}
__device__ __forceinline__ void attn_phase(LAS unsigned char* lds, const bf16_t* qb, const bf16_t* kb, const bf16_t* vb, const bf16_t* ck, const bf16_t* cv, bf16_t* ob, const float* sink, const int wv) {
    LAS bf16_t* Ks = (LAS bf16_t*)lds; LAS bf16_t* Vs = (LAS bf16_t*)(lds + 9216);
    const int wid = wv, lane = lane_id_v(), tid = wid * 64 + lane, g = wid >> 1, qh = wid & 1;
    const int l31 = lane & 31, lh = lane >> 5, q4 = (lane & 15) >> 2, p4 = lane & 3, blk = (lane >> 4) & 1;
    const int skey = tid >> 3, sdc = tid & 7;
    for (int it = bid_s(); it < 1152; it += gridDim.x) {
        int b, hk, seqrow0, T, qbase, nlat, latk0, nctx; bool masked;
        if (it < 1024) { b = it >> 7; const int n = (it >> 2) & 31; hk = it & 3; seqrow0 = NPROMPT + b * 4096; T = 4096; qbase = n * 128; nlat = 6; latk0 = qbase - 128; nctx = 8; masked = true; }
        else { const int i2 = it - 1024; b = i2 >> 3; hk = (i2 >> 1) & 3; seqrow0 = b * 256; T = 256; qbase = (i2 & 1) * 128; nlat = 4; latk0 = 0; nctx = 0; masked = false; }
        const int h = hk * 4 + g, qpos0 = qbase + 64 * qh, ntiles = nlat + nctx;
        bf16x8 Qf[2][4];
#pragma unroll
        for (int cb = 0; cb < 2; ++cb)
#pragma unroll
            for (int s = 0; s < 4; ++s) Qf[cb][s] = *(const bf16x8*)(qb + (size_t)(seqrow0 + qpos0 + cb * 32 + l31) * 1024 + h * 64 + 16 * s + 8 * lh);
        float mrun[2], lrun[2]; f32x16 ot[2][2];
        const float sk = sink[h] * LOG2E;
        mrun[0] = sk; mrun[1] = sk; lrun[0] = lh == 0 ? 1.f : 0.f; lrun[1] = lrun[0];
#pragma unroll
        for (int i = 0; i < 2; ++i)
#pragma unroll
            for (int j = 0; j < 2; ++j)
#pragma unroll
                for (int r = 0; r < 16; ++r) ot[i][j][r] = 0.f;
        int ti = 0; while (ti < nlat && latk0 + 64 * ti < 0) ++ti;
        u32x4 kr0, vr0, kr1, vr1;
#define ATT_NEXT(tt) (((tt) + 1 < nlat && latk0 + 64 * ((tt) + 1) >= T) ? nlat : (tt) + 1)
#define ATT_LD(tt, KR, VR) do { const bf16_t *kp_, *vp_; if ((tt) < nlat) { const size_t o_ = (size_t)(seqrow0 + latk0 + 64 * (tt) + skey) * 256 + hk * 64 + sdc * 8; kp_ = kb + o_; vp_ = vb + o_; } \
            else { const size_t o_ = ((size_t)b * 1024 + 64 * ((tt) - nlat) + skey) * 256 + hk * 64 + sdc * 8; kp_ = ck + o_; vp_ = cv + o_; } KR = *(const u32x4*)kp_; VR = *(const u32x4*)vp_; } while (0)
#define ATT_FLAGS(cur_, SK, NM, KP) const bool SK##l_ = (cur_) < nlat; const int KP = latk0 + 64 * (cur_); bool SK = false, NM = false; \
            if (masked && SK##l_) { SK = (KP > qpos0 + 63 + 128) || (KP + 63 < qpos0 - 128); NM = (KP < qpos0 - 64) || (KP > qpos0 + 64); }
        int tp = ti, tq = ATT_NEXT(tp);
        ATT_LD(tp, kr0, vr0); ATT_LD(tq, kr1, vr1);
        while (tp < ntiles) {
            __syncthreads();
            *(LAS u32x4*)(Ks + skey * 72 + sdc * 8) = kr0; *(LAS u32x4*)(Vs + skey * 72 + sdc * 8) = vr0;
            *(LAS u32x4*)(Ks + 9216 + skey * 72 + sdc * 8) = kr1; *(LAS u32x4*)(Vs + 9216 + skey * 72 + sdc * 8) = vr1;
            __syncthreads();
            const int c0 = tp, c1 = tq;
            tp = ATT_NEXT(tq); tq = ATT_NEXT(tp);
            if (tp < ntiles) { ATT_LD(tp, kr0, vr0); ATT_LD(tq, kr1, vr1); }
            { ATT_FLAGS(c0, sk0, nm0, kp0) att_tile(Ks, Vs, Qf, ot, mrun, lrun, sk0, nm0, kp0, qpos0, l31, lh, q4, p4, blk); }
            { ATT_FLAGS(c1, sk1, nm1, kp1) att_tile(Ks + 9216, Vs + 9216, Qf, ot, mrun, lrun, sk1, nm1, kp1, qpos0, l31, lh, q4, p4, blk); }
        }
#undef ATT_NEXT
#undef ATT_LD
#undef ATT_FLAGS
#pragma unroll
        for (int cb = 0; cb < 2; ++cb) {
            const float lt = lrun[cb] + __shfl_xor(lrun[cb], 32), inv = 1.f / lt;
            bf16_t* orow = ob + (size_t)(seqrow0 + qpos0 + cb * 32 + l31) * 1024 + h * 64;
#pragma unroll
            for (int db = 0; db < 2; ++db)
#pragma unroll
                for (int rg = 0; rg < 4; ++rg) { const f32x4 v = {ot[db][cb][4 * rg] * inv, ot[db][cb][4 * rg + 1] * inv, ot[db][cb][4 * rg + 2] * inv, ot[db][cb][4 * rg + 3] * inv};
                    st4(orow + db * 32 + 8 * rg + 4 * lh, v); }
        }
    }
}

__device__ __forceinline__ void ret_scan_phase(LAS unsigned char* lds, const bf16_t* qb, const bf16_t* kb, const bf16_t* vb, bf16_t* ob, float* statp, const float* logdec, const float* state_in, float* state_out, const int wv) {
    constexpr int QST = 264, VST = 72;
    LAS bf16_t* Qs = (LAS bf16_t*)lds; LAS bf16_t* Ks = (LAS bf16_t*)(lds + 33792); LAS bf16_t* ST = (LAS bf16_t*)(lds + 67584);
    LAS bf16_t* Vs0 = (LAS bf16_t*)(lds + 101376); LAS bf16_t* Vw = (LAS bf16_t*)(lds + 110592); LAS bf16_t* Ps = (LAS bf16_t*)(lds + 119808);
    const int w = wv, lane = lane_id_v(), tid = w * 64 + lane, c16 = lane & 15, g = lane >> 4, q4 = (lane & 15) >> 2, p4 = lane & 3;
    const int itl = w >> 1, eb = 2 * (w & 1);
    for (int rnd = 0; rnd < 3; ++rnd) {
        const int bid = bid_s(), xx = bid & 7, ss = bid >> 3;
        const bool samp = rnd == 0; const int gidx = (samp ? 0 : (rnd - 1) * 32) + xx * 4 + (ss >> 3); const int b = gidx >> 2, head = gidx & 3, sl = ss & 7;
        const int seqrow0 = samp ? NPROMPT + b * 4096 : b * 256, T = samp ? 4096 : 256, nc = T / 64;
        for (int dir = 0; dir < 2; ++dir) {
            const float lg2 = logdec[dir * 4 + head] * LOG2E;
            f32x4 sacc[2][4];
#pragma unroll
            for (int dd = 0; dd < 2; ++dd)
#pragma unroll
                for (int et = 0; et < 4; ++et)
#pragma unroll
                    for (int r = 0; r < 4; ++r)
                        sacc[dd][et][r] = samp ? state_in[((((size_t)b * 2 + dir) * 4 + head) * 256 + 32 * w + 16 * dd + 4 * g + r) * 512 + sl * 64 + 16 * et + c16] : 0.f;
            __syncthreads();
#pragma unroll
            for (int dd = 0; dd < 2; ++dd)
#pragma unroll
                for (int et = 0; et < 4; ++et) { u32x2 wv; wv.x = cvt_pk_bf16(sacc[dd][et][0], sacc[dd][et][1]); wv.y = cvt_pk_bf16(sacc[dd][et][2], sacc[dd][et][3]);
                    *(LAS u32x2*)(ST + (16 * et + c16) * QST + 32 * w + 16 * dd + 4 * g) = wv; }
            u32x4 qreg[4], kreg[4], vreg;
#define RET_LOAD(cc_) do { const int t0_ = 64 * (cc_); _Pragma("unroll") for (int p = 0; p < 4; ++p) { const int idx = tid + 512 * p, row = idx >> 5, ch = idx & 31; \
                const size_t o_ = (size_t)(seqrow0 + t0_ + row) * 1024 + head * 256 + ch * 8; qreg[p] = *(const u32x4*)(qb + o_); kreg[p] = *(const u32x4*)(kb + o_); } \
                vreg = *(const u32x4*)(vb + (size_t)(seqrow0 + t0_ + (tid >> 3)) * 2048 + head * 512 + sl * 64 + (tid & 7) * 8); } while (0)
            RET_LOAD(dir ? nc - 1 : 0);
            const float gC = fexp2(lg2 * 64.f);
            float dec[2][4];
#pragma unroll
            for (int x = 0; x < 2; ++x)
#pragma unroll
                for (int r = 0; r < 4; ++r) { const int i = itl * 16 + c16, j = (eb + x) * 16 + 4 * g + r; const int df = dir ? j - i : i - j; const bool ok = dir ? df > 0 : df >= 0; dec[x][r] = ok ? fexp2(lg2 * (float)df) : 0.f; }
            const float wq_c = fexp2(lg2 * (float)(dir ? 64 - (itl * 16 + c16) : (itl * 16 + c16) + 1));
            const float wsj_c = fexp2(lg2 * (float)(dir ? (tid >> 3) : 63 - (tid >> 3)));
            for (int cc = 0; cc < nc; ++cc) {
                const int c = dir ? nc - 1 - cc : cc, t0 = 64 * c;
                LAS bf16_t* Vs = Vs0 + (cc & 1) * 13824;
#pragma unroll
                for (int p = 0; p < 4; ++p) { const int idx = tid + 512 * p, row = idx >> 5, ch = idx & 31; *(LAS u32x4*)(Qs + row * QST + ch * 8) = qreg[p]; *(LAS u32x4*)(Ks + row * QST + ch * 8) = kreg[p]; }
                { const int row = tid >> 3, ch = tid & 7; *(LAS u32x4*)(Vs + row * VST + ch * 8) = vreg;
                  const float wsj = wsj_c; u32x4 sv;
                  sv.x = cvt_pk_bf16(bflo(vreg.x) * wsj, bfhi(vreg.x) * wsj); sv.y = cvt_pk_bf16(bflo(vreg.y) * wsj, bfhi(vreg.y) * wsj);
                  sv.z = cvt_pk_bf16(bflo(vreg.z) * wsj, bfhi(vreg.z) * wsj); sv.w = cvt_pk_bf16(bflo(vreg.w) * wsj, bfhi(vreg.w) * wsj);
                  *(LAS u32x4*)(Vw + row * VST + ch * 8) = sv; }
                __syncthreads();
                if (cc + 1 < nc) RET_LOAD(dir ? nc - 2 - cc : cc + 1);
                const int orow = seqrow0 + t0 + itl * 16 + c16; bf16_t* op = ob + (size_t)orow * 2048 + head * 512 + sl * 64 + 4 * g;
                u32x2 pw0 = {0u, 0u}, pw1 = {0u, 0u};
                if (dir) { pw0 = *(const u32x2*)(op + eb * 16); pw1 = *(const u32x2*)(op + (eb + 1) * 16); }
                bf16x8 qf[8];
#pragma unroll
                for (int ks = 0; ks < 8; ++ks) qf[ks] = *(const LAS bf16x8*)(Qs + (itl * 16 + c16) * QST + 32 * ks + 8 * g);
#pragma unroll
                for (int x = 0; x < 2; ++x) {
                    const int jt = eb + x; f32x4 pt = {0.f, 0.f, 0.f, 0.f};
#pragma unroll
                    for (int ks = 0; ks < 8; ++ks) pt = mfma16(*(const LAS bf16x8*)(Ks + (jt * 16 + c16) * QST + 32 * ks + 8 * g), qf[ks], pt);
                    const int i = itl * 16 + c16; f32x4 pv;
#pragma unroll
                    for (int r = 0; r < 4; ++r) pv[r] = pt[r] * dec[x][r];
                    u32x2 wv; wv.x = cvt_pk_bf16(pv[0], pv[1]); wv.y = cvt_pk_bf16(pv[2], pv[3]);
                    *(LAS u32x2*)(Ps + i * VST + jt * 16 + 4 * g) = wv;
                }
                f32x4 oc[2];
                { const float wq = wq_c;
#pragma unroll
                  for (int x = 0; x < 2; ++x) { const int et = eb + x; f32x4 o = {0.f, 0.f, 0.f, 0.f};
#pragma unroll
                      for (int ks = 0; ks < 8; ++ks) o = mfma16(*(const LAS bf16x8*)(ST + (et * 16 + c16) * QST + 32 * ks + 8 * g), qf[ks], o);
                      oc[x] = o * wq; } }
#pragma unroll
                for (int dd = 0; dd < 2; ++dd)
#pragma unroll
                    for (int et = 0; et < 4; ++et) sacc[dd][et] = sacc[dd][et] * gC;
#pragma unroll
                for (int ks = 0; ks < 2; ++ks) {
                    bf16x8 bfr[4];
#pragma unroll
                    for (int et = 0; et < 4; ++et) { const LAS bf16_t* vp = Vw + (32 * ks + 8 * g + q4) * VST + 16 * et + 4 * p4; bfr[et] = tr8(vp, vp + 4 * VST); }
#pragma unroll
                    for (int dd = 0; dd < 2; ++dd) { const LAS bf16_t* kp = Ks + (32 * ks + 8 * g + q4) * QST + 32 * w + 16 * dd + 4 * p4; const bf16x8 af = tr8(kp, kp + 4 * QST);
#pragma unroll
                        for (int et = 0; et < 4; ++et) sacc[dd][et] = mfma16(af, bfr[et], sacc[dd][et]); }
                }
                __syncthreads();
#pragma unroll
                for (int x = 0; x < 2; ++x) { const int et = eb + x;
#pragma unroll
                    for (int ks = 0; ks < 2; ++ks) { const LAS bf16_t* vp = Vs + (32 * ks + 8 * g + q4) * VST + 16 * et + 4 * p4;
                        oc[x] = mfma16(tr8(vp, vp + 4 * VST), *(const LAS bf16x8*)(Ps + (itl * 16 + c16) * VST + 32 * ks + 8 * g), oc[x]); } }
                { const int row = orow;
                  if (dir == 0) { st4(op + eb * 16, oc[0]); st4(op + (eb + 1) * 16, oc[1]); }
                  else { float s1 = 0.f, s2 = 0.f;
#pragma unroll
                      for (int x = 0; x < 2; ++x) { bf16_t* o2 = op + (eb + x) * 16; const u32x2 pw = x ? pw1 : pw0; f32x4 f = oc[x];
                          f[0] += bflo(pw.x); f[1] += bfhi(pw.x); f[2] += bflo(pw.y); f[3] += bfhi(pw.y); st4(o2, f);
                          s1 += f[0] + f[1] + f[2] + f[3]; s2 += f[0] * f[0] + f[1] * f[1] + f[2] * f[2] + f[3] * f[3]; }
                      s1 += __shfl_xor(s1, 16); s1 += __shfl_xor(s1, 32); s2 += __shfl_xor(s2, 16); s2 += __shfl_xor(s2, 32);
                      if (g == 0) *(f32x2*)(statp + (((size_t)row * 4 + head) * 16 + sl * 2 + (w & 1)) * 2) = (f32x2){s1, s2}; } }
#pragma unroll
                for (int dd = 0; dd < 2; ++dd)
#pragma unroll
                    for (int et = 0; et < 4; ++et) { u32x2 wv; wv.x = cvt_pk_bf16(sacc[dd][et][0], sacc[dd][et][1]); wv.y = cvt_pk_bf16(sacc[dd][et][2], sacc[dd][et][3]);
                        *(LAS u32x2*)(ST + (16 * et + c16) * QST + 32 * w + 16 * dd + 4 * g) = wv; }
            }
#undef RET_LOAD
            if (!samp) {
#pragma unroll
                for (int dd = 0; dd < 2; ++dd)
#pragma unroll
                    for (int et = 0; et < 4; ++et)
#pragma unroll
                        for (int r = 0; r < 4; ++r)
                            state_out[((((size_t)b * 2 + dir) * 4 + head) * 256 + 32 * w + 16 * dd + 4 * g + r) * 512 + sl * 64 + 16 * et + c16] = sacc[dd][et][r];
            }
        }
    }
}
__device__ __forceinline__ void ret_fin_phase(const float* statp, float* fin, const int wv) {
    for (int i = bid_s() * 512 + (wv * 64 + lane_id_v()); i < MTOK * 4; i += gridDim.x * 512) {
        float s1 = 0.f, s2 = 0.f;
#pragma unroll
        for (int p = 0; p < 16; ++p) { const f32x2 v = *(const f32x2*)(statp + ((size_t)i * 16 + p) * 2); s1 += v.x; s2 += v.y; }
        const float mu = s1 * (1.f / 512.f), var = fmaxf(s2 * (1.f / 512.f) - mu * mu, 0.f);
        *(f32x2*)(fin + (size_t)i * 2) = (f32x2){mu, rsqrtf(var + 1e-6f)};
    }
}

__device__ __forceinline__ void lru_conv_phase(const bf16_t* __restrict__ xr, bf16_t* __restrict__ xc, const float* __restrict__ cw, const float* __restrict__ cbias, const int wv) {
    for (size_t i = (size_t)bid_s() * 512 + (wv * 64 + lane_id_v()); i < (size_t)(MTOK / 8) * 128; i += (size_t)gridDim.x * 512) {
        const int r0 = (int)(i >> 7) * 8, c8 = (int)(i & 127) * 8;
        const int t0 = r0 < NPROMPT ? (r0 & 255) : ((r0 - NPROMPT) & 4095), T = r0 < NPROMPT ? 256 : 4096;
        u32x4 xw[11];
#pragma unroll
        for (int k = 0; k < 11; ++k) { const int tt = t0 - 2 + k; xw[k] = (u32x4){0u, 0u, 0u, 0u};
            if (tt >= 0 && tt < T) xw[k] = *(const u32x4*)(xr + (size_t)(r0 - 2 + k) * 1024 + c8); }
        f32x4 w0[4], w1[4];
#pragma unroll
        for (int jj = 0; jj < 4; ++jj) { w0[jj] = *(const f32x4*)(cw + jj * 1024 + c8); w1[jj] = *(const f32x4*)(cw + jj * 1024 + c8 + 4); }
        const f32x4 b0 = *(const f32x4*)(cbias + c8), b1 = *(const f32x4*)(cbias + c8 + 4);
#pragma unroll
        for (int rr = 0; rr < 8; ++rr) {
            f32x4 a0 = b0, a1 = b1;
#pragma unroll
            for (int jj = 0; jj < 4; ++jj) { const u32x4 q = xw[rr + jj];
                a0 = a0 + w0[jj] * (f32x4){bflo(q.x), bfhi(q.x), bflo(q.y), bfhi(q.y)}; a1 = a1 + w1[jj] * (f32x4){bflo(q.z), bfhi(q.z), bflo(q.w), bfhi(q.w)}; }
            u32x4 o; o.x = cvt_pk_bf16(a0[0], a0[1]); o.y = cvt_pk_bf16(a0[2], a0[3]); o.z = cvt_pk_bf16(a1[0], a1[1]); o.w = cvt_pk_bf16(a1[2], a1[3]);
            *(u32x4*)(xc + (size_t)(r0 + rr) * 1024 + c8) = o;
        }
    }
}
__device__ __forceinline__ void lru_scanA_phase(const bf16_t* __restrict__ la, const bf16_t* __restrict__ uu, float* __restrict__ agg, const int wv) {
    constexpr int NS = 8 * 2 * 32 * 512, NP = 16 * 2 * 2 * 512;
    for (int idx = bid_s() * 512 + (wv * 64 + lane_id_v()); idx < NS + NP; idx += gridDim.x * 512) {
        int cp, dir, row0, segidx;
        if (idx < NS) { cp = idx & 511; const int seg = (idx >> 9) & 31; dir = (idx >> 14) & 1; const int b = idx >> 15; row0 = NPROMPT + b * 4096 + seg * 128; segidx = (b * 2 + dir) * 32 + seg; }
        else { const int i2 = idx - NS; cp = i2 & 511; const int seg = (i2 >> 9) & 1; dir = (i2 >> 10) & 1; const int b = i2 >> 11; row0 = b * 256 + seg * 128; segidx = 512 + (b * 2 + dir) * 2 + seg; }
        float L0 = 0.f, L1 = 0.f, H0 = 0.f, H1 = 0.f;
        for (int s0 = 0; s0 < 128; s0 += 16) {
            unsigned lw[16], uw[16];
#pragma unroll
            for (int j = 0; j < 16; ++j) { const int r = row0 + (dir ? 127 - (s0 + j) : s0 + j); const size_t o = ((size_t)r * 2 + dir) * 1024 + 2 * cp; lw[j] = *(const unsigned*)(la + o); uw[j] = *(const unsigned*)(uu + o); }
#pragma unroll
            for (int j = 0; j < 16; ++j) { const float l0 = bflo(lw[j]), l1 = bfhi(lw[j]); H0 = __expf(l0) * H0 + bflo(uw[j]); H1 = __expf(l1) * H1 + bfhi(uw[j]); L0 += l0; L1 += l1; }
        }
        *(f32x4*)(agg + ((size_t)segidx * 1024 + 2 * cp) * 2) = (f32x4){L0, H0, L1, H1};
    }
}
__device__ __forceinline__ void lru_scanC_phase(const bf16_t* __restrict__ la, const bf16_t* __restrict__ uu, const float* __restrict__ agg, bf16_t* __restrict__ rec, const float* __restrict__ st_in, float* __restrict__ st_out, const int wv) {
    constexpr int NS = 8 * 32 * 512, NP = 16 * 2 * 512;
    for (int idx = bid_s() * 512 + (wv * 64 + lane_id_v()); idx < NS + NP; idx += gridDim.x * 512) {
        int cp, seg, b, row0, nseg, segb; const bool samp = idx < NS;
        if (samp) { cp = idx & 511; seg = (idx >> 9) & 31; b = idx >> 14; row0 = NPROMPT + b * 4096 + seg * 128; nseg = 32; segb = b * 64; }
        else { const int i2 = idx - NS; cp = i2 & 511; seg = (i2 >> 9) & 1; b = i2 >> 10; row0 = b * 256 + seg * 128; nseg = 2; segb = 512 + b * 4; }
        float h0 = 0.f, h1 = 0.f;
        if (samp) { const f32x2 v = *(const f32x2*)(st_in + (b * 2 + 0) * 1024 + 2 * cp); h0 = v.x; h1 = v.y; }
        for (int s2 = 0; s2 < seg; ++s2) { const f32x4 v = *(const f32x4*)(agg + ((size_t)(segb + s2) * 1024 + 2 * cp) * 2); h0 = __expf(v[0]) * h0 + v[1]; h1 = __expf(v[2]) * h1 + v[3]; }
        for (int s0 = 0; s0 < 128; s0 += 16) {
            unsigned lw[16], uw[16];
#pragma unroll
            for (int j = 0; j < 16; ++j) { const size_t o = ((size_t)(row0 + s0 + j) * 2 + 0) * 1024 + 2 * cp; lw[j] = *(const unsigned*)(la + o); uw[j] = *(const unsigned*)(uu + o); }
#pragma unroll
            for (int j = 0; j < 16; ++j) { h0 = __expf(bflo(lw[j])) * h0 + bflo(uw[j]); h1 = __expf(bfhi(lw[j])) * h1 + bfhi(uw[j]); *(unsigned*)(rec + (size_t)(row0 + s0 + j) * 1024 + 2 * cp) = cvt_pk_bf16(h0, h1); }
        }
        if (!samp && seg == nseg - 1) *(f32x2*)(st_out + (b * 2 + 0) * 1024 + 2 * cp) = (f32x2){h0, h1};
        h0 = 0.f; h1 = 0.f;
        if (samp) { const f32x2 v = *(const f32x2*)(st_in + (b * 2 + 1) * 1024 + 2 * cp); h0 = v.x; h1 = v.y; }
        for (int s2 = nseg - 1; s2 > seg; --s2) { const f32x4 v = *(const f32x4*)(agg + ((size_t)(segb + nseg + s2) * 1024 + 2 * cp) * 2); h0 = __expf(v[0]) * h0 + v[1]; h1 = __expf(v[2]) * h1 + v[3]; }
        for (int s0 = 0; s0 < 128; s0 += 16) {
            unsigned lw[16], uw[16], rw[16];
#pragma unroll
            for (int j = 0; j < 16; ++j) { const int r = row0 + 127 - (s0 + j); const size_t o = ((size_t)r * 2 + 1) * 1024 + 2 * cp; lw[j] = *(const unsigned*)(la + o); uw[j] = *(const unsigned*)(uu + o); rw[j] = *(const unsigned*)(rec + (size_t)r * 1024 + 2 * cp); }
#pragma unroll
            for (int j = 0; j < 16; ++j) { const int r = row0 + 127 - (s0 + j); h0 = __expf(bflo(lw[j])) * h0 + bflo(uw[j]); h1 = __expf(bfhi(lw[j])) * h1 + bfhi(uw[j]);
                *(unsigned*)(rec + (size_t)r * 1024 + 2 * cp) = cvt_pk_bf16(bflo(rw[j]) + h0, bfhi(rw[j]) + h1); }
        }
        if (!samp && seg == 0) *(f32x2*)(st_out + (b * 2 + 1) * 1024 + 2 * cp) = (f32x2){h0, h1};
    }
}

#ifndef REP_BAR
#define REP_BAR 1
#endif
#ifndef REP_ATT
#define REP_ATT 1
#endif
#ifndef REP_RET
#define REP_RET 1
#endif
#ifndef REP_LRU
#define REP_LRU 1
#endif
#ifndef REP_UP
#define REP_UP 1
#endif
#ifndef REP_NORM
#define REP_NORM 1
#endif
__device__ __forceinline__ int opq(int n) { asm volatile("" : "+s"(n)); return n; }
constexpr int LDS_BYTES = 147456;
constexpr size_t WS_BAR = 4096;
#define XB_TMO      128
#define XB_XCNT(j)  (256  + 64 * (j))
#define XB_XSUB(j)  (1280 + 64 * (j))
#define XB_XGEN(j)  (2304 + 64 * (j))
#define XB_TOP      3328
#define XB_TOPGEN   3392
#define XCD_BAR_WORDS 3456
#define XB_SPIN_CAP (1u << 22)
__device__ __forceinline__ unsigned xb_ld(unsigned* p)              { return __hip_atomic_load(p, __ATOMIC_RELAXED, __HIP_MEMORY_SCOPE_AGENT); }
__device__ __forceinline__ unsigned xb_add(unsigned* p, unsigned v) { return __hip_atomic_fetch_add(p, v, __ATOMIC_RELAXED, __HIP_MEMORY_SCOPE_AGENT); }
__device__ __forceinline__ unsigned xb_xcc_id() { return (unsigned)__builtin_amdgcn_s_getreg((3 << 11) | 20) & 0xFu; }
#define XB_SPIN(cond, bar) do { unsigned _sp = 0; while (cond) { __builtin_amdgcn_s_sleep(1); \
    if ((++_sp & 255u) == 0u) { if (xb_ld(&(bar)[XB_TMO])) break; if (_sp > XB_SPIN_CAP) { atomicAdd(&(bar)[XB_TMO], 1u); break; } } } } while (0)
__device__ __forceinline__ void xcd_barrier_complete(unsigned* bar, unsigned x, unsigned& nloc, unsigned& nx) {
    const unsigned G = gridDim.x;
    unsigned sum, cnt, mine, sp = 0u;
    for (;;) {
        sum = 0u; cnt = 0u; mine = 0u;
#pragma unroll
        for (unsigned j = 0; j < 16; ++j) { const unsigned c = xb_ld(&bar[XB_XCNT(j)]); sum += c; cnt += (c > 0u) ? 1u : 0u; mine = (j == x) ? c : mine; }
        if (sum == G) break;
        __builtin_amdgcn_s_sleep(1);
        if ((++sp & 255u) == 0u) { if (xb_ld(&bar[XB_TMO])) break; if (sp > XB_SPIN_CAP) { atomicAdd(&bar[XB_TMO], 1u); break; } }
    }
    nloc = mine > 0u ? mine : 1u; nx = cnt > 0u ? cnt : 1u;
}
__device__ __forceinline__ void gbar(unsigned* bar, volatile LAS unsigned* st, const int wv) {
    asm volatile("s_waitcnt vmcnt(0) lgkmcnt(0)" ::: "memory");
    __syncthreads();
    if (wv == 0) {
      if (lane_id_v() == 0) {
        const unsigned x = xb_xcc_id();
        unsigned nloc = st[0], nx = st[1];
        if (nloc == 0u) { xcd_barrier_complete(bar, x, nloc, nx); st[0] = nloc; st[1] = nx; }
        const unsigned old = xb_add(&bar[XB_XSUB(x)], 1u);
        const unsigned gen = old / nloc;
        if (old + 1u == (gen + 1u) * nloc) {
            __builtin_amdgcn_fence(__ATOMIC_RELEASE, "agent");
            asm volatile("s_waitcnt vmcnt(0)" ::: "memory");
            const unsigned og = xb_add(&bar[XB_TOP], 1u);
            const unsigned tg = og / nx;
            if (og + 1u == (tg + 1u) * nx) xb_add(&bar[XB_TOPGEN], 1u);
            else XB_SPIN(xb_ld(&bar[XB_TOPGEN]) == tg, bar);
            __builtin_amdgcn_fence(__ATOMIC_ACQUIRE, "agent");
            xb_add(&bar[XB_XGEN(x)], 1u);
            asm volatile("s_waitcnt vmcnt(0)" ::: "memory");
        } else {
            XB_SPIN(xb_ld(&bar[XB_XGEN(x)]) == gen, bar);
            __builtin_amdgcn_fence(__ATOMIC_ACQUIRE, "agent");
            asm volatile("s_waitcnt vmcnt(0)" ::: "memory");
        }
      }
    }
    __syncthreads();
}
__global__ void __launch_bounds__(512, 2) fwd_mega(KArgs a) {
    extern __shared__ __attribute__((aligned(16))) unsigned char lds_raw[];
    LAS unsigned char* lds = (LAS unsigned char*)lds_raw;
    cg::this_grid().sync();
    volatile LAS unsigned* bst = (volatile LAS unsigned*)(lds + 143360);
    if (wave_id_s() == 0 && lane_id_v() == 0) { bst[0] = 0u; bst[1] = 0u; const unsigned xc_ = xb_xcc_id();
        const unsigned slot_ = xb_add(&((unsigned*)(karg_ptr(264) + WS_BAR))[XB_XCNT(xc_)], 1u); bst[2] = blockIdx.x; bst[3] = (xc_ << 8) | slot_; }
    __syncthreads();
    const int wave = wave_id_s(), lane = 0, G = gridDim.x, gw = bid_s() * 8 + wave, NGW = G * 8;
#define ws karg_ptr(264)
#define XR ((float*)karg_ptr(256))
#define modt ((float*)(ws + WS_MOD))
#define hbuf ((bf16_t*)(ws + WS_H))
#define WUP ((bf16_t*)(ws + WS_WUP))
#define WDN ((bf16_t*)(ws + WS_WDN))
#define WIN ((bf16_t*)(ws + WS_WIN))
#define WOUT ((bf16_t*)(ws + WS_WOUT))
#define WX ((bf16_t*)(ws + WS_WX))
#define WX2 ((bf16_t*)(ws + WS_WX2))
    mod_phase(a, lds, wave); __syncthreads();
    cache_phase(a, wave);
    convert_layer_weights(a, ws, 0, lds, wave, lane, gw, NGW);
    if (bid_s() == 0 && wave == 0) { const int l_ = lane_id_v(); if (l_ < 32) ((const float**)ws)[l_] = a.in[l_]; }
    for (int rb_ = opq(REP_BAR); rb_ > 0; --rb_) gbar((unsigned*)(ws + WS_BAR), bst, wave);
    if (wave == 0 && lane_id_v() == 0) {
        unsigned* bar_ = (unsigned*)(ws + WS_BAR); bool ok_ = gridDim.x == 256;
        for (unsigned j = 0; j < 16; ++j) { const unsigned c_ = xb_ld(&bar_[XB_XCNT(j)]); ok_ = ok_ && (c_ == (j < 8 ? 32u : 0u)); }
        const unsigned v_ = bst[3]; if (ok_) bst[2] = (v_ & 255u) * 8u + (v_ >> 8);
    }
    __syncthreads();
#define tb (KTab{(const float* const*)ws})
    constexpr int KS = 1;
    for (int layer = 0; layer < 4; ++layer) {
        const int kind = layer % 3, slot = layer / 3;
#define modl (modt + (size_t)layer * 9 * 6144)
        pg8::StaticOrder S;
        if (layer == 0) norm_phase<true>(inp(tb, 0), inp(tb, 1), XR, inp(tb, 8), modl, 0, hbuf, lane, gw, NGW);
        else { norm_phase<false>(nullptr, nullptr, XR, inp(tb, 8) + layer * DM, modl, 0, hbuf, lane, gw, NGW, KS ? (const float*)(ws + WS_PART_M) : nullptr, modl - 9 * 6144 + 5 * 1024); __syncthreads(); convert_layer_weights(tb, ws, layer, lds, wave, lane, gw, NGW); }
        for (int rb_ = opq(REP_BAR); rb_ > 0; --rb_) gbar((unsigned*)(ws + WS_BAR), bst, wave);
        if (kind == 0) {
            bf16_t *q = (bf16_t*)(ws + WS_AQ), *k = (bf16_t*)(ws + WS_AK), *v = (bf16_t*)(ws + WS_AV), *o = (bf16_t*)(ws + WS_AO);
            { pg8::Gemm g{hbuf, WIN, MTOK, 1536, 1024, 1024, 1024, 31, 0}; S.init(MTOK, 1536, G, bid_s());
              pg8::EpiAttnQKV E{q, k, v, XR + OUT_K, XR + OUT_V, inp(tb, 16) + slot * 64, inp(tb, 17) + slot * 64, slot};
              pg8::gemm_phase(lds, g, S, E, wave); }
            for (int rb_ = opq(REP_BAR); rb_ > 0; --rb_) gbar((unsigned*)(ws + WS_BAR), bst, wave);
            for (int rp_ = opq(REP_ATT); rp_ > 0; --rp_) attn_phase(lds, q, k, v, (const bf16_t*)(ws + WS_CK) + (size_t)slot * 512 * 256, (const bf16_t*)(ws + WS_CV) + (size_t)slot * 512 * 256, o, inp(tb, 18) + slot * 16, wave);
            for (int rb_ = opq(REP_BAR); rb_ > 0; --rb_) gbar((unsigned*)(ws + WS_BAR), bst, wave);
            { pg8::Gemm g{o, WOUT, MTOK, 1024, 1024, 1024, 1024, 31, 0}; S.init(MTOK, 1024, G, bid_s(), KS); pg8::EpiResid E{XR, modl + 2 * 1024, (float*)(ws + WS_PART_A)}; pg8::gemm_phase(lds, g, S, E, wave); }
            for (int rb_ = opq(REP_BAR); rb_ > 0; --rb_) gbar((unsigned*)(ws + WS_BAR), bst, wave);
        } else if (kind == 1) {
            bf16_t *q = (bf16_t*)(ws + WS_RQ), *k = (bf16_t*)(ws + WS_RK), *v = (bf16_t*)(ws + WS_RV), *o = (bf16_t*)(ws + WS_RO);
            float* statp = (float*)(ws + WS_RSTP); float* fin = (float*)(ws + WS_RFIN);
            { pg8::Gemm g{hbuf, WIN, MTOK, 4096, 1024, 1024, 1024, 31, 0}; S.init(MTOK, 4096, G, bid_s()); pg8::EpiRetQKV E{q, k, v}; pg8::gemm_phase(lds, g, S, E, wave); }
            for (int rb_ = opq(REP_BAR); rb_ > 0; --rb_) gbar((unsigned*)(ws + WS_BAR), bst, wave);
            for (int rp_ = opq(REP_RET); rp_ > 0; --rp_) ret_scan_phase(lds, q, k, v, o, statp, inp(tb, 22) + slot * 8, inp(tb, 4), XR + OUT_RET, wave);
            for (int rb_ = opq(REP_BAR); rb_ > 0; --rb_) gbar((unsigned*)(ws + WS_BAR), bst, wave);
            bf16_t* h2 = (bf16_t*)(ws + WS_RQ);
            norm_phase<false>(nullptr, nullptr, XR, inp(tb, 8) + layer * DM, modl, 0, h2, lane, gw, NGW);
            ret_fin_phase(statp, fin, wave);
            for (int rb_ = opq(REP_BAR); rb_ > 0; --rb_) gbar((unsigned*)(ws + WS_BAR), bst, wave);
            { pg8::Gemm g{h2, WX, MTOK, 2048, 1024, 1024, 1024, 31, 0}; S.init(MTOK, 2048, G, bid_s()); pg8::EpiLateGate<0> E{o, 2048, fin, inp(tb, 21) + slot * 2048}; pg8::gemm_phase(lds, g, S, E, wave); }
            for (int rb_ = opq(REP_BAR); rb_ > 0; --rb_) gbar((unsigned*)(ws + WS_BAR), bst, wave);
            { pg8::Gemm g{o, WOUT, MTOK, 1024, 2048, 2048, 2048, 31, 0}; S.init(MTOK, 1024, G, bid_s(), KS); pg8::EpiResid E{XR, modl + 2 * 1024, (float*)(ws + WS_PART_R)}; pg8::gemm_phase(lds, g, S, E, wave); }
            for (int rb_ = opq(REP_BAR); rb_ > 0; --rb_) gbar((unsigned*)(ws + WS_BAR), bst, wave);
        } else {
            bf16_t *xr = (bf16_t*)(ws + WS_LXR), *xc = (bf16_t*)(ws + WS_LXC), *la = (bf16_t*)(ws + WS_LLA), *uu = (bf16_t*)(ws + WS_LU), *rec = (bf16_t*)(ws + WS_LREC);
            float* agg = (float*)(ws + WS_LAGG);
            { pg8::Gemm g{hbuf, WIN, MTOK, 1024, 1024, 1024, 1024, 31, 0}; S.init(MTOK, 1024, G, bid_s()); pg8::EpiStore<0> E{xr, 1024}; pg8::gemm_phase(lds, g, S, E, wave); }
            for (int rb_ = opq(REP_BAR); rb_ > 0; --rb_) gbar((unsigned*)(ws + WS_BAR), bst, wave);
            for (int rp_ = opq(REP_LRU); rp_ > 0; --rp_) lru_conv_phase(xr, xc, inp(tb, 24) + slot * 4096, inp(tb, 25) + slot * 1024, wave);
            for (int rb_ = opq(REP_BAR); rb_ > 0; --rb_) gbar((unsigned*)(ws + WS_BAR), bst, wave);
            { pg8::Gemm g{xc, WX2, MTOK, 4096, 128, 1024, 128, 1, 256}; S.init(MTOK, 4096, G, bid_s());
              pg8::EpiLruGates E{xc, la, uu, inp(tb, 27) + slot * 2048, inp(tb, 29) + slot * 2048, inp(tb, 30) + slot * 2048}; pg8::gemm_phase(lds, g, S, E, wave); }
            for (int rb_ = opq(REP_BAR); rb_ > 0; --rb_) gbar((unsigned*)(ws + WS_BAR), bst, wave);
            for (int rp_ = opq(REP_LRU); rp_ > 0; --rp_) lru_scanA_phase(la, uu, agg, wave);
            for (int rb_ = opq(REP_BAR); rb_ > 0; --rb_) gbar((unsigned*)(ws + WS_BAR), bst, wave);
            for (int rp_ = opq(REP_LRU); rp_ > 0; --rp_) lru_scanC_phase(la, uu, agg, rec, inp(tb, 5) + slot * 2048, XR + OUT_LRU, wave);
            for (int rb_ = opq(REP_BAR); rb_ > 0; --rb_) gbar((unsigned*)(ws + WS_BAR), bst, wave);
            { pg8::Gemm g{hbuf, WX, MTOK, 1024, 1024, 1024, 1024, 31, 0}; S.init(MTOK, 1024, G, bid_s()); pg8::EpiLateGate<1> E{rec, 1024, nullptr, nullptr}; pg8::gemm_phase(lds, g, S, E, wave); }
            for (int rb_ = opq(REP_BAR); rb_ > 0; --rb_) gbar((unsigned*)(ws + WS_BAR), bst, wave);
            { pg8::Gemm g{rec, WOUT, MTOK, 1024, 1024, 1024, 1024, 31, 0}; S.init(MTOK, 1024, G, bid_s(), KS); pg8::EpiResid E{XR, modl + 2 * 1024, (float*)(ws + WS_PART_L)}; pg8::gemm_phase(lds, g, S, E, wave); }
            for (int rb_ = opq(REP_BAR); rb_ > 0; --rb_) gbar((unsigned*)(ws + WS_BAR), bst, wave);
        }
        norm_phase<false>(nullptr, nullptr, XR, inp(tb, 9) + layer * DM, modl, 3, hbuf, lane, gw, NGW, KS ? (const float*)(ws + (kind == 0 ? WS_PART_A : kind == 1 ? WS_PART_R : WS_PART_L)) : nullptr, modl + 2 * 1024);
        for (int rb_ = opq(REP_BAR); rb_ > 0; --rb_) gbar((unsigned*)(ws + WS_BAR), bst, wave);
        bf16_t* hid = (bf16_t*)(ws + WS_HID);
        for (int rp_ = opq(REP_UP); rp_ > 0; --rp_) { pg8::Gemm g{hbuf, WUP, MTOK, 4096, 1024, 1024, 1024, 31, 0}; S.init(MTOK, 4096, G, bid_s()); pg8::EpiStore<2> E{hid, 4096}; pg8::gemm_phase(lds, g, S, E, wave); }
        for (int rb_ = opq(REP_BAR); rb_ > 0; --rb_) gbar((unsigned*)(ws + WS_BAR), bst, wave);
        { pg8::Gemm g{hid, WDN, MTOK, 1024, 4096, 4096, 4096, 31, 0}; S.init(MTOK, 1024, G, bid_s(), KS); pg8::EpiResid E{XR, modl + 5 * 1024, (float*)(ws + WS_PART_M)}; pg8::gemm_phase(lds, g, S, E, wave); }
        for (int rb_ = opq(REP_BAR); rb_ > 0; --rb_) gbar((unsigned*)(ws + WS_BAR), bst, wave);
    }
    {
        const int layer = 3; const float* gate = modl + 5 * 1024; const float* part = (const float*)(ws + WS_PART_M); float* xo = XR;
        const int l_ = lane_id_v();
        for (int r = gw; r < MTOK; r += NGW) { const bf16_t* xb = (const bf16_t*)xo + (size_t)r * 2048; f32x4 v[4];
#pragma unroll
            for (int j = 0; j < 4; ++j) { const u32x2 w = *(const u32x2*)(xb + 4 * l_ + 256 * j); v[j] = (f32x4){bflo(w.x), bfhi(w.x), bflo(w.y), bfhi(w.y)}; }
            if (KS && r >= 32768) { const float* gp = gate + (size_t)modidx(r) * 6144;
#pragma unroll
                for (int j = 0; j < 4; ++j) { const int c = 4 * l_ + 256 * j; const bf16_t* pp = (const bf16_t*)part + (size_t)(r - 32768) * DM + c;
                    const f32x4 ps = ((ld4bf(pp) + ld4bf(pp + (size_t)4096 * DM)) + ld4bf(pp + (size_t)2 * 4096 * DM)) + ld4bf(pp + (size_t)3 * 4096 * DM);
                    v[j] = v[j] + *(const f32x4*)(gp + c) * ps; } }
            asm volatile("s_waitcnt vmcnt(0)" ::: "memory");
#pragma unroll
            for (int j = 0; j < 4; ++j) *(f32x4*)(xo + (size_t)r * DM + 4 * l_ + 256 * j) = v[j];
        }
    }
}

#undef ws
#undef XR
#undef modt
#undef hbuf
#undef WUP
#undef WDN
#undef WIN
#undef WOUT
#undef WX
#undef WX2
#undef modl
#undef tb
extern "C" void kernel_launch(void* const* d_in, const int* in_sizes, int n_in, void* d_out, int out_size, void* d_ws, size_t ws_size, hipStream_t stream) {
    static int grid = 0;
    if (grid == 0) {
        int dev = 0, cus = 0, per_cu = 0;
        hipGetDevice(&dev); hipDeviceGetAttribute(&cus, hipDeviceAttributeMultiprocessorCount, dev);
        if (hipFuncSetAttribute((const void*)fwd_mega, hipFuncAttributeMaxDynamicSharedMemorySize, LDS_BYTES) != hipSuccess) { fprintf(stderr, "hipFuncSetAttribute failed\n"); grid = -1; return; }
        if (hipOccupancyMaxActiveBlocksPerMultiprocessor(&per_cu, (const void*)fwd_mega, 512, LDS_BYTES) != hipSuccess || per_cu < 1) { fprintf(stderr, "occupancy query: %d\n", per_cu); per_cu = 1; }
        (void)hipGetLastError();
        grid = cus * per_cu;
        if (grid != 256) { fprintf(stderr, "kernel_launch: this build needs exactly 256 resident workgroups (got %d)\n", grid); grid = -1; return; }
        if (n_in != 32 || ws_size < 512 * MiB) { fprintf(stderr, "kernel_launch: unexpected n_in %d / ws %zu\n", n_in, ws_size); grid = -1; return; }
    }
    if (grid < 0) return;
    KArgs a{};
    for (int i = 0; i < 32; ++i) a.in[i] = (const float*)d_in[i];
    a.out = (float*)d_out; a.ws = (unsigned char*)d_ws;
    if (hipMemsetAsync((char*)d_ws + WS_BAR, 0, 16384, stream) != hipSuccess) { fprintf(stderr, "memset failed\n"); return; }
    void* args[] = {&a};
    hipError_t e = hipLaunchCooperativeKernel((const void*)fwd_mega, dim3(grid), dim3(512), args, LDS_BYTES, stream);
    if (e != hipSuccess) fprintf(stderr, "cooperative launch failed: %s (grid %d)\n", hipGetErrorString(e), grid);
}
```

```cpp
#include <hip/hip_runtime.h>
#include <hip/hip_cooperative_groups.h>
#include <cstdio>
#include <cstdint>
namespace cg = cooperative_groups;

#define LAS __attribute__((address_space(3)))
typedef unsigned short bf16_t;
typedef short bf16x8 __attribute__((ext_vector_type(8)));
typedef short s16x4 __attribute__((ext_vector_type(4)));
typedef float f32x4 __attribute__((ext_vector_type(4)));
typedef float f32x2 __attribute__((ext_vector_type(2)));
typedef float f32x16 __attribute__((ext_vector_type(16)));
typedef unsigned u32x4 __attribute__((ext_vector_type(4)));
typedef unsigned u32x2 __attribute__((ext_vector_type(2)));

#define LOG2E 1.4426950408889634f
constexpr int DM = 1024, NPROMPT = 4096, MTOK = 36864, DFF = 4096;
constexpr size_t MiB = 1u << 20;
constexpr size_t WS_MOD = 1 * MiB;
constexpr size_t WS_WUP = 2 * MiB, WS_WDN = 10 * MiB, WS_WIN = 18 * MiB, WS_WOUT = 26 * MiB, WS_WX = 30 * MiB, WS_WX2 = 32 * MiB;
constexpr size_t WS_CK = 34 * MiB, WS_CV = 38 * MiB;
constexpr size_t WS_A = 44 * MiB;
constexpr size_t WS_H = 440 * MiB;
constexpr size_t WS_AQ = 44 * MiB, WS_AK = 116 * MiB, WS_AV = 134 * MiB, WS_AO = 152 * MiB;
constexpr size_t WS_RQ = 44 * MiB, WS_RK = 116 * MiB, WS_RV = 188 * MiB, WS_RO = 332 * MiB, WS_RSTP = 476 * MiB, WS_RFIN = 494 * MiB;
constexpr size_t WS_LXR = 368 * MiB, WS_LXC = 44 * MiB, WS_LLA = 116 * MiB, WS_LU = 260 * MiB, WS_LAGG = 404 * MiB, WS_LREC = 44 * MiB;
constexpr size_t WS_HID = 44 * MiB;
constexpr size_t WS_PART_A = 224 * MiB, WS_PART_R = 44 * MiB, WS_PART_L = 116 * MiB, WS_PART_M = 332 * MiB;
constexpr size_t OUT_K = 37748736, OUT_V = 39845888, OUT_RET = 41943040, OUT_LRU = 58720256;

__device__ __forceinline__ unsigned cvt_pk_bf16(float lo, float hi) { unsigned r; asm volatile("v_cvt_pk_bf16_f32 %0, %1, %2" : "=v"(r) : "v"(lo), "v"(hi)); return r; }
__device__ __forceinline__ float bf2f(unsigned short b) { return __uint_as_float((unsigned)b << 16); }
__device__ __forceinline__ float bflo(unsigned w) { return __uint_as_float(w << 16); }
__device__ __forceinline__ float bfhi(unsigned w) { return __uint_as_float(w & 0xffff0000u); }
__device__ __forceinline__ f32x4 ld4bf(const bf16_t* p) { const u32x2 w = *(const u32x2*)p; return (f32x4){bflo(w.x), bfhi(w.x), bflo(w.y), bfhi(w.y)}; }
__device__ __forceinline__ float fsigmoid(float x) { return __builtin_amdgcn_rcpf(1.f + __expf(-x)); }
__device__ __forceinline__ float fsilu(float x) { return x * fsigmoid(x); }
__device__ __forceinline__ float fgelu_tanh(float x) { const float u = 0.7978845608028654f * (x + 0.044715f * x * x * x); return x * fsigmoid(2.f * u); }
__device__ __forceinline__ int launder(int v) { asm volatile("" : "+v"(v)); return v; }
__device__ __forceinline__ int lane_id_v() { int l; asm volatile("v_mbcnt_lo_u32_b32 %0, -1, 0\n\tv_mbcnt_hi_u32_b32 %0, -1, %0" : "=v"(l)); return l; }
__device__ __forceinline__ int bid_s() { const int b = *(volatile LAS int*)(uintptr_t)143368u; return __builtin_amdgcn_readfirstlane(b); }
__device__ __forceinline__ int wave_id_s() { return __builtin_amdgcn_readfirstlane(__builtin_amdgcn_workitem_id_x() >> 6); }
__device__ __forceinline__ unsigned char* karg_ptr(int off) {
#if defined(__HIP_DEVICE_COMPILE__)
    unsigned long long v; auto ka = __builtin_amdgcn_kernarg_segment_ptr();
    if (off == 256) asm volatile("s_load_dwordx2 %0, %1, 0x100\n\ts_waitcnt lgkmcnt(0)" : "=s"(v) : "s"(ka));
    else asm volatile("s_load_dwordx2 %0, %1, 0x108\n\ts_waitcnt lgkmcnt(0)" : "=s"(v) : "s"(ka));
    return (unsigned char*)v;
#else
    (void)off; return nullptr;
#endif
}
__device__ __forceinline__ int modidx(int r) { return r < NPROMPT ? 0 : 1 + ((r - NPROMPT) >> 12); }
__device__ __forceinline__ void rope_cs(float pos, float inv, float& c, float& s) {
    float rev = pos * inv * 0.15915494309189535f; rev -= rintf(rev);
    s = __builtin_amdgcn_sinf(rev); c = __builtin_amdgcn_cosf(rev);
}

namespace pg8 {
constexpr int BM = 256, BK = 64, HALF = 128, HTB = HALF * BK * 2, STAGE_BYTES = 8 * HTB, NXCD = 8, WGM = 8;
__host__ __device__ __forceinline__ int lds_byte(int r, int c) { const int st = (r >> 4) * 2 + (c >> 5), rr = r & 15, cc = c & 31, ob = rr * 64 + cc * 2; return st * 1024 + (ob ^ (((ob >> 9) & 1) << 5)); }
__host__ __device__ __forceinline__ void stage_rc(int b, int& R, int& C) { const int st = b / 1024, sb = b % 1024, swz = sb ^ (((sb >> 9) & 1) << 5); R = (st >> 1) * 16 + swz / 64; C = (st & 1) * 32 + (swz % 64) / 2; }
__host__ __device__ __forceinline__ int perm32(int rho) { const int n = rho >> 4, i = rho & 15; return 8 * (i >> 2) + 4 * n + (i & 3); }
struct Unit { int pm, pn, kq; };
struct Gemm { const bf16_t* A; const bf16_t* Bt; int M, N, K, lda, ldb, ash, astep; };
struct StaticOrder {
    int nM, nN, nwg, G, c, ks;
    __device__ void init(int M, int N, int G_, int c_, int ks_ = 0) { nM = M / BM; nN = N / BM; nwg = nM * nN; G = G_; c = c_; ks = ks_; }
    __device__ bool next(int i, Unit& u) const {
        if (ks) { if (i < 2) { const int j = i * 32 + (c >> 3), xx = c & 7; u.pm = 16 * xx + (j >> 2); u.pn = j & 3; u.kq = -1; return true; }
                  if (i == 2) { const int t = c >> 2; u.pm = 128 + (t >> 2); u.pn = t & 3; u.kq = c & 3; return true; } return false; }
        u.kq = -1;
        const int L = i * G + c; if (L >= nwg) return false;
        int wgid = L; { const int q = nwg / NXCD, r = nwg % NXCD, xcd = wgid % NXCD, off = wgid / NXCD; wgid = (xcd < r ? xcd * (q + 1) : r * (q + 1) + (xcd - r) * q) + off; }
        const int nig = WGM * nN, gid = wgid / nig, fm = gid * WGM, gsz = (nM - fm) < WGM ? (nM - fm) : WGM;
        u.pm = fm + ((wgid % nig) % gsz); u.pn = (wgid % nig) / gsz; return true;
    }
};

template <class Epi>
__device__ __forceinline__ void gemm_phase(LAS unsigned char* lds, const Gemm g, const StaticOrder& S, const Epi& E, const int wv) {
    const int wid = wv, lane = lane_id_v(), tid = wid * 64 + lane, wr = wid >> 2, wc = wid & 3, fr = lane & 15, fq = lane >> 4;
    int K_ = g.K; asm volatile("" : "+s"(K_));
    const int K = K_, nt = K / BK;
    unsigned voffA[2], voffB[2];
#pragma unroll
    for (int i = 0; i < 2; ++i) { int R, C; stage_rc(tid * 16 + i * 8192, R, C); const int Rb = Epi::PERM ? ((R & ~31) + perm32(R & 31)) : R;
        voffA[i] = (unsigned)(R * g.lda + C) * 2u; voffB[i] = (unsigned)(Rb * g.ldb + C) * 2u; }
    const unsigned kstep = (unsigned)(BK * 2);
    const unsigned hA = (unsigned)HALF * g.lda * 2u, hB = (unsigned)HALF * g.ldb * 2u, tA = 2u * hA, tB = 2u * hB;
    const unsigned ldsw = (unsigned)wid * 1024u;
    const int aoff = lds_byte(wr * 64 + fr, fq * 8), boff = lds_byte(wc * 32 + fr, fq * 8);
#define PG8_SA(b, h) (((b) * 2 + (h)) * HTB)
#define PG8_SB(b, h) ((4 + (b) * 2 + (h)) * HTB)
#define PG8_STAGE(bufoff, gbase, voff) do { _Pragma("unroll") for (int _i = 0; _i < 2; ++_i) \
        __builtin_amdgcn_global_load_lds((const unsigned*)((const char*)(gbase) + (voff)[_i]), (LAS unsigned*)(lds + (bufoff) + ldsw + _i * 8192), 16, 0, 0); } while (0)
#define PG8_LDA(dst, b, h) do { _Pragma("unroll") for (int m = 0; m < 4; ++m) _Pragma("unroll") for (int k = 0; k < 2; ++k) dst[m][k] = *(const LAS bf16x8*)(lds + PG8_SA(b, h) + aoff + m * 2048 + k * 1024); } while (0)
#define PG8_LDB(dst, b, h) do { _Pragma("unroll") for (int n = 0; n < 2; ++n) _Pragma("unroll") for (int k = 0; k < 2; ++k) dst[n][k] = *(const LAS bf16x8*)(lds + PG8_SB(b, h) + boff + n * 2048 + k * 1024); } while (0)
#define PG8_MMA(ai, bj, At, Bt) do { __builtin_amdgcn_s_setprio(1); _Pragma("unroll") for (int m = 0; m < 4; ++m) _Pragma("unroll") for (int n = 0; n < 2; ++n) _Pragma("unroll") for (int k = 0; k < 2; ++k) \
        acc[ai][bj][m][n] = __builtin_amdgcn_mfma_f32_16x16x32_bf16(Bt[n][k], At[m][k], acc[ai][bj][m][n], 0, 0, 0); __builtin_amdgcn_s_setprio(0); } while (0)
#define PG8_WAIT_V(n) asm volatile("s_waitcnt vmcnt(" #n ")" ::: "memory")
#define PG8_WAIT_L(n) asm volatile("s_waitcnt lgkmcnt(" #n ")" ::: "memory")
#define PG8_BAR __builtin_amdgcn_s_barrier()
#define PG8_SCHED __builtin_amdgcn_sched_barrier(0)
    Unit cur, nxt; int ui = 0;
    if (!S.next(0, cur)) return;
    f32x4 acc[2][2][4][2];
#pragma unroll
    for (int a = 0; a < 2; ++a)
#pragma unroll
        for (int b = 0; b < 2; ++b)
#pragma unroll
            for (int m = 0; m < 4; ++m)
#pragma unroll
                for (int n = 0; n < 2; ++n) acc[a][b][m][n] = (f32x4){0.f, 0.f, 0.f, 0.f};
    bf16x8 At[4][2], B0[2][2], B1[2][2];
    const int ntq = nt >> 2;
    int cnt = cur.kq >= 0 ? ntq : nt;
    const unsigned cko = cur.kq >= 0 ? (unsigned)(cur.kq * ntq) * kstep : 0u;
    const char* cA = (const char*)g.A + ((unsigned)cur.pm * tA + (unsigned)(cur.pn >> g.ash) * (unsigned)g.astep + cko);
    const char* cB = (const char*)g.Bt + ((unsigned)cur.pn * tB + cko);
    PG8_STAGE(PG8_SB(0, 0), cB, voffB); PG8_STAGE(PG8_SB(0, 1), cB + hB, voffB); PG8_STAGE(PG8_SA(0, 0), cA, voffA); PG8_STAGE(PG8_SA(0, 1), cA + hA, voffA);
    if (wr == 1) PG8_BAR;
    PG8_WAIT_V(2); PG8_BAR;
    PG8_STAGE(PG8_SB(1, 0), cB + kstep, voffB); PG8_STAGE(PG8_SA(1, 0), cA + kstep, voffA); PG8_STAGE(PG8_SB(1, 1), cB + hB + kstep, voffB);
    PG8_WAIT_V(6); PG8_BAR;
    for (;;) {
        const bool has_next = S.next(ui + 1, nxt);
        const unsigned nko = (has_next && nxt.kq >= 0) ? (unsigned)(nxt.kq * ntq) * kstep : 0u;
        const char* nA = has_next ? (const char*)g.A + ((unsigned)nxt.pm * tA + (unsigned)(nxt.pn >> g.ash) * (unsigned)g.astep + nko) : cA; const char* nB = has_next ? (const char*)g.Bt + ((unsigned)nxt.pn * tB + nko) : cB;
        for (int t = 0; t < cnt; t += 2) {
            const bool last = (t == cnt - 2);
            const char* a1 = cA + (unsigned)(t + 1) * kstep;
            const char* a2 = last ? nA : cA + (unsigned)(t + 2) * kstep; const char* b2 = last ? nB : cB + (unsigned)(t + 2) * kstep;
            const char* a3 = a2 + kstep; const char* b3 = b2 + kstep;
            PG8_LDB(B0, 0, 0); PG8_LDB(B1, 0, 1); PG8_SCHED; PG8_LDA(At, 0, 0); PG8_STAGE(PG8_SA(1, 1), a1 + hA, voffA);
            PG8_WAIT_V(8); PG8_WAIT_L(0); PG8_BAR; PG8_MMA(0, 0, At, B0); PG8_MMA(0, 1, At, B1); PG8_BAR; PG8_SCHED;
            PG8_LDA(At, 0, 1); PG8_STAGE(PG8_SB(0, 0), b2, voffB); PG8_STAGE(PG8_SB(0, 1), b2 + hB, voffB); PG8_STAGE(PG8_SA(0, 0), a2, voffA);
            PG8_WAIT_V(8); PG8_WAIT_L(0); PG8_BAR; PG8_MMA(1, 0, At, B0); PG8_MMA(1, 1, At, B1); PG8_BAR; PG8_SCHED;
            PG8_LDB(B0, 1, 0); PG8_LDB(B1, 1, 1); PG8_SCHED; PG8_LDA(At, 1, 0); PG8_STAGE(PG8_SA(0, 1), a2 + hA, voffA);
            PG8_WAIT_V(8); PG8_WAIT_L(0); PG8_BAR; PG8_MMA(0, 0, At, B0); PG8_MMA(0, 1, At, B1); PG8_BAR; PG8_SCHED;
            PG8_LDA(At, 1, 1); PG8_STAGE(PG8_SB(1, 0), b3, voffB); PG8_STAGE(PG8_SB(1, 1), b3 + hB, voffB); PG8_STAGE(PG8_SA(1, 0), a3, voffA);
            PG8_WAIT_V(8); PG8_WAIT_L(0); PG8_BAR; PG8_MMA(1, 0, At, B0); PG8_MMA(1, 1, At, B1); PG8_BAR; PG8_SCHED;
        }
        if (wr == 0) PG8_BAR;
        E(acc, cur, wr, wc, fr, fq);
        if (!has_next) break;
#pragma unroll
        for (int a = 0; a < 2; ++a)
#pragma unroll
            for (int b = 0; b < 2; ++b)
#pragma unroll
                for (int m = 0; m < 4; ++m)
#pragma unroll
                    for (int n = 0; n < 2; ++n) acc[a][b][m][n] = (f32x4){0.f, 0.f, 0.f, 0.f};
        cur = nxt; cA = nA; cB = nB; ++ui; cnt = cur.kq >= 0 ? ntq : nt;
        if (wr == 1) PG8_BAR;
    }
    PG8_WAIT_V(0);
    PG8_BAR;
#undef PG8_SA
#undef PG8_SB
#undef PG8_STAGE
#undef PG8_LDA
#undef PG8_LDB
#undef PG8_MMA
#undef PG8_WAIT_V
#undef PG8_WAIT_L
#undef PG8_BAR
#undef PG8_SCHED
}

template <int ACT> struct EpiStore {
    static constexpr bool PERM = true;
    bf16_t* O; int ldc;
    __device__ __forceinline__ void operator()(const f32x4 (&acc)[2][2][4][2], const Unit& u, int wr, int wc, int fr, int fq) const {
        fr = launder(fr); fq = launder(fq);
        const int row0 = u.pm * BM + wr * 64 + fr, col0 = u.pn * BM + wc * 32 + 8 * fq;
#pragma unroll
        for (int ai = 0; ai < 2; ++ai)
#pragma unroll
            for (int m = 0; m < 4; ++m) { bf16_t* rowp = O + (size_t)(row0 + ai * HALF + m * 16) * ldc + col0;
#pragma unroll
                for (int bj = 0; bj < 2; ++bj) { f32x4 v0 = acc[ai][bj][m][0], v1 = acc[ai][bj][m][1];
                    if (ACT == 2) {
#pragma unroll
                        for (int e = 0; e < 4; ++e) { const float a = fmaxf(v0[e], 0.f), b = fmaxf(v1[e], 0.f); v0[e] = a * a; v1[e] = b * b; } }
                    u32x4 w; w.x = cvt_pk_bf16(v0[0], v0[1]); w.y = cvt_pk_bf16(v0[2], v0[3]); w.z = cvt_pk_bf16(v1[0], v1[1]); w.w = cvt_pk_bf16(v1[2], v1[3]);
                    *(u32x4*)(rowp + bj * HALF) = w; } asm volatile("" ::: "memory"); }
    }
};
struct EpiResid {
    static constexpr bool PERM = true;
    float* x; const float* gate; float* part;
    __device__ __forceinline__ void operator()(const f32x4 (&acc)[2][2][4][2], const Unit& u, int wr, int wc, int fr, int fq) const {
        fr = launder(fr); fq = launder(fq);
        const int row0 = u.pm * BM + wr * 64 + fr, col0 = u.pn * BM + wc * 32 + 8 * fq;
        if (u.kq >= 0) {
#pragma unroll
            for (int ai = 0; ai < 2; ++ai)
#pragma unroll
                for (int m = 0; m < 4; ++m) { bf16_t* rowp = (bf16_t*)part + ((size_t)u.kq * 4096 + (row0 + ai * HALF + m * 16 - 32768)) * DM + col0;
#pragma unroll
                    for (int bj = 0; bj < 2; ++bj) { const f32x4 a0 = acc[ai][bj][m][0], a1 = acc[ai][bj][m][1];
                        u32x4 o; o.x = cvt_pk_bf16(a0[0], a0[1]); o.y = cvt_pk_bf16(a0[2], a0[3]); o.z = cvt_pk_bf16(a1[0], a1[1]); o.w = cvt_pk_bf16(a1[2], a1[3]); *(u32x4*)(rowp + bj * HALF) = o; } }
            return;
        }
        const float* gp = gate + (size_t)modidx(u.pm * BM) * 6144 + col0;
        f32x4 gv[2][2];
#pragma unroll
        for (int bj = 0; bj < 2; ++bj)
#pragma unroll
            for (int n = 0; n < 2; ++n) gv[bj][n] = *(const f32x4*)(gp + bj * HALF + 4 * n);
#pragma unroll
        for (int ai = 0; ai < 2; ++ai) {
            u32x4 xw[4][2];
#pragma unroll
            for (int m = 0; m < 4; ++m)
#pragma unroll
                for (int bj = 0; bj < 2; ++bj) xw[m][bj] = *(const u32x4*)((const bf16_t*)x + (size_t)(row0 + ai * HALF + m * 16) * 2048 + col0 + bj * HALF);
#pragma unroll
            for (int m = 0; m < 4; ++m)
#pragma unroll
                for (int bj = 0; bj < 2; ++bj) { const u32x4 w = xw[m][bj];
                    const f32x4 xa = (f32x4){bflo(w.x), bfhi(w.x), bflo(w.y), bfhi(w.y)} + gv[bj][0] * acc[ai][bj][m][0], xb = (f32x4){bflo(w.z), bfhi(w.z), bflo(w.w), bfhi(w.w)} + gv[bj][1] * acc[ai][bj][m][1];
                    u32x4 o; o.x = cvt_pk_bf16(xa[0], xa[1]); o.y = cvt_pk_bf16(xa[2], xa[3]); o.z = cvt_pk_bf16(xb[0], xb[1]); o.w = cvt_pk_bf16(xb[2], xb[3]);
                    *(u32x4*)((bf16_t*)x + (size_t)(row0 + ai * HALF + m * 16) * 2048 + col0 + bj * HALF) = o; }
            asm volatile("" ::: "memory"); }
    }
};
__device__ __forceinline__ void st4(bf16_t* p, const f32x4 v) { u32x2 w; w.x = cvt_pk_bf16(v[0], v[1]); w.y = cvt_pk_bf16(v[2], v[3]); *(u32x2*)p = w; }
struct EpiAttnQKV {
    static constexpr bool PERM = false;
    bf16_t *q, *k, *v; float *nk, *nv; const float *qg, *kg; int slot;
    __device__ __forceinline__ void operator()(const f32x4 (&acc)[2][2][4][2], const Unit& u, int wr, int wc, int fr, int fq) const {
        fr = launder(fr); fq = launder(fq);
        const int pn = u.pn;
#pragma unroll
        for (int ai = 0; ai < 2; ++ai)
#pragma unroll
            for (int m = 0; m < 4; ++m) {
                const int r = u.pm * BM + ai * HALF + wr * 64 + m * 16 + fr;
                f32x4 v00 = acc[ai][0][m][0], v01 = acc[ai][0][m][1], v10 = acc[ai][1][m][0], v11 = acc[ai][1][m][1];
                if (pn < 5) {
                    float ss = 0.f;
#pragma unroll
                    for (int e = 0; e < 4; ++e) ss += v00[e] * v00[e] + v01[e] * v01[e] + v10[e] * v10[e] + v11[e] * v11[e];
                    ss += __shfl_xor(ss, 16); ss += __shfl_xor(ss, 32);
                    const float rs = rsqrtf(ss * (1.f / 64.f) + 1e-6f);
                    const float* gn = (pn < 4 ? qg : kg) + 4 * fq;
                    v00 = v00 * rs * *(const f32x4*)(gn); v01 = v01 * rs * *(const f32x4*)(gn + 16); v10 = v10 * rs * *(const f32x4*)(gn + 32); v11 = v11 * rs * *(const f32x4*)(gn + 48);
                    if (r >= NPROMPT) {
                        const int t = (r - NPROMPT) & 4095; const float rp = (float)(t >> 6), cp = (float)(t & 63);
#pragma unroll
                        for (int e = 0; e < 4; ++e) {
                            const float inv = __builtin_amdgcn_exp2f(-(float)(4 * fq + e) * (13.287712379549449f / 16.f)); float c, s;
                            rope_cs(rp, inv, c, s); { const float x1 = v00[e], x2 = v01[e]; v00[e] = x1 * c - x2 * s; v01[e] = x2 * c + x1 * s; }
                            rope_cs(cp, inv, c, s); { const float x1 = v10[e], x2 = v11[e]; v10[e] = x1 * c - x2 * s; v11[e] = x2 * c + x1 * s; }
                        }
                    }
                }
                if (pn < 4) {
                    bf16_t* d = q + (size_t)r * 1024 + (4 * pn + wc) * 64 + 4 * fq;
                    constexpr float QS = 0.125f * LOG2E; st4(d, v00 * QS); st4(d + 16, v01 * QS); st4(d + 32, v10 * QS); st4(d + 48, v11 * QS);
                } else {
                    bf16_t* d = (pn == 4 ? k : v) + (size_t)r * 256 + wc * 64 + 4 * fq;
                    st4(d, v00); st4(d + 16, v01); st4(d + 32, v10); st4(d + 48, v11);
                    if (r < NPROMPT) { const int b = r >> 8, t = r & 255; float* o = (pn == 4 ? nk : nv) + ((size_t)(b * 2 + slot) * 256 + t) * 256 + wc * 64 + 4 * fq;
                        *(f32x4*)o = v00; *(f32x4*)(o + 16) = v01; *(f32x4*)(o + 32) = v10; *(f32x4*)(o + 48) = v11; }
                }
            }
    }
};
struct EpiRetQKV {
    static constexpr bool PERM = false;
    bf16_t *q, *k, *v;
    __device__ __forceinline__ void operator()(const f32x4 (&acc)[2][2][4][2], const Unit& u, int wr, int wc, int fr, int fq) const {
        fr = launder(fr); fq = launder(fq);
        const int pn = u.pn;
#pragma unroll
        for (int ai = 0; ai < 2; ++ai)
#pragma unroll
            for (int m = 0; m < 4; ++m) {
                const int r = u.pm * BM + ai * HALF + wr * 64 + m * 16 + fr;
                f32x4 v00 = acc[ai][0][m][0], v01 = acc[ai][0][m][1], v10 = acc[ai][1][m][0], v11 = acc[ai][1][m][1];
                if (pn < 8) {
                    if (r >= NPROMPT) {
                        const int t = (r - NPROMPT) & 4095; const float rp = (float)(t >> 6), cp = (float)(t & 63);
#pragma unroll
                        for (int e = 0; e < 4; ++e) {
                            const float inv = __builtin_amdgcn_exp2f(-(float)(16 * wc + 4 * fq + e) * (13.287712379549449f / 64.f)); float c, s;
                            rope_cs(rp, inv, c, s); { const float x1 = v00[e], x2 = v01[e]; v00[e] = x1 * c - x2 * s; v01[e] = x2 * c + x1 * s; }
                            rope_cs(cp, inv, c, s); { const float x1 = v10[e], x2 = v11[e]; v10[e] = x1 * c - x2 * s; v11[e] = x2 * c + x1 * s; }
                        }
                    }
                    if (pn >= 4) { v00 = v00 * 0.0625f; v01 = v01 * 0.0625f; v10 = v10 * 0.0625f; v11 = v11 * 0.0625f; }
                }
                bf16_t* d = (pn < 4 ? q + (size_t)r * 1024 + pn * 256 : pn < 8 ? k + (size_t)r * 1024 + (pn - 4) * 256 : v + (size_t)r * 2048 + (pn - 8) * 256) + 16 * wc + 4 * fq;
                st4(d, v00); st4(d + 64, v01); st4(d + 128, v10); st4(d + 192, v11);
            }
    }
};
template <int MODE> struct EpiLateGate {
    static constexpr bool PERM = true;
    bf16_t* Z; int ldz; const float* fin; const float* gn;
    __device__ __forceinline__ void operator()(const f32x4 (&acc)[2][2][4][2], const Unit& u, int wr, int wc, int fr, int fq) const {
        fr = launder(fr); fq = launder(fq);
        const int row0 = u.pm * BM + wr * 64 + fr, col0 = u.pn * BM + wc * 32 + 8 * fq;
#pragma unroll
        for (int ai = 0; ai < 2; ++ai) {
            u32x4 zq[4][2];
#pragma unroll
            for (int m = 0; m < 4; ++m)
#pragma unroll
                for (int bj = 0; bj < 2; ++bj) zq[m][bj] = *(const u32x4*)(Z + (size_t)(row0 + ai * HALF + m * 16) * ldz + col0 + bj * HALF);
#pragma unroll
            for (int m = 0; m < 4; ++m) { const int r = row0 + ai * HALF + m * 16;
#pragma unroll
                for (int bj = 0; bj < 2; ++bj) { const int c0 = col0 + bj * HALF; bf16_t* zp = Z + (size_t)r * ldz + c0;
                    const u32x4 zw = zq[m][bj]; float z[8] = {bflo(zw.x), bfhi(zw.x), bflo(zw.y), bfhi(zw.y), bflo(zw.z), bfhi(zw.z), bflo(zw.w), bfhi(zw.w)};
                    float a[8]; { const f32x4 a0 = acc[ai][bj][m][0], a1 = acc[ai][bj][m][1]; a[0] = a0[0]; a[1] = a0[1]; a[2] = a0[2]; a[3] = a0[3]; a[4] = a1[0]; a[5] = a1[1]; a[6] = a1[2]; a[7] = a1[3]; }
                    float y[8];
                    if (MODE == 0) { const f32x2 st = *(const f32x2*)(fin + ((size_t)r * 4 + (c0 >> 9)) * 2); const f32x4 g0 = *(const f32x4*)(gn + c0), g1 = *(const f32x4*)(gn + c0 + 4);
                        const float gg[8] = {g0[0], g0[1], g0[2], g0[3], g1[0], g1[1], g1[2], g1[3]};
#pragma unroll
                        for (int e = 0; e < 8; ++e) y[e] = fsilu(a[e]) * ((z[e] - st.x) * st.y * gg[e]);
                    } else {
#pragma unroll
                        for (int e = 0; e < 8; ++e) y[e] = fgelu_tanh(a[e]) * z[e];
                    }
                    u32x4 w; w.x = cvt_pk_bf16(y[0], y[1]); w.y = cvt_pk_bf16(y[2], y[3]); w.z = cvt_pk_bf16(y[4], y[5]); w.w = cvt_pk_bf16(y[6], y[7]);
                    *(u32x4*)zp = w; } }
            asm volatile("" ::: "memory"); }
    }
};
struct EpiLruGates {
    static constexpr bool PERM = false;
    const bf16_t* xc; bf16_t *la, *uu; const float *br, *bi, *lam;
    __device__ __forceinline__ void operator()(const f32x4 (&acc)[2][2][4][2], const Unit& u, int wr, int wc, int fr, int fq) const {
        fr = launder(fr); fq = launder(fq);
        const int nb = u.pn >> 1, dir = u.pn & 1;
#pragma unroll
        for (int bj = 0; bj < 2; ++bj) {
            const int ch = nb * 128 + 64 * bj + 16 * wc + 4 * fq;
            const f32x4 brv = *(const f32x4*)(br + dir * 1024 + ch), biv = *(const f32x4*)(bi + dir * 1024 + ch), lv = *(const f32x4*)(lam + dir * 1024 + ch);
            f32x4 sp;
#pragma unroll
            for (int e = 0; e < 4; ++e) sp[e] = -8.f * __logf(1.f + __expf(-lv[e]));
            u32x2 xq[2][4];
#pragma unroll
            for (int ai = 0; ai < 2; ++ai)
#pragma unroll
                for (int m = 0; m < 4; ++m) xq[ai][m] = *(const u32x2*)(xc + (size_t)(u.pm * BM + ai * HALF + wr * 64 + m * 16 + fr) * 1024 + ch);
#pragma unroll
            for (int ai = 0; ai < 2; ++ai)
#pragma unroll
                for (int m = 0; m < 4; ++m) {
                    const int r = u.pm * BM + ai * HALF + wr * 64 + m * 16 + fr;
                    const u32x2 xw = xq[ai][m]; const float xv[4] = {bflo(xw.x), bfhi(xw.x), bflo(xw.y), bfhi(xw.y)};
                    const f32x4 rp = acc[ai][bj][m][0], ip = acc[ai][bj][m][1]; f32x4 lo, uo;
#pragma unroll
                    for (int e = 0; e < 4; ++e) { const float pa = 1.f + __expf(-(rp[e] + brv[e])), pb = 1.f + __expf(-(ip[e] + biv[e])); const float inv = __builtin_amdgcn_rcpf(pa * pb);
                        const float rg = pb * inv, ig = pa * inv; const float l = rg * sp[e]; lo[e] = l; uo[e] = __builtin_amdgcn_sqrtf(fmaxf(1.f - __expf(2.f * l), 0.f)) * ig * xv[e]; }
                    st4(la + ((size_t)r * 2 + dir) * 1024 + ch, lo); st4(uu + ((size_t)r * 2 + dir) * 1024 + ch, uo);
                    asm volatile("" ::: "memory");
                }
        }
    }
};
}
using pg8::st4;

struct KArgs { const float* in[32]; float* out; unsigned char* ws; };
struct KTab { const float* const* t; };
__device__ __forceinline__ const float* inp(const KTab& a, int k) { return a.t[k]; }
__device__ __forceinline__ const float* inp(const KArgs& a, int k) { return a.in[k]; }

__device__ __forceinline__ float wave_sum(float v) {
#pragma unroll
    for (int o = 1; o < 64; o <<= 1) v += __shfl_xor(v, o);
    return v;
}
__device__ __forceinline__ float wave_max(float v) {
#pragma unroll
    for (int o = 1; o < 64; o <<= 1) v = fmaxf(v, __shfl_xor(v, o));
    return v;
}

template <int MODE>
__device__ __forceinline__ const float* wcol(const float* s0, const float* s1, int n) {
    if (MODE == 0) return s0 + n;
    if (MODE == 1) { const int gp = (n >> 5) & 7, bj = gp >> 2, wc = gp & 3; return s0 + (n & ~255) + (2 * wc + bj) * 32 + (n & 31); }
    if (MODE == 2) { const int p = n & 255, bj = p >> 7, wc = (p >> 5) & 3, nn = (p >> 4) & 1, r = p & 15; return s0 + (n & ~255) + 128 * bj + 64 * nn + 16 * wc + r; }
    { const int pn = n >> 8, nb = pn >> 1, dir = pn & 1, p = n & 255, bj = p >> 7, wc = (p >> 5) & 3, nn = (p >> 4) & 1, r = p & 15; const int cb = 64 * bj + 16 * wc + r;
      return (nn ? s1 : s0) + (size_t)(dir * 8 + nb) * 16384 + cb; }
}
template <int MODE>
__device__ __forceinline__ void wconv(const float* s0, const float* s1, int ld, int K, int N, bf16_t* WT, LAS float* scr, int lane_, int gw, int NGW) {
    const int lane = lane_id_v(); (void)lane_; asm volatile("" : "+s"(gw));
    const int nblk = N / 32, nitems = (K / 64) * nblk;
    for (int item = gw; item < nitems; item += NGW) {
        const int kb = item / nblk, nb = item % nblk, k0 = 64 * kb, n0 = 32 * nb;
        const float* cp = wcol<MODE>(s0, s1, n0 + (lane & 31));
#pragma unroll 8
        for (int i = 0; i < 32; ++i) { const int kk = 2 * i + (lane >> 5); scr[kk * 33 + (lane & 31)] = cp[(size_t)(k0 + kk) * ld]; }
        asm volatile("s_waitcnt lgkmcnt(0)" ::: "memory");
        const int c = lane & 7;
#pragma unroll
        for (int j = 0; j < 4; ++j) { const int n = (lane >> 3) + 8 * j; const LAS float* s = scr + (8 * c) * 33 + n;
            u32x4 o; o.x = cvt_pk_bf16(s[0 * 33], s[1 * 33]); o.y = cvt_pk_bf16(s[2 * 33], s[3 * 33]); o.z = cvt_pk_bf16(s[4 * 33], s[5 * 33]); o.w = cvt_pk_bf16(s[6 * 33], s[7 * 33]);
            *(u32x4*)(WT + (size_t)(n0 + n) * K + k0 + 8 * c) = o; }
        asm volatile("s_waitcnt lgkmcnt(0)" ::: "memory");
    }
}
template <class AT>
__device__ __forceinline__ void convert_layer_weights(const AT& a, unsigned char* ws, int layer, LAS unsigned char* lds, int wave, int lane, int gw, int NGW) {
    LAS float* scr = (LAS float*)(lds + wave * 8448);
    wconv<0>(inp(a, 12) + (size_t)layer * DM * DFF, nullptr, DFF, DM, DFF, (bf16_t*)(ws + WS_WUP), scr, lane, gw, NGW);
    wconv<0>(inp(a, 13) + (size_t)layer * DFF * DM, nullptr, DM, DFF, DM, (bf16_t*)(ws + WS_WDN), scr, lane, gw, NGW);
    const int kind = layer % 3, slot = layer / 3;
    if (kind == 0) {
        wconv<1>(inp(a, 14) + (size_t)slot * DM * 1536, nullptr, 1536, DM, 1536, (bf16_t*)(ws + WS_WIN), scr, lane, gw, NGW);
        wconv<0>(inp(a, 15) + (size_t)slot * DM * DM, nullptr, DM, DM, DM, (bf16_t*)(ws + WS_WOUT), scr, lane, gw, NGW);
    } else if (kind == 1) {
        wconv<2>(inp(a, 19) + (size_t)slot * DM * 6144, nullptr, 6144, DM, 4096, (bf16_t*)(ws + WS_WIN), scr, lane, gw, NGW);
        wconv<0>(inp(a, 19) + (size_t)slot * DM * 6144 + 4096, nullptr, 6144, DM, 2048, (bf16_t*)(ws + WS_WX), scr, lane, gw, NGW);
        wconv<0>(inp(a, 20) + (size_t)slot * 2048 * DM, nullptr, DM, 2048, DM, (bf16_t*)(ws + WS_WOUT), scr, lane, gw, NGW);
    } else {
        wconv<0>(inp(a, 23) + (size_t)slot * DM * 2048 + 1024, nullptr, 2048, DM, 1024, (bf16_t*)(ws + WS_WIN), scr, lane, gw, NGW);
        wconv<0>(inp(a, 23) + (size_t)slot * DM * 2048, nullptr, 2048, DM, 1024, (bf16_t*)(ws + WS_WX), scr, lane, gw, NGW);
        wconv<3>(inp(a, 26) + (size_t)slot * 2 * 8 * 16384, inp(a, 28) + (size_t)slot * 2 * 8 * 16384, 128, 128, 4096, (bf16_t*)(ws + WS_WX2), scr, lane, gw, NGW);
        wconv<0>(inp(a, 31) + (size_t)slot * DM * DM, nullptr, DM, DM, DM, (bf16_t*)(ws + WS_WOUT), scr, lane, gw, NGW);
    }
}

__device__ __forceinline__ void mod_phase(const KArgs& a, LAS unsigned char* lds, const int wv) {
    LAS float* sc = (LAS float*)lds;
    LAS float* red = (LAS float*)(lds + 36864);
    const int tid = (wv * 64 + lane_id_v());
    if (bid_s() >= 384) return;
    for (int i = tid; i < 9 * 1024; i += 512) { const int j = i >> 10, k = i & 1023; const float v = j == 0 ? inp(a, 7)[k] : inp(a, 6)[(j - 1) * 1024 + k]; sc[i] = fsilu(v); }
    __syncthreads();
    float* modt = (float*)(a.ws + WS_MOD);
    const int cl = tid & 63, ks = tid >> 6;
    for (int item = bid_s(); item < 384; item += gridDim.x) {
        const int l = item / 96, cg_ = item % 96, col = cg_ * 64 + cl;
        const float* w = inp(a, 10) + (size_t)l * DM * 6144 + col;
        float acc[9];
#pragma unroll
        for (int j = 0; j < 9; ++j) acc[j] = 0.f;
        for (int k0 = ks * 128; k0 < ks * 128 + 128; k0 += 16) {
            float wv[16];
#pragma unroll
            for (int u = 0; u < 16; ++u) wv[u] = w[(size_t)(k0 + u) * 6144];
#pragma unroll
            for (int u = 0; u < 16; ++u)
#pragma unroll
                for (int j = 0; j < 9; ++j) acc[j] += sc[j * 1024 + k0 + u] * wv[u];
        }
#pragma unroll
        for (int j = 0; j < 9; ++j) red[(ks * 9 + j) * 64 + cl] = acc[j];
        __syncthreads();
        for (int idx = tid; idx < 576; idx += 512) { const int j = idx >> 6, c2 = idx & 63; float s = inp(a, 11)[(size_t)l * 6144 + cg_ * 64 + c2];
#pragma unroll
            for (int q = 0; q < 8; ++q) s += red[(q * 9 + j) * 64 + c2];
            modt[((size_t)l * 9 + j) * 6144 + cg_ * 64 + c2] = s; }
        __syncthreads();
    }
}
__device__ __forceinline__ void cache_phase(const KArgs& a, const int wv) {
    const size_t n4 = (size_t)8 * 2 * 512 * 256 / 4;
    for (size_t i = (size_t)bid_s() * 512 + (wv * 64 + lane_id_v()); i < 2 * n4; i += (size_t)gridDim.x * 512) {
        const bool isv = i >= n4; const size_t j = isv ? i - n4 : i;
        const f32x4 v = *(const f32x4*)((isv ? inp(a, 3) : inp(a, 2)) + j * 4);
        st4((bf16_t*)(a.ws + (isv ? WS_CV : WS_CK)) + j * 4, v);
    }
}
template <bool FIRST>
__device__ __forceinline__ void norm_ld(const int r, f32x4 (&v)[4], const float* xp_, const float* xs_, const float* xres, int lane) {
    const float* xr = FIRST ? (r < NPROMPT ? xp_ + (size_t)r * DM : xs_ + (size_t)(r - NPROMPT) * DM) : nullptr;
    const bf16_t* xb = (const bf16_t*)xres + (size_t)r * 2048;
#pragma unroll
    for (int j = 0; j < 4; ++j) {
        if (FIRST) v[j] = *(const f32x4*)(xr + 4 * lane + 256 * j);
        else v[j] = ld4bf(xb + 4 * lane + 256 * j); }
}
template <bool FIRST>
__device__ __forceinline__ void norm_row(const int r, f32x4 (&v)[4], float* xres, const float* gain, const float* modl, int sh_chunk, bf16_t* hout, int lane, const float* part, const float* fixgate) {
    bf16_t* xb = (bf16_t*)xres + (size_t)r * 2048; float s = 0.f;
#pragma unroll
    for (int j = 0; j < 4; ++j) s += v[j][0] * v[j][0] + v[j][1] * v[j][1] + v[j][2] * v[j][2] + v[j][3] * v[j][3];
    if (FIRST) {
#pragma unroll
        for (int j = 0; j < 4; ++j) st4(xb + 4 * lane + 256 * j, v[j]);
    }
    if (!FIRST && part != nullptr && r >= 32768) {
        const float* gp = fixgate + (size_t)modidx(r) * 6144; s = 0.f;
#pragma unroll
        for (int j = 0; j < 4; ++j) { const int c = 4 * lane + 256 * j; const bf16_t* pp = (const bf16_t*)part + (size_t)(r - 32768) * DM + c;
            const f32x4 ps = ((ld4bf(pp) + ld4bf(pp + (size_t)4096 * DM)) + ld4bf(pp + (size_t)2 * 4096 * DM)) + ld4bf(pp + (size_t)3 * 4096 * DM);
            v[j] = v[j] + *(const f32x4*)(gp + c) * ps; st4(xb + c, v[j]);
            s += v[j][0] * v[j][0] + v[j][1] * v[j][1] + v[j][2] * v[j][2] + v[j][3] * v[j][3]; }
    }
    const float rs = rsqrtf(wave_sum(s) * (1.f / DM) + 1e-6f);
    const float* mp = modl + (size_t)modidx(r) * 6144 + sh_chunk * 1024;
#pragma unroll
    for (int j = 0; j < 4; ++j) { const int c = 4 * lane + 256 * j; const f32x4 g = *(const f32x4*)(gain + c), sh = *(const f32x4*)(mp + c), sc = *(const f32x4*)(mp + 1024 + c);
        const f32x4 y = v[j] * rs * g * (1.f + sc) + sh; st4(hout + (size_t)r * DM + c, y); }
}
template <bool FIRST>
__device__ __forceinline__ void norm_phase(const float* xp_, const float* xs_, float* xres, const float* gain, const float* modl, int sh_chunk, bf16_t* hout, int lane_, int gw, int NGW, const float* part = nullptr, const float* fixgate = nullptr) {
    const int lane = lane_id_v(); (void)lane_; asm volatile("" : "+s"(gw));
    for (int r = gw; r < MTOK; r += 3 * NGW) {
        const int r2 = r + NGW, r3 = r + 2 * NGW;
        f32x4 va[4], vb[4], vc[4];
        norm_ld<FIRST>(r, va, xp_, xs_, xres, lane);
        if (r2 < MTOK) norm_ld<FIRST>(r2, vb, xp_, xs_, xres, lane);
        if (r3 < MTOK) norm_ld<FIRST>(r3, vc, xp_, xs_, xres, lane);
        norm_row<FIRST>(r, va, xres, gain, modl, sh_chunk, hout, lane, part, fixgate);
        if (r2 < MTOK) norm_row<FIRST>(r2, vb, xres, gain, modl, sh_chunk, hout, lane, part, fixgate);
        if (r3 < MTOK) norm_row<FIRST>(r3, vc, xres, gain, modl, sh_chunk, hout, lane, part, fixgate);
    }
}

__device__ __forceinline__ bf16x8 tr8(const LAS bf16_t* p0, const LAS bf16_t* p1) {
    const s16x4 a = __builtin_amdgcn_ds_read_tr16_b64_v4i16((LAS s16x4*)p0);
    const s16x4 b = __builtin_amdgcn_ds_read_tr16_b64_v4i16((LAS s16x4*)p1);
    return (bf16x8){a[0], a[1], a[2], a[3], b[0], b[1], b[2], b[3]};
}
__device__ __forceinline__ f32x16 mfma32(bf16x8 a, bf16x8 b, f32x16 c) { return __builtin_amdgcn_mfma_f32_32x32x16_bf16(a, b, c, 0, 0, 0); }
__device__ __forceinline__ f32x4 mfma16(bf16x8 a, bf16x8 b, f32x4 c) { return __builtin_amdgcn_mfma_f32_16x16x32_bf16(a, b, c, 0, 0, 0); }
__device__ __forceinline__ float fexp2(float x) { return __builtin_amdgcn_exp2f(x); }

__device__ __forceinline__ void att_tile(const LAS bf16_t* Ks, const LAS bf16_t* Vs, const bf16x8 (&Qf)[2][4], f32x16 (&ot)[2][2], float (&mrun)[2], float (&lrun)[2],
                                         bool skipw, bool needmask, int kpos0, int qpos0, int l31, int lh, int q4, int p4, int blk) {
            if (!skipw) {
                f32x16 sc[2][2];
#pragma unroll
                for (int cb = 0; cb < 2; ++cb)
#pragma unroll
                    for (int kk = 0; kk < 2; ++kk)
#pragma unroll
                        for (int r = 0; r < 16; ++r) sc[cb][kk][r] = 0.f;
#pragma unroll
                for (int s = 0; s < 4; ++s) {
                    const bf16x8 k0 = *(const LAS bf16x8*)(Ks + l31 * 72 + 16 * s + 8 * lh), k1 = *(const LAS bf16x8*)(Ks + (32 + l31) * 72 + 16 * s + 8 * lh);
                    sc[0][0] = mfma32(k0, Qf[0][s], sc[0][0]); sc[0][1] = mfma32(k1, Qf[0][s], sc[0][1]);
                    sc[1][0] = mfma32(k0, Qf[1][s], sc[1][0]); sc[1][1] = mfma32(k1, Qf[1][s], sc[1][1]);
                }
                bf16x8 pf[2][2][2];
#pragma unroll
                for (int cb = 0; cb < 2; ++cb) {
                    const int qpos = qpos0 + cb * 32 + l31;
                    float mx = -3.0e38f;
                    if (needmask) {
#pragma unroll
                        for (int r = 0; r < 16; ++r) { const int d0 = kpos0 + (r & 3) + 8 * (r >> 2) + 4 * lh - qpos, d1 = d0 + 32;
                            if (d0 > 128 || d0 < -128) sc[cb][0][r] = -1e30f; if (d1 > 128 || d1 < -128) sc[cb][1][r] = -1e30f; }
                    }
#pragma unroll
                    for (int r = 0; r < 16; ++r) mx = fmaxf(mx, fmaxf(sc[cb][0][r], sc[cb][1][r]));
                    mx = fmaxf(mx, __shfl_xor(mx, 32));
                    const float mnew = fmaxf(mrun[cb], mx), alpha = fexp2(mrun[cb] - mnew); mrun[cb] = mnew;
                    float ls = 0.f;
#pragma unroll
                    for (int r = 0; r < 16; ++r) { sc[cb][0][r] = fexp2(sc[cb][0][r] - mnew); sc[cb][1][r] = fexp2(sc[cb][1][r] - mnew); ls += sc[cb][0][r] + sc[cb][1][r]; }
                    lrun[cb] = lrun[cb] * alpha + ls;
                    if (__builtin_amdgcn_ballot_w64(alpha != 1.f) != 0ull) { ot[0][cb] = ot[0][cb] * alpha; ot[1][cb] = ot[1][cb] * alpha; }
#pragma unroll
                    for (int kk = 0; kk < 2; ++kk)
#pragma unroll
                        for (int s2 = 0; s2 < 2; ++s2) {
                            u32x4 w0;
                            w0.x = cvt_pk_bf16(sc[cb][kk][8 * s2 + 0], sc[cb][kk][8 * s2 + 1]); w0.y = cvt_pk_bf16(sc[cb][kk][8 * s2 + 2], sc[cb][kk][8 * s2 + 3]);
                            w0.z = cvt_pk_bf16(sc[cb][kk][8 * s2 + 4], sc[cb][kk][8 * s2 + 5]); w0.w = cvt_pk_bf16(sc[cb][kk][8 * s2 + 6], sc[cb][kk][8 * s2 + 7]);
                            pf[cb][kk][s2] = __builtin_bit_cast(bf16x8, w0);
                        }
                }
#pragma unroll
                for (int db = 0; db < 2; ++db)
#pragma unroll
                    for (int kbk = 0; kbk < 2; ++kbk)
#pragma unroll
                        for (int s2 = 0; s2 < 2; ++s2) {
                            const LAS bf16_t* vp = Vs + (kbk * 32 + 16 * s2 + 4 * lh + q4) * 72 + 32 * db + 16 * blk + 4 * p4;
                            const bf16x8 vf = tr8(vp, vp + 8 * 72);
                            ot[db][0] = mfma32(vf, pf[0][kbk][s2], ot[db][0]);
                            ot[db][1] = mfma32(vf, pf[1][kbk][s2], ot[db][1]);
                        }
            }
}
__device__ __forceinline__ void attn_phase(LAS unsigned char* lds, const bf16_t* qb, const bf16_t* kb, const bf16_t* vb, const bf16_t* ck, const bf16_t* cv, bf16_t* ob, const float* sink, const int wv) {
    LAS bf16_t* Ks = (LAS bf16_t*)lds; LAS bf16_t* Vs = (LAS bf16_t*)(lds + 9216);
    const int wid = wv, lane = lane_id_v(), tid = wid * 64 + lane, g = wid >> 1, qh = wid & 1;
    const int l31 = lane & 31, lh = lane >> 5, q4 = (lane & 15) >> 2, p4 = lane & 3, blk = (lane >> 4) & 1;
    const int skey = tid >> 3, sdc = tid & 7;
    for (int it = bid_s(); it < 1152; it += gridDim.x) {
        int b, hk, seqrow0, T, qbase, nlat, latk0, nctx; bool masked;
        if (it < 1024) { b = it >> 7; const int n = (it >> 2) & 31; hk = it & 3; seqrow0 = NPROMPT + b * 4096; T = 4096; qbase = n * 128; nlat = 6; latk0 = qbase - 128; nctx = 8; masked = true; }
        else { const int i2 = it - 1024; b = i2 >> 3; hk = (i2 >> 1) & 3; seqrow0 = b * 256; T = 256; qbase = (i2 & 1) * 128; nlat = 4; latk0 = 0; nctx = 0; masked = false; }
        const int h = hk * 4 + g, qpos0 = qbase + 64 * qh, ntiles = nlat + nctx;
        bf16x8 Qf[2][4];
#pragma unroll
        for (int cb = 0; cb < 2; ++cb)
#pragma unroll
            for (int s = 0; s < 4; ++s) Qf[cb][s] = *(const bf16x8*)(qb + (size_t)(seqrow0 + qpos0 + cb * 32 + l31) * 1024 + h * 64 + 16 * s + 8 * lh);
        float mrun[2], lrun[2]; f32x16 ot[2][2];
        const float sk = sink[h] * LOG2E;
        mrun[0] = sk; mrun[1] = sk; lrun[0] = lh == 0 ? 1.f : 0.f; lrun[1] = lrun[0];
#pragma unroll
        for (int i = 0; i < 2; ++i)
#pragma unroll
            for (int j = 0; j < 2; ++j)
#pragma unroll
                for (int r = 0; r < 16; ++r) ot[i][j][r] = 0.f;
        int ti = 0; while (ti < nlat && latk0 + 64 * ti < 0) ++ti;
        u32x4 kr0, vr0, kr1, vr1;
#define ATT_NEXT(tt) (((tt) + 1 < nlat && latk0 + 64 * ((tt) + 1) >= T) ? nlat : (tt) + 1)
#define ATT_LD(tt, KR, VR) do { const bf16_t *kp_, *vp_; if ((tt) < nlat) { const size_t o_ = (size_t)(seqrow0 + latk0 + 64 * (tt) + skey) * 256 + hk * 64 + sdc * 8; kp_ = kb + o_; vp_ = vb + o_; } \
            else { const size_t o_ = ((size_t)b * 1024 + 64 * ((tt) - nlat) + skey) * 256 + hk * 64 + sdc * 8; kp_ = ck + o_; vp_ = cv + o_; } KR = *(const u32x4*)kp_; VR = *(const u32x4*)vp_; } while (0)
#define ATT_FLAGS(cur_, SK, NM, KP) const bool SK##l_ = (cur_) < nlat; const int KP = latk0 + 64 * (cur_); bool SK = false, NM = false; \
            if (masked && SK##l_) { SK = (KP > qpos0 + 63 + 128) || (KP + 63 < qpos0 - 128); NM = (KP < qpos0 - 64) || (KP > qpos0 + 64); }
        int tp = ti, tq = ATT_NEXT(tp);
        ATT_LD(tp, kr0, vr0); ATT_LD(tq, kr1, vr1);
        while (tp < ntiles) {
            __syncthreads();
            *(LAS u32x4*)(Ks + skey * 72 + sdc * 8) = kr0; *(LAS u32x4*)(Vs + skey * 72 + sdc * 8) = vr0;
            *(LAS u32x4*)(Ks + 9216 + skey * 72 + sdc * 8) = kr1; *(LAS u32x4*)(Vs + 9216 + skey * 72 + sdc * 8) = vr1;
            __syncthreads();
            const int c0 = tp, c1 = tq;
            tp = ATT_NEXT(tq); tq = ATT_NEXT(tp);
            if (tp < ntiles) { ATT_LD(tp, kr0, vr0); ATT_LD(tq, kr1, vr1); }
            { ATT_FLAGS(c0, sk0, nm0, kp0) att_tile(Ks, Vs, Qf, ot, mrun, lrun, sk0, nm0, kp0, qpos0, l31, lh, q4, p4, blk); }
            { ATT_FLAGS(c1, sk1, nm1, kp1) att_tile(Ks + 9216, Vs + 9216, Qf, ot, mrun, lrun, sk1, nm1, kp1, qpos0, l31, lh, q4, p4, blk); }
        }
#undef ATT_NEXT
#undef ATT_LD
#undef ATT_FLAGS
#pragma unroll
        for (int cb = 0; cb < 2; ++cb) {
            const float lt = lrun[cb] + __shfl_xor(lrun[cb], 32), inv = 1.f / lt;
            bf16_t* orow = ob + (size_t)(seqrow0 + qpos0 + cb * 32 + l31) * 1024 + h * 64;
#pragma unroll
            for (int db = 0; db < 2; ++db)
#pragma unroll
                for (int rg = 0; rg < 4; ++rg) { const f32x4 v = {ot[db][cb][4 * rg] * inv, ot[db][cb][4 * rg + 1] * inv, ot[db][cb][4 * rg + 2] * inv, ot[db][cb][4 * rg + 3] * inv};
                    st4(orow + db * 32 + 8 * rg + 4 * lh, v); }
        }
    }
}

__device__ __forceinline__ void ret_scan_phase(LAS unsigned char* lds, const bf16_t* qb, const bf16_t* kb, const bf16_t* vb, bf16_t* ob, float* statp, const float* logdec, const float* state_in, float* state_out, const int wv) {
    constexpr int QST = 264, VST = 72;
    LAS bf16_t* Qs = (LAS bf16_t*)lds; LAS bf16_t* Ks = (LAS bf16_t*)(lds + 33792); LAS bf16_t* ST = (LAS bf16_t*)(lds + 67584);
    LAS bf16_t* Vs0 = (LAS bf16_t*)(lds + 101376); LAS bf16_t* Vw = (LAS bf16_t*)(lds + 110592); LAS bf16_t* Ps = (LAS bf16_t*)(lds + 119808);
    const int w = wv, lane = lane_id_v(), tid = w * 64 + lane, c16 = lane & 15, g = lane >> 4, q4 = (lane & 15) >> 2, p4 = lane & 3;
    const int itl = w >> 1, eb = 2 * (w & 1);
    for (int rnd = 0; rnd < 3; ++rnd) {
        const int bid = bid_s(), xx = bid & 7, ss = bid >> 3;
        const bool samp = rnd == 0; const int gidx = (samp ? 0 : (rnd - 1) * 32) + xx * 4 + (ss >> 3); const int b = gidx >> 2, head = gidx & 3, sl = ss & 7;
        const int seqrow0 = samp ? NPROMPT + b * 4096 : b * 256, T = samp ? 4096 : 256, nc = T / 64;
        for (int dir = 0; dir < 2; ++dir) {
            const float lg2 = logdec[dir * 4 + head] * LOG2E;
            f32x4 sacc[2][4];
#pragma unroll
            for (int dd = 0; dd < 2; ++dd)
#pragma unroll
                for (int et = 0; et < 4; ++et)
#pragma unroll
                    for (int r = 0; r < 4; ++r)
                        sacc[dd][et][r] = samp ? state_in[((((size_t)b * 2 + dir) * 4 + head) * 256 + 32 * w + 16 * dd + 4 * g + r) * 512 + sl * 64 + 16 * et + c16] : 0.f;
            __syncthreads();
#pragma unroll
            for (int dd = 0; dd < 2; ++dd)
#pragma unroll
                for (int et = 0; et < 4; ++et) { u32x2 wv; wv.x = cvt_pk_bf16(sacc[dd][et][0], sacc[dd][et][1]); wv.y = cvt_pk_bf16(sacc[dd][et][2], sacc[dd][et][3]);
                    *(LAS u32x2*)(ST + (16 * et + c16) * QST + 32 * w + 16 * dd + 4 * g) = wv; }
            u32x4 qreg[4], kreg[4], vreg;
#define RET_LOAD(cc_) do { const int t0_ = 64 * (cc_); _Pragma("unroll") for (int p = 0; p < 4; ++p) { const int idx = tid + 512 * p, row = idx >> 5, ch = idx & 31; \
                const size_t o_ = (size_t)(seqrow0 + t0_ + row) * 1024 + head * 256 + ch * 8; qreg[p] = *(const u32x4*)(qb + o_); kreg[p] = *(const u32x4*)(kb + o_); } \
                vreg = *(const u32x4*)(vb + (size_t)(seqrow0 + t0_ + (tid >> 3)) * 2048 + head * 512 + sl * 64 + (tid & 7) * 8); } while (0)
            RET_LOAD(dir ? nc - 1 : 0);
            const float gC = fexp2(lg2 * 64.f);
            float dec[2][4];
#pragma unroll
            for (int x = 0; x < 2; ++x)
#pragma unroll
                for (int r = 0; r < 4; ++r) { const int i = itl * 16 + c16, j = (eb + x) * 16 + 4 * g + r; const int df = dir ? j - i : i - j; const bool ok = dir ? df > 0 : df >= 0; dec[x][r] = ok ? fexp2(lg2 * (float)df) : 0.f; }
            const float wq_c = fexp2(lg2 * (float)(dir ? 64 - (itl * 16 + c16) : (itl * 16 + c16) + 1));
            const float wsj_c = fexp2(lg2 * (float)(dir ? (tid >> 3) : 63 - (tid >> 3)));
            for (int cc = 0; cc < nc; ++cc) {
                const int c = dir ? nc - 1 - cc : cc, t0 = 64 * c;
                LAS bf16_t* Vs = Vs0 + (cc & 1) * 13824;
#pragma unroll
                for (int p = 0; p < 4; ++p) { const int idx = tid + 512 * p, row = idx >> 5, ch = idx & 31; *(LAS u32x4*)(Qs + row * QST + ch * 8) = qreg[p]; *(LAS u32x4*)(Ks + row * QST + ch * 8) = kreg[p]; }
                { const int row = tid >> 3, ch = tid & 7; *(LAS u32x4*)(Vs + row * VST + ch * 8) = vreg;
                  const float wsj = wsj_c; u32x4 sv;
                  sv.x = cvt_pk_bf16(bflo(vreg.x) * wsj, bfhi(vreg.x) * wsj); sv.y = cvt_pk_bf16(bflo(vreg.y) * wsj, bfhi(vreg.y) * wsj);
                  sv.z = cvt_pk_bf16(bflo(vreg.z) * wsj, bfhi(vreg.z) * wsj); sv.w = cvt_pk_bf16(bflo(vreg.w) * wsj, bfhi(vreg.w) * wsj);
                  *(LAS u32x4*)(Vw + row * VST + ch * 8) = sv; }
                __syncthreads();
                if (cc + 1 < nc) RET_LOAD(dir ? nc - 2 - cc : cc + 1);
                const int orow = seqrow0 + t0 + itl * 16 + c16; bf16_t* op = ob + (size_t)orow * 2048 + head * 512 + sl * 64 + 4 * g;
                u32x2 pw0 = {0u, 0u}, pw1 = {0u, 0u};
                if (dir) { pw0 = *(const u32x2*)(op + eb * 16); pw1 = *(const u32x2*)(op + (eb + 1) * 16); }
                bf16x8 qf[8];
#pragma unroll
                for (int ks = 0; ks < 8; ++ks) qf[ks] = *(const LAS bf16x8*)(Qs + (itl * 16 + c16) * QST + 32 * ks + 8 * g);
#pragma unroll
                for (int x = 0; x < 2; ++x) {
                    const int jt = eb + x; f32x4 pt = {0.f, 0.f, 0.f, 0.f};
#pragma unroll
                    for (int ks = 0; ks < 8; ++ks) pt = mfma16(*(const LAS bf16x8*)(Ks + (jt * 16 + c16) * QST + 32 * ks + 8 * g), qf[ks], pt);
                    const int i = itl * 16 + c16; f32x4 pv;
#pragma unroll
                    for (int r = 0; r < 4; ++r) pv[r] = pt[r] * dec[x][r];
                    u32x2 wv; wv.x = cvt_pk_bf16(pv[0], pv[1]); wv.y = cvt_pk_bf16(pv[2], pv[3]);
                    *(LAS u32x2*)(Ps + i * VST + jt * 16 + 4 * g) = wv;
                }
                f32x4 oc[2];
                { const float wq = wq_c;
#pragma unroll
                  for (int x = 0; x < 2; ++x) { const int et = eb + x; f32x4 o = {0.f, 0.f, 0.f, 0.f};
#pragma unroll
                      for (int ks = 0; ks < 8; ++ks) o = mfma16(*(const LAS bf16x8*)(ST + (et * 16 + c16) * QST + 32 * ks + 8 * g), qf[ks], o);
                      oc[x] = o * wq; } }
#pragma unroll
                for (int dd = 0; dd < 2; ++dd)
#pragma unroll
                    for (int et = 0; et < 4; ++et) sacc[dd][et] = sacc[dd][et] * gC;
#pragma unroll
                for (int ks = 0; ks < 2; ++ks) {
                    bf16x8 bfr[4];
#pragma unroll
                    for (int et = 0; et < 4; ++et) { const LAS bf16_t* vp = Vw + (32 * ks + 8 * g + q4) * VST + 16 * et + 4 * p4; bfr[et] = tr8(vp, vp + 4 * VST); }
#pragma unroll
                    for (int dd = 0; dd < 2; ++dd) { const LAS bf16_t* kp = Ks + (32 * ks + 8 * g + q4) * QST + 32 * w + 16 * dd + 4 * p4; const bf16x8 af = tr8(kp, kp + 4 * QST);
#pragma unroll
                        for (int et = 0; et < 4; ++et) sacc[dd][et] = mfma16(af, bfr[et], sacc[dd][et]); }
                }
                __syncthreads();
#pragma unroll
                for (int x = 0; x < 2; ++x) { const int et = eb + x;
#pragma unroll
                    for (int ks = 0; ks < 2; ++ks) { const LAS bf16_t* vp = Vs + (32 * ks + 8 * g + q4) * VST + 16 * et + 4 * p4;
                        oc[x] = mfma16(tr8(vp, vp + 4 * VST), *(const LAS bf16x8*)(Ps + (itl * 16 + c16) * VST + 32 * ks + 8 * g), oc[x]); } }
                { const int row = orow;
                  if (dir == 0) { st4(op + eb * 16, oc[0]); st4(op + (eb + 1) * 16, oc[1]); }
                  else { float s1 = 0.f, s2 = 0.f;
#pragma unroll
                      for (int x = 0; x < 2; ++x) { bf16_t* o2 = op + (eb + x) * 16; const u32x2 pw = x ? pw1 : pw0; f32x4 f = oc[x];
                          f[0] += bflo(pw.x); f[1] += bfhi(pw.x); f[2] += bflo(pw.y); f[3] += bfhi(pw.y); st4(o2, f);
                          s1 += f[0] + f[1] + f[2] + f[3]; s2 += f[0] * f[0] + f[1] * f[1] + f[2] * f[2] + f[3] * f[3]; }
                      s1 += __shfl_xor(s1, 16); s1 += __shfl_xor(s1, 32); s2 += __shfl_xor(s2, 16); s2 += __shfl_xor(s2, 32);
                      if (g == 0) *(f32x2*)(statp + (((size_t)row * 4 + head) * 16 + sl * 2 + (w & 1)) * 2) = (f32x2){s1, s2}; } }
#pragma unroll
                for (int dd = 0; dd < 2; ++dd)
#pragma unroll
                    for (int et = 0; et < 4; ++et) { u32x2 wv; wv.x = cvt_pk_bf16(sacc[dd][et][0], sacc[dd][et][1]); wv.y = cvt_pk_bf16(sacc[dd][et][2], sacc[dd][et][3]);
                        *(LAS u32x2*)(ST + (16 * et + c16) * QST + 32 * w + 16 * dd + 4 * g) = wv; }
            }
#undef RET_LOAD
            if (!samp) {
#pragma unroll
                for (int dd = 0; dd < 2; ++dd)
#pragma unroll
                    for (int et = 0; et < 4; ++et)
#pragma unroll
                        for (int r = 0; r < 4; ++r)
                            state_out[((((size_t)b * 2 + dir) * 4 + head) * 256 + 32 * w + 16 * dd + 4 * g + r) * 512 + sl * 64 + 16 * et + c16] = sacc[dd][et][r];
            }
        }
    }
}
__device__ __forceinline__ void ret_fin_phase(const float* statp, float* fin, const int wv) {
    for (int i = bid_s() * 512 + (wv * 64 + lane_id_v()); i < MTOK * 4; i += gridDim.x * 512) {
        float s1 = 0.f, s2 = 0.f;
#pragma unroll
        for (int p = 0; p < 16; ++p) { const f32x2 v = *(const f32x2*)(statp + ((size_t)i * 16 + p) * 2); s1 += v.x; s2 += v.y; }
        const float mu = s1 * (1.f / 512.f), var = fmaxf(s2 * (1.f / 512.f) - mu * mu, 0.f);
        *(f32x2*)(fin + (size_t)i * 2) = (f32x2){mu, rsqrtf(var + 1e-6f)};
    }
}

__device__ __forceinline__ void lru_conv_phase(const bf16_t* __restrict__ xr, bf16_t* __restrict__ xc, const float* __restrict__ cw, const float* __restrict__ cbias, const int wv) {
    for (size_t i = (size_t)bid_s() * 512 + (wv * 64 + lane_id_v()); i < (size_t)(MTOK / 8) * 128; i += (size_t)gridDim.x * 512) {
        const int r0 = (int)(i >> 7) * 8, c8 = (int)(i & 127) * 8;
        const int t0 = r0 < NPROMPT ? (r0 & 255) : ((r0 - NPROMPT) & 4095), T = r0 < NPROMPT ? 256 : 4096;
        u32x4 xw[11];
#pragma unroll
        for (int k = 0; k < 11; ++k) { const int tt = t0 - 2 + k; xw[k] = (u32x4){0u, 0u, 0u, 0u};
            if (tt >= 0 && tt < T) xw[k] = *(const u32x4*)(xr + (size_t)(r0 - 2 + k) * 1024 + c8); }
        f32x4 w0[4], w1[4];
#pragma unroll
        for (int jj = 0; jj < 4; ++jj) { w0[jj] = *(const f32x4*)(cw + jj * 1024 + c8); w1[jj] = *(const f32x4*)(cw + jj * 1024 + c8 + 4); }
        const f32x4 b0 = *(const f32x4*)(cbias + c8), b1 = *(const f32x4*)(cbias + c8 + 4);
#pragma unroll
        for (int rr = 0; rr < 8; ++rr) {
            f32x4 a0 = b0, a1 = b1;
#pragma unroll
            for (int jj = 0; jj < 4; ++jj) { const u32x4 q = xw[rr + jj];
                a0 = a0 + w0[jj] * (f32x4){bflo(q.x), bfhi(q.x), bflo(q.y), bfhi(q.y)}; a1 = a1 + w1[jj] * (f32x4){bflo(q.z), bfhi(q.z), bflo(q.w), bfhi(q.w)}; }
            u32x4 o; o.x = cvt_pk_bf16(a0[0], a0[1]); o.y = cvt_pk_bf16(a0[2], a0[3]); o.z = cvt_pk_bf16(a1[0], a1[1]); o.w = cvt_pk_bf16(a1[2], a1[3]);
            *(u32x4*)(xc + (size_t)(r0 + rr) * 1024 + c8) = o;
        }
    }
}
__device__ __forceinline__ void lru_scanA_phase(const bf16_t* __restrict__ la, const bf16_t* __restrict__ uu, float* __restrict__ agg, const int wv) {
    constexpr int NS = 8 * 2 * 32 * 512, NP = 16 * 2 * 2 * 512;
    for (int idx = bid_s() * 512 + (wv * 64 + lane_id_v()); idx < NS + NP; idx += gridDim.x * 512) {
        int cp, dir, row0, segidx;
        if (idx < NS) { cp = idx & 511; const int seg = (idx >> 9) & 31; dir = (idx >> 14) & 1; const int b = idx >> 15; row0 = NPROMPT + b * 4096 + seg * 128; segidx = (b * 2 + dir) * 32 + seg; }
        else { const int i2 = idx - NS; cp = i2 & 511; const int seg = (i2 >> 9) & 1; dir = (i2 >> 10) & 1; const int b = i2 >> 11; row0 = b * 256 + seg * 128; segidx = 512 + (b * 2 + dir) * 2 + seg; }
        float L0 = 0.f, L1 = 0.f, H0 = 0.f, H1 = 0.f;
        for (int s0 = 0; s0 < 128; s0 += 16) {
            unsigned lw[16], uw[16];
#pragma unroll
            for (int j = 0; j < 16; ++j) { const int r = row0 + (dir ? 127 - (s0 + j) : s0 + j); const size_t o = ((size_t)r * 2 + dir) * 1024 + 2 * cp; lw[j] = *(const unsigned*)(la + o); uw[j] = *(const unsigned*)(uu + o); }
#pragma unroll
            for (int j = 0; j < 16; ++j) { const float l0 = bflo(lw[j]), l1 = bfhi(lw[j]); H0 = __expf(l0) * H0 + bflo(uw[j]); H1 = __expf(l1) * H1 + bfhi(uw[j]); L0 += l0; L1 += l1; }
        }
        *(f32x4*)(agg + ((size_t)segidx * 1024 + 2 * cp) * 2) = (f32x4){L0, H0, L1, H1};
    }
}
__device__ __forceinline__ void lru_scanC_phase(const bf16_t* __restrict__ la, const bf16_t* __restrict__ uu, const float* __restrict__ agg, bf16_t* __restrict__ rec, const float* __restrict__ st_in, float* __restrict__ st_out, const int wv) {
    constexpr int NS = 8 * 32 * 512, NP = 16 * 2 * 512;
    for (int idx = bid_s() * 512 + (wv * 64 + lane_id_v()); idx < NS + NP; idx += gridDim.x * 512) {
        int cp, seg, b, row0, nseg, segb; const bool samp = idx < NS;
        if (samp) { cp = idx & 511; seg = (idx >> 9) & 31; b = idx >> 14; row0 = NPROMPT + b * 4096 + seg * 128; nseg = 32; segb = b * 64; }
        else { const int i2 = idx - NS; cp = i2 & 511; seg = (i2 >> 9) & 1; b = i2 >> 10; row0 = b * 256 + seg * 128; nseg = 2; segb = 512 + b * 4; }
        float h0 = 0.f, h1 = 0.f;
        if (samp) { const f32x2 v = *(const f32x2*)(st_in + (b * 2 + 0) * 1024 + 2 * cp); h0 = v.x; h1 = v.y; }
        for (int s2 = 0; s2 < seg; ++s2) { const f32x4 v = *(const f32x4*)(agg + ((size_t)(segb + s2) * 1024 + 2 * cp) * 2); h0 = __expf(v[0]) * h0 + v[1]; h1 = __expf(v[2]) * h1 + v[3]; }
        for (int s0 = 0; s0 < 128; s0 += 16) {
            unsigned lw[16], uw[16];
#pragma unroll
            for (int j = 0; j < 16; ++j) { const size_t o = ((size_t)(row0 + s0 + j) * 2 + 0) * 1024 + 2 * cp; lw[j] = *(const unsigned*)(la + o); uw[j] = *(const unsigned*)(uu + o); }
#pragma unroll
            for (int j = 0; j < 16; ++j) { h0 = __expf(bflo(lw[j])) * h0 + bflo(uw[j]); h1 = __expf(bfhi(lw[j])) * h1 + bfhi(uw[j]); *(unsigned*)(rec + (size_t)(row0 + s0 + j) * 1024 + 2 * cp) = cvt_pk_bf16(h0, h1); }
        }
        if (!samp && seg == nseg - 1) *(f32x2*)(st_out + (b * 2 + 0) * 1024 + 2 * cp) = (f32x2){h0, h1};
        h0 = 0.f; h1 = 0.f;
        if (samp) { const f32x2 v = *(const f32x2*)(st_in + (b * 2 + 1) * 1024 + 2 * cp); h0 = v.x; h1 = v.y; }
        for (int s2 = nseg - 1; s2 > seg; --s2) { const f32x4 v = *(const f32x4*)(agg + ((size_t)(segb + nseg + s2) * 1024 + 2 * cp) * 2); h0 = __expf(v[0]) * h0 + v[1]; h1 = __expf(v[2]) * h1 + v[3]; }
        for (int s0 = 0; s0 < 128; s0 += 16) {
            unsigned lw[16], uw[16], rw[16];
#pragma unroll
            for (int j = 0; j < 16; ++j) { const int r = row0 + 127 - (s0 + j); const size_t o = ((size_t)r * 2 + 1) * 1024 + 2 * cp; lw[j] = *(const unsigned*)(la + o); uw[j] = *(const unsigned*)(uu + o); rw[j] = *(const unsigned*)(rec + (size_t)r * 1024 + 2 * cp); }
#pragma unroll
            for (int j = 0; j < 16; ++j) { const int r = row0 + 127 - (s0 + j); h0 = __expf(bflo(lw[j])) * h0 + bflo(uw[j]); h1 = __expf(bfhi(lw[j])) * h1 + bfhi(uw[j]);
                *(unsigned*)(rec + (size_t)r * 1024 + 2 * cp) = cvt_pk_bf16(bflo(rw[j]) + h0, bfhi(rw[j]) + h1); }
        }
        if (!samp && seg == 0) *(f32x2*)(st_out + (b * 2 + 1) * 1024 + 2 * cp) = (f32x2){h0, h1};
    }
}

#ifndef REP_BAR
#define REP_BAR 1
#endif
#ifndef REP_ATT
#define REP_ATT 1
#endif
#ifndef REP_RET
#define REP_RET 1
#endif
#ifndef REP_LRU
#define REP_LRU 1
#endif
#ifndef REP_UP
#define REP_UP 1
#endif
#ifndef REP_NORM
#define REP_NORM 1
#endif
__device__ __forceinline__ int opq(int n) { asm volatile("" : "+s"(n)); return n; }
constexpr int LDS_BYTES = 147456;
constexpr size_t WS_BAR = 4096;
#define XB_TMO      128
#define XB_XCNT(j)  (256  + 64 * (j))
#define XB_XSUB(j)  (1280 + 64 * (j))
#define XB_XGEN(j)  (2304 + 64 * (j))
#define XB_TOP      3328
#define XB_TOPGEN   3392
#define XCD_BAR_WORDS 3456
#define XB_SPIN_CAP (1u << 22)
__device__ __forceinline__ unsigned xb_ld(unsigned* p)              { return __hip_atomic_load(p, __ATOMIC_RELAXED, __HIP_MEMORY_SCOPE_AGENT); }
__device__ __forceinline__ unsigned xb_add(unsigned* p, unsigned v) { return __hip_atomic_fetch_add(p, v, __ATOMIC_RELAXED, __HIP_MEMORY_SCOPE_AGENT); }
__device__ __forceinline__ unsigned xb_xcc_id() { return (unsigned)__builtin_amdgcn_s_getreg((3 << 11) | 20) & 0xFu; }
#define XB_SPIN(cond, bar) do { unsigned _sp = 0; while (cond) { __builtin_amdgcn_s_sleep(1); \
    if ((++_sp & 255u) == 0u) { if (xb_ld(&(bar)[XB_TMO])) break; if (_sp > XB_SPIN_CAP) { atomicAdd(&(bar)[XB_TMO], 1u); break; } } } } while (0)
__device__ __forceinline__ void xcd_barrier_complete(unsigned* bar, unsigned x, unsigned& nloc, unsigned& nx) {
    const unsigned G = gridDim.x;
    unsigned sum, cnt, mine, sp = 0u;
    for (;;) {
        sum = 0u; cnt = 0u; mine = 0u;
#pragma unroll
        for (unsigned j = 0; j < 16; ++j) { const unsigned c = xb_ld(&bar[XB_XCNT(j)]); sum += c; cnt += (c > 0u) ? 1u : 0u; mine = (j == x) ? c : mine; }
        if (sum == G) break;
        __builtin_amdgcn_s_sleep(1);
        if ((++sp & 255u) == 0u) { if (xb_ld(&bar[XB_TMO])) break; if (sp > XB_SPIN_CAP) { atomicAdd(&bar[XB_TMO], 1u); break; } }
    }
    nloc = mine > 0u ? mine : 1u; nx = cnt > 0u ? cnt : 1u;
}
__device__ __forceinline__ void gbar(unsigned* bar, volatile LAS unsigned* st, const int wv) {
    asm volatile("s_waitcnt vmcnt(0) lgkmcnt(0)" ::: "memory");
    __syncthreads();
    if (wv == 0) {
      if (lane_id_v() == 0) {
        const unsigned x = xb_xcc_id();
        unsigned nloc = st[0], nx = st[1];
        if (nloc == 0u) { xcd_barrier_complete(bar, x, nloc, nx); st[0] = nloc; st[1] = nx; }
        const unsigned old = xb_add(&bar[XB_XSUB(x)], 1u);
        const unsigned gen = old / nloc;
        if (old + 1u == (gen + 1u) * nloc) {
            __builtin_amdgcn_fence(__ATOMIC_RELEASE, "agent");
            asm volatile("s_waitcnt vmcnt(0)" ::: "memory");
            const unsigned og = xb_add(&bar[XB_TOP], 1u);
            const unsigned tg = og / nx;
            if (og + 1u == (tg + 1u) * nx) xb_add(&bar[XB_TOPGEN], 1u);
            else XB_SPIN(xb_ld(&bar[XB_TOPGEN]) == tg, bar);
            __builtin_amdgcn_fence(__ATOMIC_ACQUIRE, "agent");
            xb_add(&bar[XB_XGEN(x)], 1u);
            asm volatile("s_waitcnt vmcnt(0)" ::: "memory");
        } else {
            XB_SPIN(xb_ld(&bar[XB_XGEN(x)]) == gen, bar);
            __builtin_amdgcn_fence(__ATOMIC_ACQUIRE, "agent");
            asm volatile("s_waitcnt vmcnt(0)" ::: "memory");
        }
      }
    }
    __syncthreads();
}
__global__ void __launch_bounds__(512, 2) fwd_mega(KArgs a) {
    extern __shared__ __attribute__((aligned(16))) unsigned char lds_raw[];
    LAS unsigned char* lds = (LAS unsigned char*)lds_raw;
    cg::this_grid().sync();
    volatile LAS unsigned* bst = (volatile LAS unsigned*)(lds + 143360);
    if (wave_id_s() == 0 && lane_id_v() == 0) { bst[0] = 0u; bst[1] = 0u; const unsigned xc_ = xb_xcc_id();
        const unsigned slot_ = xb_add(&((unsigned*)(karg_ptr(264) + WS_BAR))[XB_XCNT(xc_)], 1u); bst[2] = blockIdx.x; bst[3] = (xc_ << 8) | slot_; }
    __syncthreads();
    const int wave = wave_id_s(), lane = 0, G = gridDim.x, gw = bid_s() * 8 + wave, NGW = G * 8;
#define ws karg_ptr(264)
#define XR ((float*)karg_ptr(256))
#define modt ((float*)(ws + WS_MOD))
#define hbuf ((bf16_t*)(ws + WS_H))
#define WUP ((bf16_t*)(ws + WS_WUP))
#define WDN ((bf16_t*)(ws + WS_WDN))
#define WIN ((bf16_t*)(ws + WS_WIN))
#define WOUT ((bf16_t*)(ws + WS_WOUT))
#define WX ((bf16_t*)(ws + WS_WX))
#define WX2 ((bf16_t*)(ws + WS_WX2))
    mod_phase(a, lds, wave); __syncthreads();
    cache_phase(a, wave);
    convert_layer_weights(a, ws, 0, lds, wave, lane, gw, NGW);
    if (bid_s() == 0 && wave == 0) { const int l_ = lane_id_v(); if (l_ < 32) ((const float**)ws)[l_] = a.in[l_]; }
    for (int rb_ = opq(REP_BAR); rb_ > 0; --rb_) gbar((unsigned*)(ws + WS_BAR), bst, wave);
    if (wave == 0 && lane_id_v() == 0) {
        unsigned* bar_ = (unsigned*)(ws + WS_BAR); bool ok_ = gridDim.x == 256;
        for (unsigned j = 0; j < 16; ++j) { const unsigned c_ = xb_ld(&bar_[XB_XCNT(j)]); ok_ = ok_ && (c_ == (j < 8 ? 32u : 0u)); }
        const unsigned v_ = bst[3]; if (ok_) bst[2] = (v_ & 255u) * 8u + (v_ >> 8);
    }
    __syncthreads();
#define tb (KTab{(const float* const*)ws})
    constexpr int KS = 1;
    for (int layer = 0; layer < 4; ++layer) {
        const int kind = layer % 3, slot = layer / 3;
#define modl (modt + (size_t)layer * 9 * 6144)
        pg8::StaticOrder S;
        if (layer == 0) norm_phase<true>(inp(tb, 0), inp(tb, 1), XR, inp(tb, 8), modl, 0, hbuf, lane, gw, NGW);
        else { norm_phase<false>(nullptr, nullptr, XR, inp(tb, 8) + layer * DM, modl, 0, hbuf, lane, gw, NGW, KS ? (const float*)(ws + WS_PART_M) : nullptr, modl - 9 * 6144 + 5 * 1024); __syncthreads(); convert_layer_weights(tb, ws, layer, lds, wave, lane, gw, NGW); }
        for (int rb_ = opq(REP_BAR); rb_ > 0; --rb_) gbar((unsigned*)(ws + WS_BAR), bst, wave);
        if (kind == 0) {
            bf16_t *q = (bf16_t*)(ws + WS_AQ), *k = (bf16_t*)(ws + WS_AK), *v = (bf16_t*)(ws + WS_AV), *o = (bf16_t*)(ws + WS_AO);
            { pg8::Gemm g{hbuf, WIN, MTOK, 1536, 1024, 1024, 1024, 31, 0}; S.init(MTOK, 1536, G, bid_s());
              pg8::EpiAttnQKV E{q, k, v, XR + OUT_K, XR + OUT_V, inp(tb, 16) + slot * 64, inp(tb, 17) + slot * 64, slot};
              pg8::gemm_phase(lds, g, S, E, wave); }
            for (int rb_ = opq(REP_BAR); rb_ > 0; --rb_) gbar((unsigned*)(ws + WS_BAR), bst, wave);
            for (int rp_ = opq(REP_ATT); rp_ > 0; --rp_) attn_phase(lds, q, k, v, (const bf16_t*)(ws + WS_CK) + (size_t)slot * 512 * 256, (const bf16_t*)(ws + WS_CV) + (size_t)slot * 512 * 256, o, inp(tb, 18) + slot * 16, wave);
            for (int rb_ = opq(REP_BAR); rb_ > 0; --rb_) gbar((unsigned*)(ws + WS_BAR), bst, wave);
            { pg8::Gemm g{o, WOUT, MTOK, 1024, 1024, 1024, 1024, 31, 0}; S.init(MTOK, 1024, G, bid_s(), KS); pg8::EpiResid E{XR, modl + 2 * 1024, (float*)(ws + WS_PART_A)}; pg8::gemm_phase(lds, g, S, E, wave); }
            for (int rb_ = opq(REP_BAR); rb_ > 0; --rb_) gbar((unsigned*)(ws + WS_BAR), bst, wave);
        } else if (kind == 1) {
            bf16_t *q = (bf16_t*)(ws + WS_RQ), *k = (bf16_t*)(ws + WS_RK), *v = (bf16_t*)(ws + WS_RV), *o = (bf16_t*)(ws + WS_RO);
            float* statp = (float*)(ws + WS_RSTP); float* fin = (float*)(ws + WS_RFIN);
            { pg8::Gemm g{hbuf, WIN, MTOK, 4096, 1024, 1024, 1024, 31, 0}; S.init(MTOK, 4096, G, bid_s()); pg8::EpiRetQKV E{q, k, v}; pg8::gemm_phase(lds, g, S, E, wave); }
            for (int rb_ = opq(REP_BAR); rb_ > 0; --rb_) gbar((unsigned*)(ws + WS_BAR), bst, wave);
            for (int rp_ = opq(REP_RET); rp_ > 0; --rp_) ret_scan_phase(lds, q, k, v, o, statp, inp(tb, 22) + slot * 8, inp(tb, 4), XR + OUT_RET, wave);
            for (int rb_ = opq(REP_BAR); rb_ > 0; --rb_) gbar((unsigned*)(ws + WS_BAR), bst, wave);
            bf16_t* h2 = (bf16_t*)(ws + WS_RQ);
            norm_phase<false>(nullptr, nullptr, XR, inp(tb, 8) + layer * DM, modl, 0, h2, lane, gw, NGW);
            ret_fin_phase(statp, fin, wave);
            for (int rb_ = opq(REP_BAR); rb_ > 0; --rb_) gbar((unsigned*)(ws + WS_BAR), bst, wave);
            { pg8::Gemm g{h2, WX, MTOK, 2048, 1024, 1024, 1024, 31, 0}; S.init(MTOK, 2048, G, bid_s()); pg8::EpiLateGate<0> E{o, 2048, fin, inp(tb, 21) + slot * 2048}; pg8::gemm_phase(lds, g, S, E, wave); }
            for (int rb_ = opq(REP_BAR); rb_ > 0; --rb_) gbar((unsigned*)(ws + WS_BAR), bst, wave);
            { pg8::Gemm g{o, WOUT, MTOK, 1024, 2048, 2048, 2048, 31, 0}; S.init(MTOK, 1024, G, bid_s(), KS); pg8::EpiResid E{XR, modl + 2 * 1024, (float*)(ws + WS_PART_R)}; pg8::gemm_phase(lds, g, S, E, wave); }
            for (int rb_ = opq(REP_BAR); rb_ > 0; --rb_) gbar((unsigned*)(ws + WS_BAR), bst, wave);
        } else {
            bf16_t *xr = (bf16_t*)(ws + WS_LXR), *xc = (bf16_t*)(ws + WS_LXC), *la = (bf16_t*)(ws + WS_LLA), *uu = (bf16_t*)(ws + WS_LU), *rec = (bf16_t*)(ws + WS_LREC);
            float* agg = (float*)(ws + WS_LAGG);
            { pg8::Gemm g{hbuf, WIN, MTOK, 1024, 1024, 1024, 1024, 31, 0}; S.init(MTOK, 1024, G, bid_s()); pg8::EpiStore<0> E{xr, 1024}; pg8::gemm_phase(lds, g, S, E, wave); }
            for (int rb_ = opq(REP_BAR); rb_ > 0; --rb_) gbar((unsigned*)(ws + WS_BAR), bst, wave);
            for (int rp_ = opq(REP_LRU); rp_ > 0; --rp_) lru_conv_phase(xr, xc, inp(tb, 24) + slot * 4096, inp(tb, 25) + slot * 1024, wave);
            for (int rb_ = opq(REP_BAR); rb_ > 0; --rb_) gbar((unsigned*)(ws + WS_BAR), bst, wave);
            { pg8::Gemm g{xc, WX2, MTOK, 4096, 128, 1024, 128, 1, 256}; S.init(MTOK, 4096, G, bid_s());
              pg8::EpiLruGates E{xc, la, uu, inp(tb, 27) + slot * 2048, inp(tb, 29) + slot * 2048, inp(tb, 30) + slot * 2048}; pg8::gemm_phase(lds, g, S, E, wave); }
            for (int rb_ = opq(REP_BAR); rb_ > 0; --rb_) gbar((unsigned*)(ws + WS_BAR), bst, wave);
            for (int rp_ = opq(REP_LRU); rp_ > 0; --rp_) lru_scanA_phase(la, uu, agg, wave);
            for (int rb_ = opq(REP_BAR); rb_ > 0; --rb_) gbar((unsigned*)(ws + WS_BAR), bst, wave);
            for (int rp_ = opq(REP_LRU); rp_ > 0; --rp_) lru_scanC_phase(la, uu, agg, rec, inp(tb, 5) + slot * 2048, XR + OUT_LRU, wave);
            for (int rb_ = opq(REP_BAR); rb_ > 0; --rb_) gbar((unsigned*)(ws + WS_BAR), bst, wave);
            { pg8::Gemm g{hbuf, WX, MTOK, 1024, 1024, 1024, 1024, 31, 0}; S.init(MTOK, 1024, G, bid_s()); pg8::EpiLateGate<1> E{rec, 1024, nullptr, nullptr}; pg8::gemm_phase(lds, g, S, E, wave); }
            for (int rb_ = opq(REP_BAR); rb_ > 0; --rb_) gbar((unsigned*)(ws + WS_BAR), bst, wave);
            { pg8::Gemm g{rec, WOUT, MTOK, 1024, 1024, 1024, 1024, 31, 0}; S.init(MTOK, 1024, G, bid_s(), KS); pg8::EpiResid E{XR, modl + 2 * 1024, (float*)(ws + WS_PART_L)}; pg8::gemm_phase(lds, g, S, E, wave); }
            for (int rb_ = opq(REP_BAR); rb_ > 0; --rb_) gbar((unsigned*)(ws + WS_BAR), bst, wave);
        }
        norm_phase<false>(nullptr, nullptr, XR, inp(tb, 9) + layer * DM, modl, 3, hbuf, lane, gw, NGW, KS ? (const float*)(ws + (kind == 0 ? WS_PART_A : kind == 1 ? WS_PART_R : WS_PART_L)) : nullptr, modl + 2 * 1024);
        for (int rb_ = opq(REP_BAR); rb_ > 0; --rb_) gbar((unsigned*)(ws + WS_BAR), bst, wave);
        bf16_t* hid = (bf16_t*)(ws + WS_HID);
        for (int rp_ = opq(REP_UP); rp_ > 0; --rp_) { pg8::Gemm g{hbuf, WUP, MTOK, 4096, 1024, 1024, 1024, 31, 0}; S.init(MTOK, 4096, G, bid_s()); pg8::EpiStore<2> E{hid, 4096}; pg8::gemm_phase(lds, g, S, E, wave); }
        for (int rb_ = opq(REP_BAR); rb_ > 0; --rb_) gbar((unsigned*)(ws + WS_BAR), bst, wave);
        { pg8::Gemm g{hid, WDN, MTOK, 1024, 4096, 4096, 4096, 31, 0}; S.init(MTOK, 1024, G, bid_s(), KS); pg8::EpiResid E{XR, modl + 5 * 1024, (float*)(ws + WS_PART_M)}; pg8::gemm_phase(lds, g, S, E, wave); }
        for (int rb_ = opq(REP_BAR); rb_ > 0; --rb_) gbar((unsigned*)(ws + WS_BAR), bst, wave);
    }
    {
        const int layer = 3; const float* gate = modl + 5 * 1024; const float* part = (const float*)(ws + WS_PART_M); float* xo = XR;
        const int l_ = lane_id_v();
        for (int r = gw; r < MTOK; r += NGW) { const bf16_t* xb = (const bf16_t*)xo + (size_t)r * 2048; f32x4 v[4];
#pragma unroll
            for (int j = 0; j < 4; ++j) { const u32x2 w = *(const u32x2*)(xb + 4 * l_ + 256 * j); v[j] = (f32x4){bflo(w.x), bfhi(w.x), bflo(w.y), bfhi(w.y)}; }
            if (KS && r >= 32768) { const float* gp = gate + (size_t)modidx(r) * 6144;
#pragma unroll
                for (int j = 0; j < 4; ++j) { const int c = 4 * l_ + 256 * j; const bf16_t* pp = (const bf16_t*)part + (size_t)(r - 32768) * DM + c;
                    const f32x4 ps = ((ld4bf(pp) + ld4bf(pp + (size_t)4096 * DM)) + ld4bf(pp + (size_t)2 * 4096 * DM)) + ld4bf(pp + (size_t)3 * 4096 * DM);
                    v[j] = v[j] + *(const f32x4*)(gp + c) * ps; } }
            asm volatile("s_waitcnt vmcnt(0)" ::: "memory");
#pragma unroll
            for (int j = 0; j < 4; ++j) *(f32x4*)(xo + (size_t)r * DM + 4 * l_ + 256 * j) = v[j];
        }
    }
}

#undef ws
#undef XR
#undef modt
#undef hbuf
#undef WUP
#undef WDN
#undef WIN
#undef WOUT
#undef WX
#undef WX2
#undef modl
#undef tb
extern "C" void kernel_launch(void* const* d_in, const int* in_sizes, int n_in, void* d_out, int out_size, void* d_ws, size_t ws_size, hipStream_t stream) {
    static int grid = 0;
    if (grid == 0) {
        int dev = 0, cus = 0, per_cu = 0;
        hipGetDevice(&dev); hipDeviceGetAttribute(&cus, hipDeviceAttributeMultiprocessorCount, dev);
        if (hipFuncSetAttribute((const void*)fwd_mega, hipFuncAttributeMaxDynamicSharedMemorySize, LDS_BYTES) != hipSuccess) { fprintf(stderr, "hipFuncSetAttribute failed\n"); grid = -1; return; }
        if (hipOccupancyMaxActiveBlocksPerMultiprocessor(&per_cu, (const void*)fwd_mega, 512, LDS_BYTES) != hipSuccess || per_cu < 1) { fprintf(stderr, "occupancy query: %d\n", per_cu); per_cu = 1; }
        (void)hipGetLastError();
        grid = cus * per_cu;
        if (grid != 256) { fprintf(stderr, "kernel_launch: this build needs exactly 256 resident workgroups (got %d)\n", grid); grid = -1; return; }
        if (n_in != 32 || ws_size < 512 * MiB) { fprintf(stderr, "kernel_launch: unexpected n_in %d / ws %zu\n", n_in, ws_size); grid = -1; return; }
    }
    if (grid < 0) return;
    KArgs a{};
    for (int i = 0; i < 32; ++i) a.in[i] = (const float*)d_in[i];
    a.out = (float*)d_out; a.ws = (unsigned char*)d_ws;
    if (hipMemsetAsync((char*)d_ws + WS_BAR, 0, 16384, stream) != hipSuccess) { fprintf(stderr, "memset failed\n"); return; }
    void* args[] = {&a};
    hipError_t e = hipLaunchCooperativeKernel((const void*)fwd_mega, dim3(grid), dim3(512), args, LDS_BYTES, stream);
    if (e != hipSuccess) fprintf(stderr, "cooperative launch failed: %s (grid %d)\n", hipGetErrorString(e), grid);
}
```
